# Optimizing an MI355X kernel written in HIP

```python
import math
import jax, jax.numpy as jnp
from jax import lax
import numpy as np

D_MODEL = 1024
BATCH = 4
SEQ = 4096
DEPTH = 1
DEC_BATCH = 2
DEC_SEQ = 16384
PAST_LEN = 128

MLA_HEADS = 8
QK_NOPE = 128
QK_ROPE = 64
V_HEAD = 128
Q_LORA = 384
KV_LORA = 256
ROPE_BASE = 10000.0
Q_BLOCK = 128
HY_WIDTH = 1024
HY_ORDER = 2
HY_DIRS = 2
FILT_BANDS = 16
FILT_EMB = 1 + 2 * FILT_BANDS
FILT_HID = 64
FILT_OUT_SCALE = 0.005
DECAY_FAST = 0.3
DECAY_SLOW = 1.5
DECAY_TARGET = 1e-2
DECAY_SHIFT = 0.05
MAX_DECAY = math.log(DECAY_TARGET) / DECAY_FAST
MIN_DECAY = math.log(DECAY_TARGET) / DECAY_SLOW
D_FF = 2816
IN_Q = Q_LORA
IN_KV = KV_LORA
IN_KR = QK_ROPE
IN_HY = 3 * HY_WIDTH
IN_GATE = 2 * D_MODEL
IN_COLS = IN_Q + IN_KV + IN_KR + IN_HY + IN_GATE
IN_SPLITS = (IN_Q, IN_Q + IN_KV, IN_Q + IN_KV + IN_KR, IN_Q + IN_KV + IN_KR + IN_HY)
DN_ALPHA = (2.0 * DEPTH) ** 0.25
DN_BETA = (8.0 * DEPTH) ** -0.25
LN_EPS = 1e-5
RMS_EPS = 1e-6

kernel_name = "hybrid_hyena_mla_deepnorm_encoder"


def layer_norm(x, g, b):
    xf = x.astype(jnp.float32)
    mu = jnp.mean(xf, axis=-1, keepdims=True)
    xc = xf - mu
    var = jnp.mean(xc * xc, axis=-1, keepdims=True)
    return (xc * lax.rsqrt(var + LN_EPS) * g.astype(jnp.float32) + b.astype(jnp.float32)).astype(x.dtype)


def rms_norm(x, g):
    xf = x.astype(jnp.float32)
    ms = jnp.mean(xf * xf, axis=-1, keepdims=True)
    return (xf * lax.rsqrt(ms + RMS_EPS) * g.astype(jnp.float32)).astype(x.dtype)


def dwconv3(u, w, b):
    up = jnp.pad(u, ((0, 0), (1, 1), (0, 0)))
    return up[:, :-2] * w[0] + up[:, 1:-1] * w[1] + up[:, 2:] * w[2] + b


def rope_tables(L):
    pos = jnp.arange(L, dtype=jnp.float32)
    inv = ROPE_BASE ** (-jnp.arange(0, QK_ROPE, 2, dtype=jnp.float32) / QK_ROPE)
    ang = pos[:, None] * inv[None, :]
    return jnp.cos(ang), jnp.sin(ang)


def apply_rope(x, cos, sin):
    x1, x2 = jnp.split(x, 2, axis=-1)
    return jnp.concatenate([x1 * cos - x2 * sin, x1 * sin + x2 * cos], axis=-1)


def mla_branch(c_q, c_kv, k_r, q_norm_g, w_uq, kv_norm_g, w_ukv, w_o_mla):
    B, L, _ = c_q.shape
    q = (rms_norm(c_q, q_norm_g) @ w_uq).reshape(B, L, MLA_HEADS, QK_NOPE + QK_ROPE)
    kv = (rms_norm(c_kv, kv_norm_g) @ w_ukv).reshape(B, L, MLA_HEADS, QK_NOPE + V_HEAD)
    q_nope, q_rope = q[..., :QK_NOPE], q[..., QK_NOPE:]
    k_nope, v = kv[..., :QK_NOPE], kv[..., QK_NOPE:]
    cos, sin = rope_tables(L)
    q_rope = apply_rope(q_rope, cos[None, :, None, :], sin[None, :, None, :])
    k_rope = apply_rope(k_r, cos[None], sin[None])
    scale = (QK_NOPE + QK_ROPE) ** -0.5
    nblk = L // Q_BLOCK
    qn_b = q_nope.reshape(B, nblk, Q_BLOCK, MLA_HEADS, QK_NOPE).transpose(1, 0, 2, 3, 4)
    qr_b = q_rope.reshape(B, nblk, Q_BLOCK, MLA_HEADS, QK_ROPE).transpose(1, 0, 2, 3, 4)

    def attend(blk):
        qn, qr = blk
        s = (jnp.einsum('bqhd,bkhd->bhqk', qn, k_nope).astype(jnp.float32)
             + jnp.einsum('bqhr,bkr->bhqk', qr, k_rope).astype(jnp.float32)) * scale
        p = jax.nn.softmax(s, axis=-1).astype(v.dtype)
        return jnp.einsum('bhqk,bkhd->bqhd', p, v)

    o = lax.map(attend, (qn_b, qr_b))
    o = o.transpose(1, 0, 2, 3, 4).reshape(B, L, MLA_HEADS * V_HEAD)
    return o @ w_o_mla


def hyena_filters(L, filt_w1, filt_b1, filt_freq, filt_w2, filt_b2, filt_w3):
    f32 = jnp.float32
    pos = jnp.arange(L, dtype=f32)
    t = pos / max(L - 1, 1)
    bands = jnp.linspace(1e-4, FILT_BANDS - 1, FILT_BANDS, dtype=f32)
    ang = (2.0 * math.pi * pos / L)[:, None] * bands[None, :]
    z = jnp.concatenate([t[:, None], jnp.cos(ang), -jnp.sin(ang)], axis=-1)
    freq = filt_freq.astype(f32)
    h = jnp.sin(freq * (z @ filt_w1.astype(f32) + filt_b1.astype(f32)))
    h = jnp.sin(freq * (h @ filt_w2.astype(f32) + filt_b2.astype(f32)))
    h = h @ filt_w3.astype(f32)
    deltas = jnp.abs(jnp.linspace(MIN_DECAY, MAX_DECAY, HY_WIDTH, dtype=f32))
    window = jnp.exp(-t[:, None] * deltas[None, :]) + DECAY_SHIFT
    return h.reshape(L, HY_DIRS, HY_ORDER, HY_WIDTH) * window[:, None, None, :]


def long_conv(v, h_fwd, h_bwd, skip):
    L, C = h_fwd.shape
    k = jnp.concatenate([h_fwd, jnp.zeros((1, C), jnp.float32), h_bwd[:0:-1]], axis=0)
    vf = jnp.fft.rfft(v, n=2 * L, axis=1)
    kf = jnp.fft.rfft(k, axis=0)
    y = jnp.fft.irfft(vf * kf[None], n=2 * L, axis=1)[:, :L]
    return y + v * skip.astype(jnp.float32)


def hyena_branch(u, short_w, short_b, filt_w1, filt_b1, filt_freq, filt_w2, filt_b2, filt_w3, hy_skip, w_o_hy):
    L = u.shape[1]
    u = dwconv3(u, short_w, short_b)
    x1, x2, v = jnp.split(u, 3, axis=-1)
    h = hyena_filters(L, filt_w1, filt_b1, filt_freq, filt_w2, filt_b2, filt_w3)
    z = v.astype(jnp.float32)
    for n, gate in enumerate((x1, x2)):
        z = gate.astype(jnp.float32) * long_conv(z, h[:, 0, n], h[:, 1, n], hy_skip[n])
    return z.astype(u.dtype) @ w_o_hy


def encoder_layer(x, w_in, short_w, short_b, q_norm_g, w_uq, kv_norm_g, w_ukv, w_o_mla,
                  filt_w1, filt_b1, filt_freq, filt_w2, filt_b2, filt_w3, hy_skip, w_o_hy,
                  w_out, ln1_g, ln1_b, w_ffn_up, dw_w, dw_b, w_ffn_down, ln2_g, ln2_b):
    proj = x @ w_in
    c_q, c_kv, k_r, u_hy, g = jnp.split(proj, IN_SPLITS, axis=-1)
    o_mla = mla_branch(c_q, c_kv, k_r, q_norm_g, w_uq, kv_norm_g, w_ukv, w_o_mla)
    o_hy = hyena_branch(u_hy, short_w, short_b, filt_w1, filt_b1, filt_freq, filt_w2, filt_b2,
                        filt_w3, hy_skip, w_o_hy)
    g_hy, g_mla = jnp.split(g, 2, axis=-1)
    merged = jax.nn.sigmoid(g_hy) * o_hy + jax.nn.sigmoid(g_mla) * o_mla
    x = layer_norm(DN_ALPHA * x + merged @ w_out, ln1_g, ln1_b)
    a, b = jnp.split(x @ w_ffn_up, 2, axis=-1)
    hmid = jax.nn.gelu(dwconv3(a, dw_w, dw_b), approximate=False) * b
    return layer_norm(DN_ALPHA * x + hmid @ w_ffn_down, ln2_g, ln2_b)


def setup_inputs(seed: int = 0) -> dict:
    key = jax.random.key(seed)
    ks = jax.random.split(key, 32)

    def nrm(k, shape, scale):
        return jax.random.normal(k, shape, jnp.float32) * scale

    def gain(k, shape):
        return 1.0 + nrm(k, shape, 0.02)

    Dp = DEPTH
    return {
        "x_prompt": nrm(ks[0], (BATCH, SEQ, D_MODEL), 1.0),
        "x_sample": nrm(ks[1], (DEC_BATCH, DEC_SEQ, D_MODEL), 1.0),
        "w_in": nrm(ks[2], (Dp, D_MODEL, IN_COLS), D_MODEL ** -0.5),
        "short_w": nrm(ks[3], (Dp, 3, IN_HY), 3 ** -0.5),
        "short_b": nrm(ks[4], (Dp, IN_HY), 0.02),
        "q_norm_g": gain(ks[5], (Dp, Q_LORA)),
        "w_uq": nrm(ks[6], (Dp, Q_LORA, MLA_HEADS * (QK_NOPE + QK_ROPE)), Q_LORA ** -0.5),
        "kv_norm_g": gain(ks[7], (Dp, KV_LORA)),
        "w_ukv": nrm(ks[8], (Dp, KV_LORA, MLA_HEADS * (QK_NOPE + V_HEAD)), KV_LORA ** -0.5),
        "w_o_mla": nrm(ks[9], (Dp, MLA_HEADS * V_HEAD, D_MODEL), (MLA_HEADS * V_HEAD) ** -0.5),
        "filt_w1": nrm(ks[10], (Dp, FILT_EMB, FILT_HID), FILT_EMB ** -0.5),
        "filt_b1": nrm(ks[11], (Dp, FILT_HID), 0.1),
        "filt_freq": gain(ks[12], (Dp, FILT_HID)),
        "filt_w2": nrm(ks[13], (Dp, FILT_HID, FILT_HID), FILT_HID ** -0.5),
        "filt_b2": nrm(ks[14], (Dp, FILT_HID), 0.1),
        "filt_w3": nrm(ks[15], (Dp, FILT_HID, HY_DIRS * HY_ORDER * HY_WIDTH), FILT_OUT_SCALE),
        "hy_skip": nrm(ks[16], (Dp, HY_ORDER, HY_WIDTH), 0.5),
        "w_o_hy": nrm(ks[17], (Dp, HY_WIDTH, D_MODEL), HY_WIDTH ** -0.5),
        "w_out": nrm(ks[18], (Dp, D_MODEL, D_MODEL), D_MODEL ** -0.5 * DN_BETA),
        "ln1_g": gain(ks[19], (Dp, D_MODEL)),
        "ln1_b": nrm(ks[20], (Dp, D_MODEL), 0.02),
        "w_ffn_up": nrm(ks[21], (Dp, D_MODEL, 2 * D_FF), D_MODEL ** -0.5),
        "dw_w": nrm(ks[22], (Dp, 3, D_FF), 3 ** -0.5),
        "dw_b": nrm(ks[23], (Dp, D_FF), 0.02),
        "w_ffn_down": nrm(ks[24], (Dp, D_FF, D_MODEL), D_FF ** -0.5 * DN_BETA),
        "ln2_g": gain(ks[25], (Dp, D_MODEL)),
        "ln2_b": nrm(ks[26], (Dp, D_MODEL), 0.02),
    }


def reference(x_prompt, x_sample, w_in, short_w, short_b, q_norm_g, w_uq, kv_norm_g, w_ukv, w_o_mla,
              filt_w1, filt_b1, filt_freq, filt_w2, filt_b2, filt_w3, hy_skip, w_o_hy,
              w_out, ln1_g, ln1_b, w_ffn_up, dw_w, dw_b, w_ffn_down, ln2_g, ln2_b):
    y_prompt = x_prompt
    y_sample = x_sample
    for i in range(DEPTH):
        lp = (w_in[i], short_w[i], short_b[i], q_norm_g[i], w_uq[i], kv_norm_g[i], w_ukv[i], w_o_mla[i],
              filt_w1[i], filt_b1[i], filt_freq[i], filt_w2[i], filt_b2[i], filt_w3[i], hy_skip[i], w_o_hy[i],
              w_out[i], ln1_g[i], ln1_b[i], w_ffn_up[i], dw_w[i], dw_b[i], w_ffn_down[i], ln2_g[i], ln2_b[i])
        y_prompt = encoder_layer(y_prompt, *lp)
        y_sample = encoder_layer(y_sample, *lp)
    return (y_prompt, y_sample)
```

```cpp
#include <hip/hip_runtime.h>
#include <hip/hip_cooperative_groups.h>
#include <cstdio>
#include <cstdint>
namespace cg = cooperative_groups;
namespace pg8 {
#define PG8_LAS __attribute__((address_space(3)))
typedef unsigned short bf16_t;
typedef short bf16x8 __attribute__((ext_vector_type(8)));
typedef float f32x4 __attribute__((ext_vector_type(4)));
typedef unsigned u32x4 __attribute__((ext_vector_type(4)));
constexpr int BM = 256, BK = 64, HALF = 128, HTB = HALF * BK * 2  , STAGE_BYTES = 8 * HTB, NXCD = 8, WGM = 8;

__host__ __device__ __forceinline__ int lds_byte(int r, int c) { const int st = (r >> 4) * 2 + (c >> 5), rr = r & 15, cc = c & 31, ob = rr * 64 + cc * 2; return st * 1024 + (ob ^ (((ob >> 9) & 1) << 5)); }
__host__ __device__ __forceinline__ void stage_rc(int b, int& R, int& C) { const int st = b / 1024, sb = b % 1024, swz = sb ^ (((sb >> 9) & 1) << 5); R = (st >> 1) * 16 + swz / 64; C = (st & 1) * 32 + (swz % 64) / 2; }
__host__ __device__ __forceinline__ int perm32(int rho) { const int n = rho >> 4, i = rho & 15; return 8 * (i >> 2) + 4 * n + (i & 3); }

struct Unit { int pm, pn; };
struct Gemm { const bf16_t* A; const bf16_t* Bt; int M, N, K; };

struct StaticOrder {
    int nM, nN, nwg, G, c;
    __host__ __device__ void init(int M, int N, int G_, int c_) { nM = M / BM; nN = N / BM; nwg = nM * nN; G = G_; c = c_; }
    __host__ __device__ bool next(int i, Unit& u) const {
        const long L = (long)i * G + c; if (L >= nwg) return false;
        int wgid = (int)L; { const int q = nwg / NXCD, r = nwg % NXCD, xcd = wgid % NXCD, off = wgid / NXCD; wgid = (xcd < r ? xcd * (q + 1) : r * (q + 1) + (xcd - r) * q) + off; }
        const int nig = WGM * nN, gid = wgid / nig, fm = gid * WGM, gsz = (nM - fm) < WGM ? (nM - fm) : WGM;
        u.pm = fm + ((wgid % nig) % gsz); u.pn = (wgid % nig) / gsz; return true;
    }
    __device__ __forceinline__ void a_ready(const Unit&) const {}
    __device__ __forceinline__ void done(const Unit&) const {}
};

__device__ __forceinline__ unsigned cvt_pk_bf16(float lo, float hi) { unsigned r; asm volatile("v_cvt_pk_bf16_f32 %0, %1, %2" : "=v"(r) : "v"(lo), "v"(hi)); return r; }
typedef float f32x2 __attribute__((ext_vector_type(2)));
__device__ __forceinline__ f32x2 gelu_pk(f32x2 v) {
    const f32x2 av = __builtin_elementwise_abs(v), d = av * 0.2316418882f + 1.0f;
    f32x2 t; t.x = __builtin_amdgcn_rcpf(d.x); t.y = __builtin_amdgcn_rcpf(d.y);
    f32x2 q = t * 0.5307027145f + (-0.7265760135f); q = q * t + 0.7107068705f; q = q * t + (-0.142248368f); q = q * t + 0.127414796f; q = q * t;
    const f32x2 s = (v * v) * (-0.72134752044f);
    f32x2 e; e.x = __builtin_amdgcn_exp2f(s.x); e.y = __builtin_amdgcn_exp2f(s.y);
    const f32x2 m = v * (q * e), r = v - m;
    f32x2 o; o.x = v.x < 0.f ? m.x : r.x; o.y = v.y < 0.f ? m.y : r.y; return o;
}
template <class Epi, class Sched, bool ALIGN_EPI = false, bool SP2 = false>
__device__ __forceinline__ void gemm_phase(PG8_LAS unsigned char* lds, const Gemm g, const Sched& S, const Epi& E) {
    int tid = threadIdx.x; asm volatile("" : "+v"(tid));
    const int wid = __builtin_amdgcn_readfirstlane(tid >> 6), lane = tid & 63, wr = wid >> 2, wc = wid & 3, fr = lane & 15, fq = lane >> 4;
    const int K = g.K, nt = K / BK;
    unsigned voffA[2], voffB[2];
#pragma unroll
    for (int i = 0; i < 2; ++i) { int R, C; stage_rc(tid * 16 + i * 8192, R, C); const int Rb = Epi::PERM ? ((R & ~31) + perm32(R & 31)) : R;
        voffA[i] = (unsigned)(R * K + C) * 2u; voffB[i] = (unsigned)(Rb * K + C) * 2u; }
    const size_t kstep = (size_t)(BK * 2);
    const size_t hstep = (size_t)HALF * K * 2;
    const size_t tstep = 2 * hstep;
    const unsigned ldsw = (unsigned)wid * 1024u;
    const int aoff = lds_byte(wr * 64 + fr, fq * 8), boff = lds_byte(wc * 32 + fr, fq * 8);
#define PG8_SA(b, h) (((b) * 2 + (h)) * HTB)
#define PG8_SB(b, h) ((4 + (b) * 2 + (h)) * HTB)
#define PG8_STAGE(bufoff, gbase, voff) do { _Pragma("unroll") for (int _i = 0; _i < 2; ++_i) \
        __builtin_amdgcn_global_load_lds((const unsigned*)((const char*)(gbase) + (voff)[_i]), (PG8_LAS unsigned*)(lds + (bufoff) + ldsw + _i * 8192), 16, 0, 0); } while (0)
#define PG8_LDA(dst, b, h) do { _Pragma("unroll") for (int m = 0; m < 4; ++m) _Pragma("unroll") for (int k = 0; k < 2; ++k) dst[m][k] = *(const PG8_LAS bf16x8*)(lds + PG8_SA(b, h) + aoff + m * 2048 + k * 1024); } while (0)
#define PG8_LDB(dst, b, h) do { _Pragma("unroll") for (int n = 0; n < 2; ++n) _Pragma("unroll") for (int k = 0; k < 2; ++k) dst[n][k] = *(const PG8_LAS bf16x8*)(lds + PG8_SB(b, h) + boff + n * 2048 + k * 1024); } while (0)
#define PG8_MMA(ai, bj, At, Bt) do { __builtin_amdgcn_s_setprio(1); _Pragma("unroll") for (int m = 0; m < 4; ++m) _Pragma("unroll") for (int n = 0; n < 2; ++n) _Pragma("unroll") for (int k = 0; k < 2; ++k) \
        acc[ai][bj][m][n] = __builtin_amdgcn_mfma_f32_16x16x32_bf16(Bt[n][k], At[m][k], acc[ai][bj][m][n], 0, 0, 0); __builtin_amdgcn_s_setprio(0); } while (0)
#define PG8_WAIT_V(n) asm volatile("s_waitcnt vmcnt(" #n ")" ::: "memory")
#define PG8_WAIT_L(n) asm volatile("s_waitcnt lgkmcnt(" #n ")" ::: "memory")
#define PG8_BAR __builtin_amdgcn_s_barrier()
#define PG8_SCHED __builtin_amdgcn_sched_barrier(0)
    Unit cur, nxt; int ui = 0;
    if (!S.next(0, cur)) return;
    f32x4 acc[2][2][4][2];
#pragma unroll
    for (int a = 0; a < 2; ++a)
#pragma unroll
        for (int b = 0; b < 2; ++b)
#pragma unroll
            for (int m = 0; m < 4; ++m)
#pragma unroll
                for (int n = 0; n < 2; ++n) acc[a][b][m][n] = (f32x4){0.f, 0.f, 0.f, 0.f};
    bf16x8 At[4][2], B0[2][2], B1[2][2];
    const char* cA = (const char*)g.A + (size_t)cur.pm * tstep; const char* cB = (const char*)g.Bt + (size_t)cur.pn * tstep;
    S.a_ready(cur);
    if constexpr (SP2) {
        PG8_STAGE(PG8_SB(0, 0), cB, voffB); PG8_STAGE(PG8_SB(0, 1), cB + hstep, voffB); PG8_STAGE(PG8_SA(0, 0), cA, voffA); PG8_STAGE(PG8_SA(0, 1), cA + hstep, voffA);
        if (wr == 1) PG8_BAR;
        PG8_WAIT_V(2); PG8_BAR;
        PG8_STAGE(PG8_SB(1, 0), cB + kstep, voffB); PG8_STAGE(PG8_SA(1, 0), cA + kstep, voffA); PG8_STAGE(PG8_SB(1, 1), cB + hstep + kstep, voffB);
        PG8_WAIT_V(6); PG8_BAR;
    } else {
        PG8_STAGE(PG8_SB(0, 0), cB, voffB); PG8_STAGE(PG8_SA(0, 0), cA, voffA); PG8_STAGE(PG8_SB(0, 1), cB + hstep, voffB); PG8_STAGE(PG8_SA(0, 1), cA + hstep, voffA);
        if (wr == 1) PG8_BAR;
        PG8_WAIT_V(4); PG8_BAR;
        PG8_STAGE(PG8_SB(1, 0), cB + kstep, voffB); PG8_STAGE(PG8_SA(1, 0), cA + kstep, voffA); PG8_STAGE(PG8_SB(1, 1), cB + hstep + kstep, voffB);
        PG8_WAIT_V(6); PG8_BAR;
    }
    for (;;) {
        const bool has_next = S.next(ui + 1, nxt);
        const char* nA = has_next ? (const char*)g.A + (size_t)nxt.pm * tstep : cA; const char* nB = has_next ? (const char*)g.Bt + (size_t)nxt.pn * tstep : cB;
        for (int t = 0; t < nt; t += 2) {
            const bool last = (t == nt - 2);
            const char* a1 = cA + (size_t)(t + 1) * kstep;
            const char* a2 = last ? nA : cA + (size_t)(t + 2) * kstep; const char* b2 = last ? nB : cB + (size_t)(t + 2) * kstep;
            const char* a3 = a2 + kstep; const char* b3 = b2 + kstep;
            if (last && has_next) S.a_ready(nxt);
            if constexpr (SP2) {
            PG8_LDB(B0, 0, 0); PG8_LDB(B1, 0, 1); PG8_SCHED; PG8_LDA(At, 0, 0); PG8_STAGE(PG8_SA(1, 1), a1 + hstep, voffA);
            PG8_WAIT_V(8); PG8_WAIT_L(0); PG8_BAR; PG8_MMA(0, 0, At, B0); PG8_MMA(0, 1, At, B1); PG8_BAR; PG8_SCHED;
            PG8_LDA(At, 0, 1); PG8_STAGE(PG8_SB(0, 0), b2, voffB); PG8_STAGE(PG8_SB(0, 1), b2 + hstep, voffB); PG8_STAGE(PG8_SA(0, 0), a2, voffA);
            PG8_WAIT_V(8); PG8_WAIT_L(0); PG8_BAR; PG8_MMA(1, 0, At, B0); PG8_MMA(1, 1, At, B1); PG8_BAR; PG8_SCHED;
            PG8_LDB(B0, 1, 0); PG8_LDB(B1, 1, 1); PG8_SCHED; PG8_LDA(At, 1, 0); PG8_STAGE(PG8_SA(0, 1), a2 + hstep, voffA);
            PG8_WAIT_V(8); PG8_WAIT_L(0); PG8_BAR; PG8_MMA(0, 0, At, B0); PG8_MMA(0, 1, At, B1); PG8_BAR; PG8_SCHED;
            PG8_LDA(At, 1, 1); PG8_STAGE(PG8_SB(1, 0), b3, voffB); PG8_STAGE(PG8_SB(1, 1), b3 + hstep, voffB); PG8_STAGE(PG8_SA(1, 0), a3, voffA);
            PG8_WAIT_V(8); PG8_WAIT_L(0); PG8_BAR; PG8_MMA(1, 0, At, B0); PG8_MMA(1, 1, At, B1); PG8_BAR; PG8_SCHED;
            } else {
            PG8_LDB(B0, 0, 0); PG8_SCHED; PG8_LDA(At, 0, 0); PG8_STAGE(PG8_SA(1, 1), a1 + hstep, voffA);
            PG8_WAIT_L(8); PG8_BAR; PG8_WAIT_L(0); PG8_MMA(0, 0, At, B0); PG8_BAR; PG8_SCHED;
            PG8_LDB(B1, 0, 1); PG8_STAGE(PG8_SB(0, 0), b2, voffB);
            PG8_BAR; PG8_WAIT_L(0); PG8_MMA(0, 1, At, B1); PG8_BAR;
            PG8_LDA(At, 0, 1); PG8_STAGE(PG8_SA(0, 0), a2, voffA);
            PG8_BAR; PG8_WAIT_L(0); PG8_MMA(1, 0, At, B0); PG8_BAR; PG8_SCHED;
            PG8_STAGE(PG8_SB(0, 1), b2 + hstep, voffB);
            PG8_WAIT_V(6); PG8_BAR; PG8_MMA(1, 1, At, B1); PG8_BAR;
            PG8_LDB(B0, 1, 0); PG8_SCHED; PG8_LDA(At, 1, 0); PG8_STAGE(PG8_SA(0, 1), a2 + hstep, voffA);
            PG8_WAIT_L(8); PG8_BAR; PG8_WAIT_L(0); PG8_MMA(0, 0, At, B0); PG8_BAR; PG8_SCHED;
            PG8_LDB(B1, 1, 1); PG8_STAGE(PG8_SB(1, 0), b3, voffB);
            PG8_BAR; PG8_WAIT_L(0); PG8_MMA(0, 1, At, B1); PG8_BAR;
            PG8_LDA(At, 1, 1); PG8_STAGE(PG8_SA(1, 0), a3, voffA);
            PG8_BAR; PG8_WAIT_L(0); PG8_MMA(1, 0, At, B0); PG8_BAR; PG8_SCHED;
            PG8_STAGE(PG8_SB(1, 1), b3 + hstep, voffB);
            PG8_WAIT_V(6); PG8_BAR; PG8_MMA(1, 1, At, B1); PG8_BAR;
            }
        }
        if constexpr (ALIGN_EPI) { if (wr == 0) PG8_BAR; }
        if constexpr (!Epi::AFTER_DRAIN) { E(acc, cur, wr, wc, fr, fq); S.done(cur); }
        if (!has_next) break;
#pragma unroll
        for (int a = 0; a < 2; ++a)
#pragma unroll
            for (int b = 0; b < 2; ++b)
#pragma unroll
                for (int m = 0; m < 4; ++m)
#pragma unroll
                    for (int n = 0; n < 2; ++n) acc[a][b][m][n] = (f32x4){0.f, 0.f, 0.f, 0.f};
        cur = nxt; cA = nA; cB = nB; ++ui;
        if constexpr (ALIGN_EPI) { if (wr == 1) PG8_BAR; }
    }
    PG8_WAIT_V(0);
    if constexpr (!ALIGN_EPI) { if (wr == 0) PG8_BAR; }
    PG8_BAR;
    if constexpr (Epi::AFTER_DRAIN) { E.fused(acc, cur, wr, wc, fr, fq, lds, wid, lane); S.done(cur); }
#undef PG8_SA
#undef PG8_SB
#undef PG8_STAGE
#undef PG8_LDA
#undef PG8_LDB
#undef PG8_MMA
#undef PG8_WAIT_V
#undef PG8_WAIT_L
#undef PG8_BAR
#undef PG8_SCHED
}
}

#ifndef EN_PRO
#define EN_PRO 1
#endif
#ifndef EN_HY14
#define EN_HY14 1
#endif
#ifndef EN_HY12
#define EN_HY12 1
#endif
#ifndef EN_ATT
#define EN_ATT 1
#endif
#ifndef EN_GEMM
#define EN_GEMM 0xffff
#endif
#ifndef EPI_FENCE
#define EPI_FENCE 1
#endif
#ifndef G_ALIGN
#define G_ALIGN true
#endif
#ifndef G_SP2
#define G_SP2 true
#endif
#ifndef MK_MULTI
#define MK_MULTI 0
#endif
#define LAS __attribute__((address_space(3)))
using pg8::bf16_t; using pg8::f32x4; using pg8::u32x4; using pg8::Unit;
typedef float c2 __attribute__((ext_vector_type(2)));

constexpr int TC = 16384;
constexpr int LDS_BYTES = 139264;
constexpr float DN_ALPHA = 1.189207115002721f, LN_EPS = 1e-5f, RMS_EPS = 1e-6f;
constexpr size_t MiB = 1u << 20;
constexpr size_t WS_WIN = 0, WS_WUQ = 12 * MiB, WS_WUKV = 14 * MiB, WS_WOMLA = 15 * MiB, WS_WOHY = 17 * MiB, WS_WOUT = 19 * MiB, WS_WUP = 21 * MiB,
                 WS_WDOWN = 32 * MiB, WS_W3B = 38 * MiB, WS_COS = 40 * MiB, WS_SIN = 42 * MiB, WS_H2B = 44 * MiB, WS_SSQ = 50 * MiB, WS_Z = 52 * MiB,
                 WS_UT = 116 * MiB, WS_FT = 308 * MiB, WS_ZT = 436 * MiB,
                 WS_CQ = 116 * MiB, WS_CKV = 128 * MiB, WS_KR = 136 * MiB, WS_G = 138 * MiB, WS_Q = 202 * MiB, WS_KV = 250 * MiB, WS_O = 314 * MiB,
                 WS_MG = 346 * MiB, WS_X1B = 378 * MiB, WS_HM = 410 * MiB, WS_AB = 116 * MiB, WS_END = 512 * MiB;

__device__ __forceinline__ float bflo(unsigned w) { return __uint_as_float(w << 16); }
__device__ __forceinline__ float bfhi(unsigned w) { return __uint_as_float(w & 0xffff0000u); }
__device__ __forceinline__ float bf2f(bf16_t v) { return __uint_as_float(((unsigned)v) << 16); }
__device__ __forceinline__ unsigned pk(float lo, float hi) { return pg8::cvt_pk_bf16(lo, hi); }
__device__ __forceinline__ bf16_t f2bf(float v) { return (bf16_t)(pk(v, 0.f) & 0xffffu); }
__device__ __forceinline__ void st8(bf16_t* p, f32x4 a, f32x4 b) { u32x4 w; w.x = pk(a[0], a[1]); w.y = pk(a[2], a[3]); w.z = pk(b[0], b[1]); w.w = pk(b[2], b[3]); *(u32x4*)p = w; }
__device__ __forceinline__ void ld8(const bf16_t* p, f32x4& a, f32x4& b) { const u32x4 w = *(const u32x4*)p;
    a[0] = bflo(w.x); a[1] = bfhi(w.x); a[2] = bflo(w.y); a[3] = bfhi(w.y); b[0] = bflo(w.z); b[1] = bfhi(w.z); b[2] = bflo(w.w); b[3] = bfhi(w.w); }

template <class F> struct Epi8 {
    static constexpr bool PERM = true, AFTER_DRAIN = false;
    F f;
    __device__ __forceinline__ void operator()(const f32x4 (&acc)[2][2][4][2], const Unit& u, int wr, int wc, int fr, int fq) const {
        const int row0 = u.pm * pg8::BM + wr * 64 + fr, col0 = u.pn * pg8::BM + wc * 32 + 8 * fq;
#pragma unroll
        for (int ai = 0; ai < 2; ++ai)
#pragma unroll
            for (int m = 0; m < 4; ++m)
#pragma unroll
                for (int bj = 0; bj < 2; ++bj) { f(row0 + ai * pg8::HALF + m * 16, col0 + bj * pg8::HALF, acc[ai][bj][m][0], acc[ai][bj][m][1], fq);
                  if (EPI_FENCE) asm volatile("" ::: "memory"); }
    }
};
__device__ __forceinline__ void rope8(f32x4& a, f32x4& b, const float* cosT, const float* sinT, int pos, int i0) {
    const f32x4 c = *(const f32x4*)(cosT + pos * 32 + i0), s = *(const f32x4*)(sinT + pos * 32 + i0);
    f32x4 oa, ob;
    oa[0] = a[0] * c[0] - a[1] * s[0]; oa[1] = a[0] * s[0] + a[1] * c[0]; oa[2] = a[2] * c[1] - a[3] * s[1]; oa[3] = a[2] * s[1] + a[3] * c[1];
    ob[0] = b[0] * c[2] - b[1] * s[2]; ob[1] = b[0] * s[2] + b[1] * c[2]; ob[2] = b[2] * c[3] - b[3] * s[3]; ob[3] = b[2] * s[3] + b[3] * c[3];
    a = oa; b = ob;
}
__device__ __forceinline__ float sigm(float x) { return 1.0f / (1.0f + __expf(-x)); }
struct FTm { bf16_t *CQ, *CKV, *KR, *G; float* ssq; const float *cosT, *sinT; int seqmask;
    __device__ __forceinline__ void operator()(int row, int col, f32x4 a, f32x4 b, int fq) const {
        if (col < 640) {
            float s = (a[0] * a[0] + a[1] * a[1]) + (a[2] * a[2] + a[3] * a[3]) + (b[0] * b[0] + b[1] * b[1]) + (b[2] * b[2] + b[3] * b[3]);
            s += __shfl_xor(s, 16); s += __shfl_xor(s, 32);
            if (col < 384) { st8(CQ + (size_t)row * 384 + col, a, b); if (fq == 0) __hip_atomic_fetch_add(ssq + row * 2, s, __ATOMIC_RELAXED, __HIP_MEMORY_SCOPE_AGENT); }
            else { st8(CKV + (size_t)row * 256 + (col - 384), a, b); if (fq == 0) __hip_atomic_fetch_add(ssq + row * 2 + 1, s, __ATOMIC_RELAXED, __HIP_MEMORY_SCOPE_AGENT); }
        } else if (col < 704) {
            const int j = col - 640; rope8(a, b, cosT, sinT, row & seqmask, j >> 1); st8(KR + (size_t)row * 64 + j, a, b);
        } else if (col < 2752) {
#pragma unroll
            for (int i = 0; i < 4; ++i) { a[i] = sigm(a[i]); b[i] = sigm(b[i]); }
            st8(G + (size_t)row * 2048 + (col - 704), a, b);
        }
    }
};
struct FQ { bf16_t* Q; const float* ssq; const float *cosT, *sinT; int seqmask;
    __device__ __forceinline__ void operator()(int row, int col, f32x4 a, f32x4 b, int) const {
        const float rs = rsqrtf(ssq[row * 2] * (1.0f / 384.0f) + RMS_EPS); a = a * rs; b = b * rs;
        if (col >= 1024) rope8(a, b, cosT, sinT, row & seqmask, ((col - 1024) & 63) >> 1);
        st8(Q + (size_t)row * 1536 + col, a, b);
    }
};
struct FKV { bf16_t* KV; const float* ssq;
    __device__ __forceinline__ void operator()(int row, int col, f32x4 a, f32x4 b, int) const {
        const float rs = rsqrtf(ssq[row * 2 + 1] * (1.0f / 256.0f) + RMS_EPS); st8(KV + (size_t)row * 2048 + col, a * rs, b * rs);
    }
};
struct FBf { bf16_t* O; size_t ld;
    __device__ __forceinline__ void operator()(int row, int col, f32x4 a, f32x4 b, int) const { st8(O + (size_t)row * ld + col, a, b); }
};
struct FFilt { bf16_t* FT; int L;
    __device__ __forceinline__ void operator()(int row, int col, f32x4 a, f32x4 b, int) const {
        const int c = row & 1023; const float MIN_DECAY = -3.0701134573253944f, MAX_DECAY = -15.350567286626973f;
        const float kk = -1.4426950408889634f * fabsf(MIN_DECAY + (MAX_DECAY - MIN_DECAY) * ((float)c * (1.0f / 1023.0f))) / (float)(L - 1); const float fc = (float)col;
#pragma unroll
        for (int i = 0; i < 4; ++i) { a[i] *= __builtin_amdgcn_exp2f((fc + (float)i) * kk) + 0.05f; b[i] *= __builtin_amdgcn_exp2f((fc + (float)(4 + i)) * kk) + 0.05f; }
        st8(FT + (size_t)row * L + col, a, b);
    }
};
struct FM1 { bf16_t* MG; const bf16_t* G;
    __device__ __forceinline__ void operator()(int row, int col, f32x4 a, f32x4 b, int) const {
        f32x4 ga, gb; ld8(G + (size_t)row * 2048 + col, ga, gb); st8(MG + (size_t)row * 1024 + col, a * ga, b * gb);
    }
};
struct FM2 { bf16_t* MG; const bf16_t* G;
    __device__ __forceinline__ void operator()(int row, int col, f32x4 a, f32x4 b, int) const {
        f32x4 ga, gb, pa, pb; ld8(G + (size_t)row * 2048 + 1024 + col, ga, gb); ld8(MG + (size_t)row * 1024 + col, pa, pb);
        st8(MG + (size_t)row * 1024 + col, pa + a * ga, pb + b * gb);
    }
};
struct FOut { float* Y; const float* X;
    __device__ __forceinline__ void operator()(int row, int col, f32x4 a, f32x4 b, int) const {
        const size_t o = (size_t)row * 1024 + col; const f32x4 xa = *(const f32x4*)(X + o), xb = *(const f32x4*)(X + o + 4);
        *(f32x4*)(Y + o) = xa * DN_ALPHA + a; *(f32x4*)(Y + o + 4) = xb * DN_ALPHA + b;
    }
};
struct FDown { float* Y;
    __device__ __forceinline__ void operator()(int row, int col, f32x4 a, f32x4 b, int) const {
        const size_t o = (size_t)row * 1024 + col; const f32x4 xa = *(const f32x4*)(Y + o), xb = *(const f32x4*)(Y + o + 4);
        *(f32x4*)(Y + o) = xa * DN_ALPHA + a; *(f32x4*)(Y + o + 4) = xb * DN_ALPHA + b;
    }
};
template <int ID, class F> __device__ __forceinline__ void run_gemm(PG8_LAS unsigned char* lds, const bf16_t* A, const bf16_t* Bt, int M, int N, int K, const F& f) {
  if constexpr ((EN_GEMM >> ID) & 1) {
    asm volatile("" : "+s"(M), "+s"(N), "+s"(K));
    pg8::Gemm g{A, Bt, M, N, K}; pg8::StaticOrder S; S.init(M, N, (int)gridDim.x, (int)blockIdx.x);
    Epi8<F> E{f};
    pg8::gemm_phase<Epi8<F>, pg8::StaticOrder, G_ALIGN, (ID != 0 && ID != 3)>(lds, g, S, E);
  }
}

namespace att {
typedef short bf16x8 __attribute__((ext_vector_type(8)));
typedef short s16x4 __attribute__((ext_vector_type(4)));
typedef float f32x16 __attribute__((ext_vector_type(16)));
constexpr int NW = 8, QBLK = 32, KVBLK = 64, LDQ = 1536, LDK = 2048, LDKR = 64, LDO = 1024;
constexpr float SCALE = 0.07216878364870323f, THR = 8.f;
constexpr int SHM_V = 16384, SHM_K = 24576;
#define AKSWZ(row, colB) ((row) * 384 + ((colB) ^ (((row) & 7) << 4)))
#define SBAR() __builtin_amdgcn_sched_barrier(0)
__device__ __forceinline__ int crow(int r, int hi) { return (r & 3) + 8 * (r >> 2) + 4 * hi; }
__device__ __forceinline__ void partialSM(f32x16& p0, f32x16& p1, float& m_reg, float& mn, float& alpha) {
  constexpr float C = SCALE * 1.4426950408889634f;
  float pmax = p0[0]; for (int r = 1; r < 16; ++r) pmax = fmaxf(pmax, p0[r]); for (int r = 0; r < 16; ++r) pmax = fmaxf(pmax, p1[r]);
  { auto rr = __builtin_amdgcn_permlane32_swap(__float_as_uint(pmax), __float_as_uint(pmax), false, false);
    pmax = fmaxf(__uint_as_float(rr[0]), __uint_as_float(rr[1])); }
  if (__builtin_expect(__all(pmax - m_reg <= THR / SCALE), 1)) { mn = m_reg; alpha = 1.f; }
  else { mn = fmaxf(m_reg, pmax); alpha = __builtin_amdgcn_exp2f((m_reg - mn) * C); m_reg = mn; }
  float mnC = -mn * C;
  for (int r = 0; r < 16; ++r) p0[r] = fmaf(p0[r], C, mnC); for (int r = 0; r < 16; ++r) p1[r] = fmaf(p1[r], C, mnC);
  for (int r = 0; r < 16; ++r) p0[r] = __builtin_amdgcn_exp2f(p0[r]);
}
__device__ __forceinline__ void finishSM(f32x16& p0, f32x16& p1, float alpha, float& l_reg, bf16x8& pa0, bf16x8& pa1, bf16x8& pa2, bf16x8& pa3) {
  for (int r = 0; r < 16; ++r) p1[r] = __builtin_amdgcn_exp2f(p1[r]);
  float ps = 0; for (int r = 0; r < 16; ++r) ps += p0[r]; for (int r = 0; r < 16; ++r) ps += p1[r];
  { auto rr = __builtin_amdgcn_permlane32_swap(__float_as_uint(ps), __float_as_uint(ps), false, false);
    ps = __uint_as_float(rr[0]) + __uint_as_float(rr[1]); }
  l_reg = l_reg * alpha + ps;
#define PK4(P, BASE, OUT) do { unsigned a0 = pk(P[BASE + 0], P[BASE + 1]), a1 = pk(P[BASE + 2], P[BASE + 3]);   \
    unsigned b0 = pk(P[BASE + 4], P[BASE + 5]), b1 = pk(P[BASE + 6], P[BASE + 7]);                              \
    auto r0 = __builtin_amdgcn_permlane32_swap(a0, b0, false, false); auto r1 = __builtin_amdgcn_permlane32_swap(a1, b1, false, false); \
    u32x4 w = {r0[0], r1[0], r0[1], r1[1]}; OUT = *reinterpret_cast<bf16x8*>(&w); } while (0)
  PK4(p0, 0, pa0); PK4(p0, 8, pa1); PK4(p1, 0, pa2); PK4(p1, 8, pa3);
#undef PK4
}
__device__ __forceinline__ void qkt(f32x16& p0, f32x16& p1, const char* Ks, const bf16x8* qr, const bf16x8* qrl, int r32, int hi) {
  p0 = f32x16{}; p1 = f32x16{};
  int kb[4];
#pragma unroll
  for (int dl = 0; dl < 4; ++dl) kb[dl] = r32 * 384 + ((dl * 32 + hi * 16) ^ ((r32 & 7) << 4));
#pragma unroll
  for (int d0 = 0; d0 < 12; ++d0) {
    bf16x8 b0 = *reinterpret_cast<const bf16x8*>(Ks + kb[d0 & 3] + (d0 >> 2) * 128);
    bf16x8 b1 = *reinterpret_cast<const bf16x8*>(Ks + kb[d0 & 3] + (d0 >> 2) * 128 + 32 * 384);
    const bf16x8 qv = (d0 < 8) ? qr[d0 & 7] : qrl[(d0 - 8) * 64];
    p0 = __builtin_amdgcn_mfma_f32_32x32x16_bf16(b0, qv, p0, 0, 0, 0);
    p1 = __builtin_amdgcn_mfma_f32_32x32x16_bf16(b1, qv, p1, 0, 0, 0); }
}
__device__ __forceinline__ int v_st(int k, int c) { const int kk = (k & ~0xC) | ((k & 4) << 1) | ((k & 8) >> 1); return ((kk >> 3) * 4 + (c >> 5)) * 512 + ((kk & 7) * 32 + (c & 31)) * 2; }
__device__ __forceinline__ int v_rd_base(int lane) { return ((lane & 3) << 3) | (((lane >> 2) & 3) << 6) | (((lane >> 4) & 1) << 5) | (((lane >> 5) & 1) << 8); }
constexpr int v_rd_off(int d0, int ks, int half) { return d0 * 512 + ks * 4096 + half * 2048; }
template <int OFF> __device__ __forceinline__ s16x4 tr_read(int vb) {
  s16x4 r; asm volatile("ds_read_b64_tr_b16 %0, %1 offset:%2" : "=&v"(r) : "v"(vb), "i"(OFF) : "memory"); return r;
}
template <int D0> __device__ __forceinline__ void pv_one(f32x16& od, int vb, bf16x8 pa0, bf16x8 pa1, bf16x8 pa2, bf16x8 pa3) {
  const s16x4 l0 = tr_read<v_rd_off(D0, 0, 0)>(vb), h0 = tr_read<v_rd_off(D0, 0, 1)>(vb), l1 = tr_read<v_rd_off(D0, 1, 0)>(vb), h1 = tr_read<v_rd_off(D0, 1, 1)>(vb);
  const s16x4 l2 = tr_read<v_rd_off(D0, 2, 0)>(vb), h2 = tr_read<v_rd_off(D0, 2, 1)>(vb), l3 = tr_read<v_rd_off(D0, 3, 0)>(vb), h3 = tr_read<v_rd_off(D0, 3, 1)>(vb);
  asm volatile("s_waitcnt lgkmcnt(0)" ::: "memory"); SBAR();
#define PKV(L, H) (bf16x8){L[0], L[1], L[2], L[3], H[0], H[1], H[2], H[3]}
  od = __builtin_amdgcn_mfma_f32_32x32x16_bf16(pa0, PKV(l0, h0), od, 0, 0, 0);
  od = __builtin_amdgcn_mfma_f32_32x32x16_bf16(pa1, PKV(l1, h1), od, 0, 0, 0);
  od = __builtin_amdgcn_mfma_f32_32x32x16_bf16(pa2, PKV(l2, h2), od, 0, 0, 0);
  od = __builtin_amdgcn_mfma_f32_32x32x16_bf16(pa3, PKV(l3, h3), od, 0, 0, 0);
#undef PKV
}
__device__ __forceinline__ void pv_d0(f32x16* o, int vb, bf16x8 pa0, bf16x8 pa1, bf16x8 pa2, bf16x8 pa3) {
  pv_one<0>(o[0], vb, pa0, pa1, pa2, pa3); pv_one<1>(o[1], vb, pa0, pa1, pa2, pa3); pv_one<2>(o[2], vb, pa0, pa1, pa2, pa3); pv_one<3>(o[3], vb, pa0, pa1, pa2, pa3);
}
__device__ __forceinline__ void attn_unit(const bf16_t* __restrict__ Qb, const bf16_t* __restrict__ Kh, const bf16_t* __restrict__ Vh, const bf16_t* __restrict__ KRb,
                                          bf16_t* __restrict__ Ob, int seq, char* lds, int h) {
  int tid = threadIdx.x; asm volatile("" : "+v"(tid));
  const int wid = tid >> 6, lane = tid & 63, r32 = lane & 31, hi = lane >> 5;
  char* V_lds = lds; char* K_lds = lds + 2 * SHM_V;
  float* ws = (float*)(lds + 2 * SHM_V + 2 * SHM_K) + wid * 64; float* li_l = ws; float* al_l = ws + 32;
  float m_reg = -1e30f, l_reg = 0; f32x16 o[4] = {}; bf16x8 qr[8];
  bf16x8* qrl = (bf16x8*)(lds + 2 * SHM_V + 2 * SHM_K + 2048) + wid * 256 + lane;
  const bf16_t* Qw = Qb + (long)(wid * QBLK + r32) * LDQ + hi * 8 + h * 128;
  const bf16_t* Qwr = Qb + (long)(wid * QBLK + r32) * LDQ + hi * 8 + 1024 + h * 64;
#pragma unroll
  for (int d0 = 0; d0 < 8; ++d0) qr[d0] = *reinterpret_cast<const bf16x8*>(Qw + d0 * 16);
#pragma unroll
  for (int d0 = 8; d0 < 12; ++d0) qrl[(d0 - 8) * 64] = *reinterpret_cast<const bf16x8*>(Qwr + (d0 - 8) * 16);
  const int sr = tid >> 4, sc = (tid & 15) * 8, vst0 = v_st(sr, sc), vst1 = v_st(32 + sr, sc);
  const int rr = tid >> 3, rc = (tid & 7) * 8;
  const int vb0 = (int)(uintptr_t)V_lds + v_rd_base(lane);
  bf16x8 vs0, vs1, ks0, ks1, kr0;
#define SLOAD(k0) do { vs0 = *reinterpret_cast<const bf16x8*>(&Vh[(long)((k0) + sr) * LDK + sc]); vs1 = *reinterpret_cast<const bf16x8*>(&Vh[(long)((k0) + 32 + sr) * LDK + sc]); \
    ks0 = *reinterpret_cast<const bf16x8*>(&Kh[(long)((k0) + sr) * LDK + sc]); ks1 = *reinterpret_cast<const bf16x8*>(&Kh[(long)((k0) + 32 + sr) * LDK + sc]); \
    kr0 = *reinterpret_cast<const bf16x8*>(&KRb[(long)((k0) + rr) * LDKR + rc]); } while (0)
#define SWRITE(b) do { *(bf16x8*)(V_lds + (b) * SHM_V + vst0) = vs0; *(bf16x8*)(V_lds + (b) * SHM_V + vst1) = vs1; int kc = sc * 2; \
    *(bf16x8*)(K_lds + (b) * SHM_K + AKSWZ(sr, kc)) = ks0; *(bf16x8*)(K_lds + (b) * SHM_K + AKSWZ(32 + sr, kc)) = ks1; \
    *(bf16x8*)(K_lds + (b) * SHM_K + AKSWZ(rr, 256 + rc * 2)) = kr0; } while (0)
#define SWAIT() asm volatile("s_waitcnt vmcnt(0)" ::: "memory")
#define RESC(a) do { if (__any((a) < 1.f)) { if (hi == 0) al_l[r32] = (a); asm volatile("s_waitcnt lgkmcnt(0)" ::: "memory"); \
    for (int d = 0; d < 4; ++d) for (int r = 0; r < 16; ++r) o[d][r] *= al_l[crow(r, hi)]; } } while (0)
  f32x16 pA0, pA1, pB0, pB1; float mnA, mnB, alA, alB; bf16x8 pa0, pa1, pa2, pa3; const int NT = seq / KVBLK;
  SLOAD(0); SWAIT(); SWRITE(0); __syncthreads();
  qkt(pA0, pA1, K_lds, qr, qrl, r32, hi); partialSM(pA0, pA1, m_reg, mnA, alA);
  SLOAD(KVBLK);
  SWAIT(); SWRITE(1); __syncthreads();
  for (int j = 1; j + 1 < NT; j += 2) {
    SBAR(); qkt(pB0, pB1, K_lds + SHM_K, qr, qrl, r32, hi);
    finishSM(pA0, pA1, alA, l_reg, pa0, pa1, pa2, pa3); SBAR();
    SLOAD((j + 1) * KVBLK); SBAR();
    pv_d0(o, vb0, pa0, pa1, pa2, pa3); partialSM(pB0, pB1, m_reg, mnB, alB);
    __syncthreads(); SWAIT(); SWRITE(0);
    RESC(alB); __syncthreads();
    SBAR(); qkt(pA0, pA1, K_lds, qr, qrl, r32, hi);
    finishSM(pB0, pB1, alB, l_reg, pa0, pa1, pa2, pa3); SBAR();
    SLOAD((j + 2) * KVBLK); SBAR();
    pv_d0(o, vb0 + SHM_V, pa0, pa1, pa2, pa3); partialSM(pA0, pA1, m_reg, mnA, alA);
    __syncthreads(); SWAIT(); SWRITE(1);
    RESC(alA); __syncthreads();
  }
  SBAR(); qkt(pB0, pB1, K_lds + SHM_K, qr, qrl, r32, hi);
  finishSM(pA0, pA1, alA, l_reg, pa0, pa1, pa2, pa3); SBAR();
  pv_d0(o, vb0, pa0, pa1, pa2, pa3); partialSM(pB0, pB1, m_reg, mnB, alB);
  __syncthreads(); RESC(alB);
  finishSM(pB0, pB1, alB, l_reg, pa0, pa1, pa2, pa3); SBAR();
  pv_d0(o, vb0 + SHM_V, pa0, pa1, pa2, pa3);
  if (hi == 0) li_l[r32] = l_reg; asm volatile("s_waitcnt lgkmcnt(0)" ::: "memory");
  float rli[16];
#pragma unroll
  for (int r = 0; r < 16; ++r) rli[r] = __builtin_amdgcn_rcpf(li_l[crow(r, hi)]);
  bf16_t* Ow = Ob + (long)(wid * QBLK) * LDO;
#pragma unroll
  for (int r = 0; r < 16; ++r) { int orow = crow(r, hi);
#pragma unroll
    for (int d0 = 0; d0 < 4; ++d0) Ow[(long)orow * LDO + d0 * 32 + r32] = f2bf(o[d0][r] * rli[r]); }
  __syncthreads();
#undef SLOAD
#undef SWRITE
#undef SWAIT
#undef RESC
}
}

namespace hy {
__device__ __forceinline__ c2 cmul(c2 a, c2 b) { return (c2){a.x * b.x - a.y * b.y, a.x * b.y + a.y * b.x}; }
__device__ __forceinline__ c2 cmulc(c2 a, c2 b) { return (c2){a.x * b.x + a.y * b.y, a.y * b.x - a.x * b.y}; }
__device__ __forceinline__ c2 twid(float fr) { return (c2){__builtin_amdgcn_cosf(fr), -__builtin_amdgcn_sinf(fr)}; }
__device__ __forceinline__ c2 mulW16(c2 x, int idx) {
    const float C1 = 0.9238795325112867f, S1 = 0.3826834323650898f, R = 0.7071067811865476f;
    switch (idx) {
        case 0: return x;
        case 1: return cmul(x, (c2){C1, -S1});
        case 2: return (c2){(x.x + x.y) * R, (x.y - x.x) * R};
        case 3: return cmul(x, (c2){S1, -C1});
        case 4: return (c2){x.y, -x.x};
        case 5: return cmul(x, (c2){-S1, -C1});
        case 6: return (c2){(x.y - x.x) * R, -(x.x + x.y) * R};
        default: return cmul(x, (c2){-C1, -S1});
    }
}
__device__ __forceinline__ c2 mulW16c(c2 x, int idx) { c2 t = mulW16((c2){x.x, -x.y}, idx); return (c2){t.x, -t.y}; }
template <int R, bool INV> __device__ __forceinline__ void bfly(c2 (&e)[R], c2 th0) {
    constexpr int r = (R == 16) ? 4 : 2;
    c2 th[4]; th[0] = th0; th[1] = cmul(th0, th0); th[2] = cmul(th[1], th[1]); th[3] = cmul(th[2], th[2]);
    if (!INV) {
#pragma unroll
        for (int k = 0; k < r; ++k) { const int half = R >> (k + 1);
#pragma unroll
            for (int a = 0; a < R; ++a) { if (a & half) continue; const int b = a + half;
                const c2 u = e[a], v = e[b]; e[a] = u + v; c2 d = u - v; d = mulW16(d, (a % half) * (8 / half)); e[b] = cmul(d, th[k]); } }
    } else {
#pragma unroll
        for (int k = r - 1; k >= 0; --k) { const int half = R >> (k + 1);
#pragma unroll
            for (int a = 0; a < R; ++a) { if (a & half) continue; const int b = a + half;
                c2 t = cmulc(e[b], th[k]); t = mulW16c(t, (a % half) * (8 / half)); const c2 u = e[a]; e[a] = u + t; e[b] = u - t; } }
    }
}
template <int R, bool INV, int S, int LS, int NSL> __device__ __forceinline__ void fft_pass(LAS c2* X, int seqstride, int nseq, int tid) {
    const int total = nseq << NSL;
    for (int g = tid; g < total; g += 512) {
        const int q = g >> NSL, sg = g & ((1 << NSL) - 1);
        const int j0 = sg & (S - 1), blk = sg >> LS, base = blk * R * S + j0;
        LAS c2* p = X + q * seqstride + base + (base >> 4);
        constexpr int sp = (S >= 16) ? S + (S >> 4) : S;
        c2 e[R];
#pragma unroll
        for (int a = 0; a < R; ++a) e[a] = p[a * sp];
        const c2 th0 = twid((float)j0 * (1.0f / (float)(R * S)));
        bfly<R, INV>(e, th0);
#pragma unroll
        for (int a = 0; a < R; ++a) p[a * sp] = e[a];
    }
    __syncthreads();
}
template <int LOGN> __device__ __forceinline__ void fft_fwd(LAS c2* X, int nseq, int tid) {
    constexpr int N = 1 << LOGN, SS = N + N / 16;
    if constexpr (LOGN == 14) fft_pass<4, false, 4096, 12, LOGN - 2>(X, SS, nseq, tid);
    fft_pass<16, false, 256, 8, LOGN - 4>(X, SS, nseq, tid);
    fft_pass<16, false, 16, 4, LOGN - 4>(X, SS, nseq, tid);
    fft_pass<16, false, 1, 0, LOGN - 4>(X, SS, nseq, tid);
}
template <int LOGN> __device__ __forceinline__ void fft_inv(LAS c2* X, int nseq, int tid) {
    constexpr int N = 1 << LOGN, SS = N + N / 16;
    fft_pass<16, true, 1, 0, LOGN - 4>(X, SS, nseq, tid);
    fft_pass<16, true, 16, 4, LOGN - 4>(X, SS, nseq, tid);
    fft_pass<16, true, 256, 8, LOGN - 4>(X, SS, nseq, tid);
    if constexpr (LOGN == 14) fft_pass<4, true, 4096, 12, LOGN - 2>(X, SS, nseq, tid);
}
template <int L> __device__ __forceinline__ float dw3(const bf16_t* u, int m, float w0, float w1, float w2, float b) {
    float x = bf2f(u[m]) * w1 + b; if (m > 0) x += bf2f(u[m - 1]) * w0; if (m < L - 1) x += bf2f(u[m + 1]) * w2; return x;
}
template <int LOGN> __device__ __forceinline__ void hyena_item(LAS c2* X, const bf16_t* UT, int Tg, const bf16_t* FT, bf16_t* ZT, int c,
                                                               const float* short_w, const float* short_b, const float* hy_skip, c2* KS, c2* YC, int tid) {
    constexpr int L = 1 << LOGN, NSEQ = (LOGN == 12) ? 2 : 1, NPT = L / 512, SS = L + L / 16;
    const float invL2 = 0.5f / (float)L, inv2L = 0.5f / (float)L;
    const bf16_t* u1 = UT + (size_t)c * Tg; const bf16_t* u2 = UT + (size_t)(1024 + c) * Tg; const bf16_t* uv = UT + (size_t)(2048 + c) * Tg;
    bf16_t* zt = ZT + (size_t)c * Tg;
    const float v0 = short_w[2048 + c], v1 = short_w[3072 + 2048 + c], v2 = short_w[6144 + 2048 + c], vb = short_b[2048 + c];
    for (int n = 0; n < 2; ++n) {
        const bf16_t* hf = FT + (size_t)(n * 1024 + c) * L; const bf16_t* hb = FT + (size_t)((2 + n) * 1024 + c) * L;
        const float skip = hy_skip[n * 1024 + c];
        const bf16_t* ug = n ? u2 : u1; const int gr = n ? 1024 + c : c;
        const float g0 = short_w[gr], g1 = short_w[3072 + gr], g2 = short_w[6144 + gr], gb = short_b[gr];
#pragma unroll 4
        for (int i = 0; i < NPT; ++i) { const int m = tid + 512 * i; const float f = bf2f(hf[m]); const float b = m ? bf2f(hb[L - m]) : 0.f; X[m + (m >> 4)] = (c2){f + b, 0.f}; }
        __syncthreads(); fft_fwd<LOGN>(X, 1, tid);
#pragma unroll 4
        for (int i = 0; i < NPT; ++i) { const int m = tid + 512 * i; KS[m] = X[m + (m >> 4)]; }
        __syncthreads();
        for (int q = 0; q < NSEQ; ++q)
#pragma unroll 2
            for (int i = 0; i < NPT; ++i) { const int m = tid + 512 * i; const int oA = (2 * q) * L, oB = (2 * q + 1) * L; c2 z;
                if (n == 0) { z.x = dw3<L>(uv + oA, m, v0, v1, v2, vb); z.y = dw3<L>(uv + oB, m, v0, v1, v2, vb); } else { z.x = bf2f(zt[oA + m]); z.y = bf2f(zt[oB + m]); }
                X[q * SS + m + (m >> 4)] = z; }
        __syncthreads(); fft_fwd<LOGN>(X, NSEQ, tid);
        for (int q = 0; q < NSEQ; ++q)
#pragma unroll 4
            for (int i = 0; i < NPT; ++i) { const int m = tid + 512 * i; const int p = q * SS + m + (m >> 4); X[p] = cmul(X[p], KS[m]); }
        __syncthreads(); fft_inv<LOGN>(X, NSEQ, tid);
        for (int q = 0; q < NSEQ; ++q)
#pragma unroll 4
            for (int i = 0; i < NPT; ++i) { const int m = tid + 512 * i; YC[q * L + m] = X[q * SS + m + (m >> 4)]; }
        __syncthreads();
#pragma unroll 4
        for (int i = 0; i < NPT; ++i) { const int m = tid + 512 * i; const float f = bf2f(hf[m]); const float b = m ? bf2f(hb[L - m]) : 0.f;
            X[m + (m >> 4)] = twid((float)m * inv2L) * (f - b); }
        __syncthreads(); fft_fwd<LOGN>(X, 1, tid);
#pragma unroll 4
        for (int i = 0; i < NPT; ++i) { const int m = tid + 512 * i; KS[m] = X[m + (m >> 4)]; }
        __syncthreads();
        for (int q = 0; q < NSEQ; ++q)
#pragma unroll 2
            for (int i = 0; i < NPT; ++i) { const int m = tid + 512 * i; const int oA = (2 * q) * L, oB = (2 * q + 1) * L; c2 z;
                if (n == 0) { z.x = dw3<L>(uv + oA, m, v0, v1, v2, vb); z.y = dw3<L>(uv + oB, m, v0, v1, v2, vb); } else { z.x = bf2f(zt[oA + m]); z.y = bf2f(zt[oB + m]); }
                X[q * SS + m + (m >> 4)] = cmul(z, twid((float)m * inv2L)); }
        __syncthreads(); fft_fwd<LOGN>(X, NSEQ, tid);
        for (int q = 0; q < NSEQ; ++q)
#pragma unroll 4
            for (int i = 0; i < NPT; ++i) { const int m = tid + 512 * i; const int p = q * SS + m + (m >> 4); X[p] = cmul(X[p], KS[m]); }
        __syncthreads(); fft_inv<LOGN>(X, NSEQ, tid);
        for (int q = 0; q < NSEQ; ++q)
#pragma unroll 2
            for (int i = 0; i < NPT; ++i) { const int m = tid + 512 * i; const int oA = (2 * q) * L, oB = (2 * q + 1) * L; c2 z;
                if (n == 0) { z.x = dw3<L>(uv + oA, m, v0, v1, v2, vb); z.y = dw3<L>(uv + oB, m, v0, v1, v2, vb); } else { z.x = bf2f(zt[oA + m]); z.y = bf2f(zt[oB + m]); }
                const c2 yn = X[q * SS + m + (m >> 4)];
                c2 y = (YC[q * L + m] + cmulc(yn, twid((float)m * inv2L))) * invL2 + z * skip;
                const float gA = dw3<L>(ug + oA, m, g0, g1, g2, gb), gB = dw3<L>(ug + oB, m, g0, g1, g2, gb);
                zt[oA + m] = f2bf(y.x * gA); zt[oB + m] = f2bf(y.y * gB); }
        __syncthreads();
    }
}
}

__device__ __forceinline__ int colmap(int mode, int n) {
    if (mode == 0) return n;
    if (mode == 1) {
        if (n >= 2816) return 704 + (n - 2816);
        if (n < 640) return n;
        if (n < 704) { const int j = n - 640; return 640 + (j >> 1) + 32 * (j & 1); }
        if (n < 2752) return 3776 + (n - 704);
        return -1;
    }
    if (n < 1024) return (n >> 7) * 192 + (n & 127);
    { const int h = (n - 1024) >> 6, j = (n - 1024) & 63; return h * 192 + 128 + (j >> 1) + 32 * (j & 1); }
}
__device__ __forceinline__ void wtrans(float* tile  , const float* src, int ld, int K, int dstN, bf16_t* dst, int mode, const float* scale, int tid) {
    const int tk = K / 64, ntiles = (dstN / 64) * tk;
    for (int t = blockIdx.x; t < ntiles; t += gridDim.x) {
        const int n0 = (t / tk) * 64, k0 = (t % tk) * 64;
        { const int nn = tid & 63, col = colmap(mode, n0 + nn);
#pragma unroll
          for (int i = 0; i < 8; ++i) { const int kk = (tid >> 6) + 8 * i; float v = 0.f; if (col >= 0) { v = src[(size_t)(k0 + kk) * ld + col]; if (scale) v *= scale[k0 + kk]; } tile[kk * 65 + nn] = v; } }
        __syncthreads();
        { const int kk = tid & 63;
#pragma unroll
          for (int i = 0; i < 8; ++i) { const int nn = (tid >> 6) + 8 * i; dst[(size_t)(n0 + nn) * K + k0 + kk] = f2bf(tile[kk * 65 + nn]); } }
        __syncthreads();
    }
}
__device__ __forceinline__ void cvt_rows(const float* src, bf16_t* dst, size_t n8, int gtid, int gthreads) {
    for (size_t i = gtid; i < n8; i += gthreads) { const f32x4 a = *(const f32x4*)(src + i * 8), b = *(const f32x4*)(src + i * 8 + 4); st8(dst + i * 8, a, b); }
}
__device__ __forceinline__ float wsum(float v) { v += __shfl_xor(v, 1); v += __shfl_xor(v, 2); v += __shfl_xor(v, 4); v += __shfl_xor(v, 8); v += __shfl_xor(v, 16); v += __shfl_xor(v, 32); return v; }
__device__ __forceinline__ void ln_rows(float* Y, const float* g, const float* b, bf16_t* Xb, int nrows, int tid) {
    const int wid = tid >> 6, lane = tid & 63;
    f32x4 gv[4], bv[4];
#pragma unroll
    for (int k = 0; k < 4; ++k) { gv[k] = *(const f32x4*)(g + k * 256 + lane * 4); bv[k] = *(const f32x4*)(b + k * 256 + lane * 4); }
    for (int row = blockIdx.x * 8 + wid; row < nrows; row += gridDim.x * 8) {
        float* y = Y + (size_t)row * 1024; f32x4 v[4]; float s = 0.f;
#pragma unroll
        for (int k = 0; k < 4; ++k) { v[k] = *(const f32x4*)(y + k * 256 + lane * 4); s += (v[k][0] + v[k][1]) + (v[k][2] + v[k][3]); }
        const float mean = wsum(s) * (1.0f / 1024.0f); float q = 0.f;
#pragma unroll
        for (int k = 0; k < 4; ++k) { v[k] = v[k] - mean; q += (v[k][0] * v[k][0] + v[k][1] * v[k][1]) + (v[k][2] * v[k][2] + v[k][3] * v[k][3]); }
        const float rstd = rsqrtf(wsum(q) * (1.0f / 1024.0f) + LN_EPS);
#pragma unroll
        for (int k = 0; k < 4; ++k) { const f32x4 o = v[k] * rstd * gv[k] + bv[k]; *(f32x4*)(y + k * 256 + lane * 4) = o;
            if (Xb) { unsigned w0 = pk(o[0], o[1]), w1 = pk(o[2], o[3]); *(uint2*)(Xb + (size_t)row * 1024 + k * 256 + lane * 4) = make_uint2(w0, w1); } }
    }
}
__device__ __forceinline__ void ffn_mid(const bf16_t* AB, bf16_t* HM, const float* dw_w, const float* dw_b, int seqmask, int gtid, int gthreads) {
    typedef float f32x2 __attribute__((ext_vector_type(2)));
    for (int idx = gtid; idx < TC * 352; idx += gthreads) {
        const int row = idx / 352, col = (idx % 352) * 8, pos = row & seqmask;
        const bf16_t* p = AB + (size_t)row * 5632 + col;
        f32x4 a0a = {0.f, 0.f, 0.f, 0.f}, a0b = a0a, a2a = a0a, a2b = a0a, a1a, a1b, ga, gb;
        ld8(p, a1a, a1b); ld8(p + 2816, ga, gb);
        if (pos > 0) ld8(p - 5632, a0a, a0b);
        if (pos < seqmask) ld8(p + 5632, a2a, a2b);
        const f32x4 w0a = *(const f32x4*)(dw_w + col), w0b = *(const f32x4*)(dw_w + col + 4), w1a = *(const f32x4*)(dw_w + 2816 + col), w1b = *(const f32x4*)(dw_w + 2816 + col + 4),
                    w2a = *(const f32x4*)(dw_w + 5632 + col), w2b = *(const f32x4*)(dw_w + 5632 + col + 4), ba = *(const f32x4*)(dw_b + col), bb = *(const f32x4*)(dw_b + col + 4);
        f32x4 ta = a0a * w0a + a1a * w1a + a2a * w2a + ba, tb = a0b * w0b + a1b * w1b + a2b * w2b + bb;
        const f32x2 r0 = pg8::gelu_pk((f32x2){ta[0], ta[1]}), r1 = pg8::gelu_pk((f32x2){ta[2], ta[3]}), r2 = pg8::gelu_pk((f32x2){tb[0], tb[1]}), r3 = pg8::gelu_pk((f32x2){tb[2], tb[3]});
        ta = (f32x4){r0.x, r0.y, r1.x, r1.y} * ga; tb = (f32x4){r2.x, r2.y, r3.x, r3.y} * gb;
        st8(HM + (size_t)row * 2816 + col, ta, tb);
    }
}
__device__ __forceinline__ void transpose_z(LAS bf16_t* tile  , const bf16_t* ZT, bf16_t* Z, int Tg, int tid) {
    const int tt = Tg / 64, ntiles = 16 * tt;
    for (int t = blockIdx.x; t < ntiles; t += gridDim.x) {
        const int c0 = (t / tt) * 64, t0 = (t % tt) * 64;
        { const int cc = tid >> 3, t8 = (tid & 7) * 8; const u32x4 w = *(const u32x4*)(ZT + (size_t)(c0 + cc) * Tg + t0 + t8);
          tile[(t8 + 0) * 72 + cc] = (bf16_t)(w.x & 0xffff); tile[(t8 + 1) * 72 + cc] = (bf16_t)(w.x >> 16); tile[(t8 + 2) * 72 + cc] = (bf16_t)(w.y & 0xffff); tile[(t8 + 3) * 72 + cc] = (bf16_t)(w.y >> 16);
          tile[(t8 + 4) * 72 + cc] = (bf16_t)(w.z & 0xffff); tile[(t8 + 5) * 72 + cc] = (bf16_t)(w.z >> 16); tile[(t8 + 6) * 72 + cc] = (bf16_t)(w.w & 0xffff); tile[(t8 + 7) * 72 + cc] = (bf16_t)(w.w >> 16); }
        __syncthreads();
        { const int r = tid >> 3, c8 = (tid & 7) * 8; const u32x4 w = *(const LAS u32x4*)(tile + r * 72 + c8); *(u32x4*)(Z + (size_t)(t0 + r) * 1024 + c0 + c8) = w; }
        __syncthreads();
    }
}

struct Params { const float* in[27]; float* out; unsigned char* ws; int lo, hi; };

__device__ __forceinline__ void prologue(const Params& P, unsigned char* smem, int tid) {
    unsigned char* ws = P.ws; float* tile = (float*)smem;
    const int gtid = blockIdx.x * 512 + tid, gthreads = gridDim.x * 512;
    wtrans(tile, P.in[2], 5824, 1024, 5888, (bf16_t*)(ws + WS_WIN), 1, nullptr, tid);
    wtrans(tile, P.in[6], 1536, 384, 1536, (bf16_t*)(ws + WS_WUQ), 2, P.in[5], tid);
    wtrans(tile, P.in[8], 2048, 256, 2048, (bf16_t*)(ws + WS_WUKV), 0, P.in[7], tid);
    wtrans(tile, P.in[9], 1024, 1024, 1024, (bf16_t*)(ws + WS_WOMLA), 0, nullptr, tid);
    wtrans(tile, P.in[17], 1024, 1024, 1024, (bf16_t*)(ws + WS_WOHY), 0, nullptr, tid);
    wtrans(tile, P.in[18], 1024, 1024, 1024, (bf16_t*)(ws + WS_WOUT), 0, nullptr, tid);
    wtrans(tile, P.in[21], 5632, 1024, 5632, (bf16_t*)(ws + WS_WUP), 0, nullptr, tid);
    wtrans(tile, P.in[24], 1024, 2816, 1024, (bf16_t*)(ws + WS_WDOWN), 0, nullptr, tid);
    { bf16_t* W3B = (bf16_t*)(ws + WS_W3B); const float* w3 = P.in[15];
      for (int i = gtid; i < 4096 * 128; i += gthreads) { const int k = i >> 12, o = i & 4095; W3B[o * 128 + k] = f2bf(w3[(k & 63) * 4096 + o]); } }
    cvt_rows(P.in[0], (bf16_t*)(P.out + (size_t)1 * TC * 1024), (size_t)TC * 1024 / 8, gtid, gthreads);
    cvt_rows(P.in[1], (bf16_t*)(P.out + (size_t)2 * TC * 1024), (size_t)2 * TC * 1024 / 8, gtid, gthreads);
    { float* cosT = (float*)(ws + WS_COS); float* sinT = (float*)(ws + WS_SIN);
      for (int i = gtid; i < 16384 * 32; i += gthreads) { const int pos = i >> 5, k = i & 31; const float inv = powf(10000.0f, -(float)(2 * k) / 64.0f); const float ang = (float)pos * inv;
          cosT[i] = cosf(ang); sinT[i] = sinf(ang); } }
    { float* ssq = (float*)(ws + WS_SSQ); for (int i = gtid; i < 3 * TC * 2; i += gthreads) ssq[i] = 0.f; }
    { bf16_t* H2B = (bf16_t*)(ws + WS_H2B); const float *w1 = P.in[10], *b1 = P.in[11], *fq = P.in[12], *w2 = P.in[13], *b2 = P.in[14];
      const int wid = tid >> 6, lane = tid & 63; const float fr = fq[lane];
      for (int row = blockIdx.x * 8 + wid; row < 20480; row += gridDim.x * 8) {
          const int L = row < 4096 ? 4096 : 16384, m = row < 4096 ? row : row - 4096;
          const float t = (float)m / (float)(L - 1); const int kb = lane & 15;
          const float band = 1e-4f + (float)kb * ((15.0f - 1e-4f) / 15.0f); const float a0 = (6.283185307179586f * (float)m) / (float)L; const float ang = a0 * band;
          const float cv = cosf(ang), sv = -sinf(ang);
          float acc = b1[lane] + t * w1[lane];
#pragma unroll
          for (int k = 0; k < 16; ++k) { acc += __shfl(cv, k) * w1[(1 + k) * 64 + lane]; acc += __shfl(sv, k) * w1[(17 + k) * 64 + lane]; }
          const float h1 = sinf(fr * acc);
          float acc2 = b2[lane];
#pragma unroll 8
          for (int k = 0; k < 64; ++k) acc2 += __shfl(h1, k) * w2[k * 64 + lane];
          const float h2 = sinf(fr * acc2);
          const bf16_t hi = f2bf(h2); H2B[(size_t)row * 128 + lane] = hi; H2B[(size_t)row * 128 + 64 + lane] = f2bf(h2 - bf2f(hi));
      } }
}

__global__ void __launch_bounds__(512, 2) mega(Params P) {
    extern __shared__ __attribute__((aligned(16))) unsigned char smem[];
    cg::grid_group grid = cg::this_grid();
    PG8_LAS unsigned char* lds = (PG8_LAS unsigned char*)smem;
    unsigned char* ws = P.ws; const int lo = P.lo, hi = P.hi;
    const int gthreads = gridDim.x * 512;
    int ph = 0;
#define PH_BEGIN if (ph >= lo && ph < hi) { int tid = threadIdx.x; asm volatile("" : "+v"(tid)); const int gtid = blockIdx.x * 512 + tid;
#define PH_END } ++ph; if (ph > lo && ph < hi) grid.sync();
    const float* cosT = (const float*)(ws + WS_COS); const float* sinT = (const float*)(ws + WS_SIN);
    bf16_t* WIN = (bf16_t*)(ws + WS_WIN);
    PH_BEGIN
#if EN_PRO
 prologue(P, smem, tid);
#endif
 PH_END
    for (int g = 0; g < 2; ++g) {
        const int L = g ? 16384 : 4096, Tg = g ? 2 * TC : TC, seqmask = L - 1;
        const bf16_t* xb = (const bf16_t*)(P.out + (size_t)(g ? 2 : 1) * TC * 1024);
        const bf16_t* H2 = (const bf16_t*)(ws + WS_H2B) + (g ? (size_t)4096 * 128 : 0);
        bf16_t* UT = (bf16_t*)(ws + WS_UT); bf16_t* FT = (bf16_t*)(ws + WS_FT); bf16_t* ZT = (bf16_t*)(ws + WS_ZT); bf16_t* Z = (bf16_t*)(ws + WS_Z);
        PH_BEGIN
            run_gemm<0>(lds, (const bf16_t*)(ws + WS_W3B), H2, 4096, L, 128, FFilt{FT, L});
            run_gemm<1>(lds, WIN + (size_t)2816 * 1024, xb, 3072, Tg, 1024, FBf{UT, (size_t)Tg});
        PH_END
        PH_BEGIN
            for (int c = blockIdx.x; c < 1024; c += gridDim.x) {
                c2* KS = (c2*)(P.out + (size_t)(g ? 1 : 0) * TC * 1024) + (size_t)blockIdx.x * 32768; c2* YC = KS + 16384;
#if EN_HY14
                if (g) hy::hyena_item<14>((LAS c2*)smem, UT, Tg, FT, ZT, c, P.in[3], P.in[4], P.in[16], KS, YC, tid);
#endif
#if EN_HY12
                if (!g) hy::hyena_item<12>((LAS c2*)smem, UT, Tg, FT, ZT, c, P.in[3], P.in[4], P.in[16], KS, YC, tid);
#endif
            }
        PH_END
        for (int ck = 0; ck < (g ? 2 : 1); ++ck) {
            const int chunk = g ? 1 + ck : 0;
            const bf16_t* xbc = xb + (size_t)ck * TC * 1024;
            const float* xin = g ? P.in[1] + (size_t)ck * TC * 1024 : P.in[0];
            float* Y = P.out + (size_t)chunk * TC * 1024;
            float* ssq = (float*)(ws + WS_SSQ) + (size_t)chunk * TC * 2;
            bf16_t *CQ = (bf16_t*)(ws + WS_CQ), *CKV = (bf16_t*)(ws + WS_CKV), *KR = (bf16_t*)(ws + WS_KR), *G = (bf16_t*)(ws + WS_G), *Q = (bf16_t*)(ws + WS_Q), *KV = (bf16_t*)(ws + WS_KV),
                   *O = (bf16_t*)(ws + WS_O), *MG = (bf16_t*)(ws + WS_MG), *X1B = (bf16_t*)(ws + WS_X1B), *HM = (bf16_t*)(ws + WS_HM), *AB = (bf16_t*)(ws + WS_AB);
            PH_BEGIN
                if (ck == 0) transpose_z((LAS bf16_t*)smem, ZT, Z, Tg, tid);
                run_gemm<2>(lds, xbc, WIN, TC, 2816, 1024, FTm{CQ, CKV, KR, G, ssq, cosT, sinT, seqmask});
            PH_END
            PH_BEGIN
                run_gemm<3>(lds, CQ, (const bf16_t*)(ws + WS_WUQ), TC, 1536, 384, FQ{Q, ssq, cosT, sinT, seqmask});
                run_gemm<4>(lds, CKV, (const bf16_t*)(ws + WS_WUKV), TC, 2048, 256, FKV{KV, ssq});
            PH_END
            PH_BEGIN
                const int nqb = L / 256;
                for (int i = blockIdx.x; i < 512; i += gridDim.x) {
                    const int h = i & 7, combo = i >> 3, b = combo / nqb, qb = combo % nqb;
                    const size_t r0 = (size_t)b * L;
#if EN_ATT
                    att::attn_unit(Q + (r0 + (size_t)qb * 256) * 1536, KV + r0 * 2048 + h * 256, KV + r0 * 2048 + h * 256 + 128, KR + r0 * 64,
                                   O + (r0 + (size_t)qb * 256) * 1024 + h * 128, L, (char*)smem, h);
#endif
                }
            PH_END
            PH_BEGIN
                run_gemm<5>(lds, Z + (size_t)ck * TC * 1024, (const bf16_t*)(ws + WS_WOHY), TC, 1024, 1024, FM1{MG, G});
                run_gemm<6>(lds, O, (const bf16_t*)(ws + WS_WOMLA), TC, 1024, 1024, FM2{MG, G});
            PH_END
            PH_BEGIN
                run_gemm<7>(lds, MG, (const bf16_t*)(ws + WS_WOUT), TC, 1024, 1024, FOut{Y, xin});
            PH_END
            PH_BEGIN ln_rows(Y, P.in[19], P.in[20], X1B, TC, tid); PH_END
            PH_BEGIN
                run_gemm<8>(lds, X1B, (const bf16_t*)(ws + WS_WUP), TC, 5632, 1024, FBf{AB, (size_t)5632});
            PH_END
            PH_BEGIN ffn_mid(AB, HM, P.in[22], P.in[23], seqmask, gtid, gthreads); PH_END
            PH_BEGIN
                run_gemm<9>(lds, HM, (const bf16_t*)(ws + WS_WDOWN), TC, 1024, 2816, FDown{Y});
            PH_END
            PH_BEGIN ln_rows(Y, P.in[25], P.in[26], nullptr, TC, tid); PH_END
        }
    }
}
constexpr int N_PHASES = 1 + 2 * 2 + 3 * 10;

extern "C" void kernel_launch(void* const* d_in, const int* in_sizes, int n_in, void* d_out, int out_size, void* d_ws, size_t ws_size, hipStream_t stream) {
    static int grid = 0;
    if (grid == 0) {
        if (n_in != 27 || out_size != 3 * TC * 1024 || ws_size < WS_END) { fprintf(stderr, "kernel_launch: unexpected shapes: n_in %d out %d ws %zu\n", n_in, out_size, ws_size); grid = -1; return; }
        int dev = 0, cus = 0, per_cu = 0;
        hipGetDevice(&dev); hipDeviceGetAttribute(&cus, hipDeviceAttributeMultiprocessorCount, dev);
        if (hipFuncSetAttribute((const void*)mega, hipFuncAttributeMaxDynamicSharedMemorySize, LDS_BYTES) != hipSuccess) { fprintf(stderr, "kernel_launch: hipFuncSetAttribute failed\n"); grid = -1; return; }
        if (hipOccupancyMaxActiveBlocksPerMultiprocessor(&per_cu, (const void*)mega, 512, LDS_BYTES) != hipSuccess || per_cu < 1) { fprintf(stderr, "kernel_launch: occupancy query says %d\n", per_cu); per_cu = 1; }
        (void)hipGetLastError();
        grid = cus * per_cu;
    }
    if (grid < 0) return;
    Params p{};
    for (int i = 0; i < 27; ++i) p.in[i] = (const float*)d_in[i];
    p.out = (float*)d_out; p.ws = (unsigned char*)d_ws;
#if MK_MULTI
    for (int i = 0; i < N_PHASES; ++i) { p.lo = i; p.hi = i + 1; hipLaunchKernelGGL(mega, dim3(grid), dim3(512), LDS_BYTES, stream, p); }
#else
    p.lo = 0; p.hi = N_PHASES;
    void* args[] = {&p};
    hipError_t e = hipLaunchCooperativeKernel((void*)mega, dim3(grid), dim3(512), args, LDS_BYTES, stream);
    if (e != hipSuccess) fprintf(stderr, "cooperative launch failed: %s (grid %d)\n", hipGetErrorString(e), grid);
#endif
}
```

```cpp
#include <hip/hip_runtime.h>
#include <hip/hip_cooperative_groups.h>
#include <cstdio>
#include <cstdint>
namespace cg = cooperative_groups;
namespace pg8 {
#define PG8_LAS __attribute__((address_space(3)))
typedef unsigned short bf16_t;
typedef short bf16x8 __attribute__((ext_vector_type(8)));
typedef float f32x4 __attribute__((ext_vector_type(4)));
typedef unsigned u32x4 __attribute__((ext_vector_type(4)));
constexpr int BM = 256, BK = 64, HALF = 128, HTB = HALF * BK * 2  , STAGE_BYTES = 8 * HTB, NXCD = 8, WGM = 8;

__host__ __device__ __forceinline__ int lds_byte(int r, int c) { const int st = (r >> 4) * 2 + (c >> 5), rr = r & 15, cc = c & 31, ob = rr * 64 + cc * 2; return st * 1024 + (ob ^ (((ob >> 9) & 1) << 5)); }
__host__ __device__ __forceinline__ void stage_rc(int b, int& R, int& C) { const int st = b / 1024, sb = b % 1024, swz = sb ^ (((sb >> 9) & 1) << 5); R = (st >> 1) * 16 + swz / 64; C = (st & 1) * 32 + (swz % 64) / 2; }
__host__ __device__ __forceinline__ int perm32(int rho) { const int n = rho >> 4, i = rho & 15; return 8 * (i >> 2) + 4 * n + (i & 3); }

struct Unit { int pm, pn; };
struct Gemm { const bf16_t* A; const bf16_t* Bt; int M, N, K; };

struct StaticOrder {
    int nM, nN, nwg, G, c;
    __host__ __device__ void init(int M, int N, int G_, int c_) { nM = M / BM; nN = N / BM; nwg = nM * nN; G = G_; c = c_; }
    __host__ __device__ bool next(int i, Unit& u) const {
        const long L = (long)i * G + c; if (L >= nwg) return false;
        int wgid = (int)L; { const int q = nwg / NXCD, r = nwg % NXCD, xcd = wgid % NXCD, off = wgid / NXCD; wgid = (xcd < r ? xcd * (q + 1) : r * (q + 1) + (xcd - r) * q) + off; }
        const int nig = WGM * nN, gid = wgid / nig, fm = gid * WGM, gsz = (nM - fm) < WGM ? (nM - fm) : WGM;
        u.pm = fm + ((wgid % nig) % gsz); u.pn = (wgid % nig) / gsz; return true;
    }
    __device__ __forceinline__ void a_ready(const Unit&) const {}
    __device__ __forceinline__ void done(const Unit&) const {}
};

__device__ __forceinline__ unsigned cvt_pk_bf16(float lo, float hi) { unsigned r; asm volatile("v_cvt_pk_bf16_f32 %0, %1, %2" : "=v"(r) : "v"(lo), "v"(hi)); return r; }
typedef float f32x2 __attribute__((ext_vector_type(2)));
__device__ __forceinline__ f32x2 gelu_pk(f32x2 v) {
    const f32x2 av = __builtin_elementwise_abs(v), d = av * 0.2316418882f + 1.0f;
    f32x2 t; t.x = __builtin_amdgcn_rcpf(d.x); t.y = __builtin_amdgcn_rcpf(d.y);
    f32x2 q = t * 0.5307027145f + (-0.7265760135f); q = q * t + 0.7107068705f; q = q * t + (-0.142248368f); q = q * t + 0.127414796f; q = q * t;
    const f32x2 s = (v * v) * (-0.72134752044f);
    f32x2 e; e.x = __builtin_amdgcn_exp2f(s.x); e.y = __builtin_amdgcn_exp2f(s.y);
    const f32x2 m = v * (q * e), r = v - m;
    f32x2 o; o.x = v.x < 0.f ? m.x : r.x; o.y = v.y < 0.f ? m.y : r.y; return o;
}
template <class Epi, class Sched, bool ALIGN_EPI = false, bool SP2 = false>
__device__ __forceinline__ void gemm_phase(PG8_LAS unsigned char* lds, const Gemm g, const Sched& S, const Epi& E) {
    int tid = threadIdx.x; asm volatile("" : "+v"(tid));
    const int wid = __builtin_amdgcn_readfirstlane(tid >> 6), lane = tid & 63, wr = wid >> 2, wc = wid & 3, fr = lane & 15, fq = lane >> 4;
    const int K = g.K, nt = K / BK;
    unsigned voffA[2], voffB[2];
#pragma unroll
    for (int i = 0; i < 2; ++i) { int R, C; stage_rc(tid * 16 + i * 8192, R, C); const int Rb = Epi::PERM ? ((R & ~31) + perm32(R & 31)) : R;
        voffA[i] = (unsigned)(R * K + C) * 2u; voffB[i] = (unsigned)(Rb * K + C) * 2u; }
    const size_t kstep = (size_t)(BK * 2);
    const size_t hstep = (size_t)HALF * K * 2;
    const size_t tstep = 2 * hstep;
    const unsigned ldsw = (unsigned)wid * 1024u;
    const int aoff = lds_byte(wr * 64 + fr, fq * 8), boff = lds_byte(wc * 32 + fr, fq * 8);
#define PG8_SA(b, h) (((b) * 2 + (h)) * HTB)
#define PG8_SB(b, h) ((4 + (b) * 2 + (h)) * HTB)
#define PG8_STAGE(bufoff, gbase, voff) do { _Pragma("unroll") for (int _i = 0; _i < 2; ++_i) \
        __builtin_amdgcn_global_load_lds((const unsigned*)((const char*)(gbase) + (voff)[_i]), (PG8_LAS unsigned*)(lds + (bufoff) + ldsw + _i * 8192), 16, 0, 0); } while (0)
#define PG8_LDA(dst, b, h) do { _Pragma("unroll") for (int m = 0; m < 4; ++m) _Pragma("unroll") for (int k = 0; k < 2; ++k) dst[m][k] = *(const PG8_LAS bf16x8*)(lds + PG8_SA(b, h) + aoff + m * 2048 + k * 1024); } while (0)
#define PG8_LDB(dst, b, h) do { _Pragma("unroll") for (int n = 0; n < 2; ++n) _Pragma("unroll") for (int k = 0; k < 2; ++k) dst[n][k] = *(const PG8_LAS bf16x8*)(lds + PG8_SB(b, h) + boff + n * 2048 + k * 1024); } while (0)
#define PG8_MMA(ai, bj, At, Bt) do { __builtin_amdgcn_s_setprio(1); _Pragma("unroll") for (int m = 0; m < 4; ++m) _Pragma("unroll") for (int n = 0; n < 2; ++n) _Pragma("unroll") for (int k = 0; k < 2; ++k) \
        acc[ai][bj][m][n] = __builtin_amdgcn_mfma_f32_16x16x32_bf16(Bt[n][k], At[m][k], acc[ai][bj][m][n], 0, 0, 0); __builtin_amdgcn_s_setprio(0); } while (0)
#define PG8_WAIT_V(n) asm volatile("s_waitcnt vmcnt(" #n ")" ::: "memory")
#define PG8_WAIT_L(n) asm volatile("s_waitcnt lgkmcnt(" #n ")" ::: "memory")
#define PG8_BAR __builtin_amdgcn_s_barrier()
#define PG8_SCHED __builtin_amdgcn_sched_barrier(0)
    Unit cur, nxt; int ui = 0;
    if (!S.next(0, cur)) return;
    f32x4 acc[2][2][4][2];
#pragma unroll
    for (int a = 0; a < 2; ++a)
#pragma unroll
        for (int b = 0; b < 2; ++b)
#pragma unroll
            for (int m = 0; m < 4; ++m)
#pragma unroll
                for (int n = 0; n < 2; ++n) acc[a][b][m][n] = (f32x4){0.f, 0.f, 0.f, 0.f};
    bf16x8 At[4][2], B0[2][2], B1[2][2];
    const char* cA = (const char*)g.A + (size_t)cur.pm * tstep; const char* cB = (const char*)g.Bt + (size_t)cur.pn * tstep;
    S.a_ready(cur);
    if constexpr (SP2) {
        PG8_STAGE(PG8_SB(0, 0), cB, voffB); PG8_STAGE(PG8_SB(0, 1), cB + hstep, voffB); PG8_STAGE(PG8_SA(0, 0), cA, voffA); PG8_STAGE(PG8_SA(0, 1), cA + hstep, voffA);
        if (wr == 1) PG8_BAR;
        PG8_WAIT_V(2); PG8_BAR;
        PG8_STAGE(PG8_SB(1, 0), cB + kstep, voffB); PG8_STAGE(PG8_SA(1, 0), cA + kstep, voffA); PG8_STAGE(PG8_SB(1, 1), cB + hstep + kstep, voffB);
        PG8_WAIT_V(6); PG8_BAR;
    } else {
        PG8_STAGE(PG8_SB(0, 0), cB, voffB); PG8_STAGE(PG8_SA(0, 0), cA, voffA); PG8_STAGE(PG8_SB(0, 1), cB + hstep, voffB); PG8_STAGE(PG8_SA(0, 1), cA + hstep, voffA);
        if (wr == 1) PG8_BAR;
        PG8_WAIT_V(4); PG8_BAR;
        PG8_STAGE(PG8_SB(1, 0), cB + kstep, voffB); PG8_STAGE(PG8_SA(1, 0), cA + kstep, voffA); PG8_STAGE(PG8_SB(1, 1), cB + hstep + kstep, voffB);
        PG8_WAIT_V(6); PG8_BAR;
    }
    for (;;) {
        const bool has_next = S.next(ui + 1, nxt);
        const char* nA = has_next ? (const char*)g.A + (size_t)nxt.pm * tstep : cA; const char* nB = has_next ? (const char*)g.Bt + (size_t)nxt.pn * tstep : cB;
        for (int t = 0; t < nt; t += 2) {
            const bool last = (t == nt - 2);
            const char* a1 = cA + (size_t)(t + 1) * kstep;
            const char* a2 = last ? nA : cA + (size_t)(t + 2) * kstep; const char* b2 = last ? nB : cB + (size_t)(t + 2) * kstep;
            const char* a3 = a2 + kstep; const char* b3 = b2 + kstep;
            if (last && has_next) S.a_ready(nxt);
            if constexpr (SP2) {
            PG8_LDB(B0, 0, 0); PG8_LDB(B1, 0, 1); PG8_SCHED; PG8_LDA(At, 0, 0); PG8_STAGE(PG8_SA(1, 1), a1 + hstep, voffA);
            PG8_WAIT_V(8); PG8_WAIT_L(0); PG8_BAR; PG8_MMA(0, 0, At, B0); PG8_MMA(0, 1, At, B1); PG8_BAR; PG8_SCHED;
            PG8_LDA(At, 0, 1); PG8_STAGE(PG8_SB(0, 0), b2, voffB); PG8_STAGE(PG8_SB(0, 1), b2 + hstep, voffB); PG8_STAGE(PG8_SA(0, 0), a2, voffA);
            PG8_WAIT_V(8); PG8_WAIT_L(0); PG8_BAR; PG8_MMA(1, 0, At, B0); PG8_MMA(1, 1, At, B1); PG8_BAR; PG8_SCHED;
            PG8_LDB(B0, 1, 0); PG8_LDB(B1, 1, 1); PG8_SCHED; PG8_LDA(At, 1, 0); PG8_STAGE(PG8_SA(0, 1), a2 + hstep, voffA);
            PG8_WAIT_V(8); PG8_WAIT_L(0); PG8_BAR; PG8_MMA(0, 0, At, B0); PG8_MMA(0, 1, At, B1); PG8_BAR; PG8_SCHED;
            PG8_LDA(At, 1, 1); PG8_STAGE(PG8_SB(1, 0), b3, voffB); PG8_STAGE(PG8_SB(1, 1), b3 + hstep, voffB); PG8_STAGE(PG8_SA(1, 0), a3, voffA);
            PG8_WAIT_V(8); PG8_WAIT_L(0); PG8_BAR; PG8_MMA(1, 0, At, B0); PG8_MMA(1, 1, At, B1); PG8_BAR; PG8_SCHED;
            } else {
            PG8_LDB(B0, 0, 0); PG8_SCHED; PG8_LDA(At, 0, 0); PG8_STAGE(PG8_SA(1, 1), a1 + hstep, voffA);
            PG8_WAIT_L(8); PG8_BAR; PG8_WAIT_L(0); PG8_MMA(0, 0, At, B0); PG8_BAR; PG8_SCHED;
            PG8_LDB(B1, 0, 1); PG8_STAGE(PG8_SB(0, 0), b2, voffB);
            PG8_BAR; PG8_WAIT_L(0); PG8_MMA(0, 1, At, B1); PG8_BAR;
            PG8_LDA(At, 0, 1); PG8_STAGE(PG8_SA(0, 0), a2, voffA);
            PG8_BAR; PG8_WAIT_L(0); PG8_MMA(1, 0, At, B0); PG8_BAR; PG8_SCHED;
            PG8_STAGE(PG8_SB(0, 1), b2 + hstep, voffB);
            PG8_WAIT_V(6); PG8_BAR; PG8_MMA(1, 1, At, B1); PG8_BAR;
            PG8_LDB(B0, 1, 0); PG8_SCHED; PG8_LDA(At, 1, 0); PG8_STAGE(PG8_SA(0, 1), a2 + hstep, voffA);
            PG8_WAIT_L(8); PG8_BAR; PG8_WAIT_L(0); PG8_MMA(0, 0, At, B0); PG8_BAR; PG8_SCHED;
            PG8_LDB(B1, 1, 1); PG8_STAGE(PG8_SB(1, 0), b3, voffB);
            PG8_BAR; PG8_WAIT_L(0); PG8_MMA(0, 1, At, B1); PG8_BAR;
            PG8_LDA(At, 1, 1); PG8_STAGE(PG8_SA(1, 0), a3, voffA);
            PG8_BAR; PG8_WAIT_L(0); PG8_MMA(1, 0, At, B0); PG8_BAR; PG8_SCHED;
            PG8_STAGE(PG8_SB(1, 1), b3 + hstep, voffB);
            PG8_WAIT_V(6); PG8_BAR; PG8_MMA(1, 1, At, B1); PG8_BAR;
            }
        }
        if constexpr (ALIGN_EPI) { if (wr == 0) PG8_BAR; }
        if constexpr (!Epi::AFTER_DRAIN) { E(acc, cur, wr, wc, fr, fq); S.done(cur); }
        if (!has_next) break;
#pragma unroll
        for (int a = 0; a < 2; ++a)
#pragma unroll
            for (int b = 0; b < 2; ++b)
#pragma unroll
                for (int m = 0; m < 4; ++m)
#pragma unroll
                    for (int n = 0; n < 2; ++n) acc[a][b][m][n] = (f32x4){0.f, 0.f, 0.f, 0.f};
        cur = nxt; cA = nA; cB = nB; ++ui;
        if constexpr (ALIGN_EPI) { if (wr == 1) PG8_BAR; }
    }
    PG8_WAIT_V(0);
    if constexpr (!ALIGN_EPI) { if (wr == 0) PG8_BAR; }
    PG8_BAR;
    if constexpr (Epi::AFTER_DRAIN) { E.fused(acc, cur, wr, wc, fr, fq, lds, wid, lane); S.done(cur); }
#undef PG8_SA
#undef PG8_SB
#undef PG8_STAGE
#undef PG8_LDA
#undef PG8_LDB
#undef PG8_MMA
#undef PG8_WAIT_V
#undef PG8_WAIT_L
#undef PG8_BAR
#undef PG8_SCHED
}
}

#ifndef EN_PRO
#define EN_PRO 1
#endif
#ifndef EN_HY14
#define EN_HY14 1
#endif
#ifndef EN_HY12
#define EN_HY12 1
#endif
#ifndef EN_ATT
#define EN_ATT 1
#endif
#ifndef EN_GEMM
#define EN_GEMM 0xffff
#endif
#ifndef EPI_FENCE
#define EPI_FENCE 1
#endif
#ifndef G_ALIGN
#define G_ALIGN true
#endif
#ifndef G_SP2
#define G_SP2 true
#endif
#ifndef REP_ATT
#define REP_ATT 1
#endif
#ifndef REP_HY
#define REP_HY 1
#endif
#ifndef REP_G
#define REP_G 1
#endif
#ifndef REP_SM
#define REP_SM 1
#endif
#ifndef MK_MULTI
#define MK_MULTI 0
#endif
#define LAS __attribute__((address_space(3)))
using pg8::bf16_t; using pg8::f32x4; using pg8::u32x4; using pg8::Unit;
typedef float c2 __attribute__((ext_vector_type(2)));

constexpr int TC = 16384;
constexpr int LDS_BYTES = 139264;
constexpr float DN_ALPHA = 1.189207115002721f, LN_EPS = 1e-5f, RMS_EPS = 1e-6f;
constexpr size_t MiB = 1u << 20;
constexpr size_t WS_WIN = 0, WS_WUQ = 12 * MiB, WS_WUKV = 14 * MiB, WS_WOMLA = 15 * MiB, WS_WOHY = 17 * MiB, WS_WOUT = 19 * MiB, WS_WUP = 21 * MiB,
                 WS_WDOWN = 32 * MiB, WS_W3B = 38 * MiB, WS_COS = 40 * MiB, WS_SIN = 42 * MiB, WS_H2B = 44 * MiB, WS_SSQ = 50 * MiB, WS_Z = 52 * MiB,
                 WS_UT = 116 * MiB, WS_FT = 308 * MiB, WS_ZT = 436 * MiB,
                 WS_CQ = 116 * MiB, WS_CKV = 128 * MiB, WS_KR = 136 * MiB, WS_G = 138 * MiB, WS_Q = 202 * MiB, WS_KV = 250 * MiB, WS_O = 314 * MiB,
                 WS_MG = 346 * MiB, WS_X1B = 378 * MiB, WS_HM = 410 * MiB, WS_AB = 116 * MiB, WS_END = 512 * MiB;

__device__ __forceinline__ float bflo(unsigned w) { return __uint_as_float(w << 16); }
__device__ __forceinline__ float bfhi(unsigned w) { return __uint_as_float(w & 0xffff0000u); }
__device__ __forceinline__ float bf2f(bf16_t v) { return __uint_as_float(((unsigned)v) << 16); }
__device__ __forceinline__ unsigned pk(float lo, float hi) { return pg8::cvt_pk_bf16(lo, hi); }
__device__ __forceinline__ bf16_t f2bf(float v) { return (bf16_t)(pk(v, 0.f) & 0xffffu); }
__device__ __forceinline__ void st8(bf16_t* p, f32x4 a, f32x4 b) { u32x4 w; w.x = pk(a[0], a[1]); w.y = pk(a[2], a[3]); w.z = pk(b[0], b[1]); w.w = pk(b[2], b[3]); *(u32x4*)p = w; }
__device__ __forceinline__ void ld8(const bf16_t* p, f32x4& a, f32x4& b) { const u32x4 w = *(const u32x4*)p;
    a[0] = bflo(w.x); a[1] = bfhi(w.x); a[2] = bflo(w.y); a[3] = bfhi(w.y); b[0] = bflo(w.z); b[1] = bfhi(w.z); b[2] = bflo(w.w); b[3] = bfhi(w.w); }

template <class F> struct Epi8 {
    static constexpr bool PERM = true, AFTER_DRAIN = false;
    F f;
    __device__ __forceinline__ void operator()(const f32x4 (&acc)[2][2][4][2], const Unit& u, int wr, int wc, int fr, int fq) const {
        const int row0 = u.pm * pg8::BM + wr * 64 + fr, col0 = u.pn * pg8::BM + wc * 32 + 8 * fq;
#pragma unroll
        for (int ai = 0; ai < 2; ++ai)
#pragma unroll
            for (int m = 0; m < 4; ++m)
#pragma unroll
                for (int bj = 0; bj < 2; ++bj) { f(row0 + ai * pg8::HALF + m * 16, col0 + bj * pg8::HALF, acc[ai][bj][m][0], acc[ai][bj][m][1], fq);
                  if (EPI_FENCE) asm volatile("" ::: "memory"); }
    }
};
__device__ __forceinline__ void rope8(f32x4& a, f32x4& b, const float* cosT, const float* sinT, int pos, int i0) {
    const f32x4 c = *(const f32x4*)(cosT + pos * 32 + i0), s = *(const f32x4*)(sinT + pos * 32 + i0);
    f32x4 oa, ob;
    oa[0] = a[0] * c[0] - a[1] * s[0]; oa[1] = a[0] * s[0] + a[1] * c[0]; oa[2] = a[2] * c[1] - a[3] * s[1]; oa[3] = a[2] * s[1] + a[3] * c[1];
    ob[0] = b[0] * c[2] - b[1] * s[2]; ob[1] = b[0] * s[2] + b[1] * c[2]; ob[2] = b[2] * c[3] - b[3] * s[3]; ob[3] = b[2] * s[3] + b[3] * c[3];
    a = oa; b = ob;
}
__device__ __forceinline__ float sigm(float x) { return 1.0f / (1.0f + __expf(-x)); }
struct FTm { bf16_t *CQ, *CKV, *KR, *G; float* ssq; const float *cosT, *sinT; int seqmask;
    __device__ __forceinline__ void operator()(int row, int col, f32x4 a, f32x4 b, int fq) const {
        if (col < 640) {
            float s = (a[0] * a[0] + a[1] * a[1]) + (a[2] * a[2] + a[3] * a[3]) + (b[0] * b[0] + b[1] * b[1]) + (b[2] * b[2] + b[3] * b[3]);
            s += __shfl_xor(s, 16); s += __shfl_xor(s, 32);
            if (col < 384) { st8(CQ + (size_t)row * 384 + col, a, b); if (fq == 0) __hip_atomic_fetch_add(ssq + row * 2, s, __ATOMIC_RELAXED, __HIP_MEMORY_SCOPE_AGENT); }
            else { st8(CKV + (size_t)row * 256 + (col - 384), a, b); if (fq == 0) __hip_atomic_fetch_add(ssq + row * 2 + 1, s, __ATOMIC_RELAXED, __HIP_MEMORY_SCOPE_AGENT); }
        } else if (col < 704) {
            const int j = col - 640; rope8(a, b, cosT, sinT, row & seqmask, j >> 1); st8(KR + (size_t)row * 64 + j, a, b);
        } else if (col < 2752) {
#pragma unroll
            for (int i = 0; i < 4; ++i) { a[i] = sigm(a[i]); b[i] = sigm(b[i]); }
            st8(G + (size_t)row * 2048 + (col - 704), a, b);
        }
    }
};
struct FQ { bf16_t* Q; const float* ssq; const float *cosT, *sinT; int seqmask;
    __device__ __forceinline__ void operator()(int row, int col, f32x4 a, f32x4 b, int) const {
        const float rs = rsqrtf(ssq[row * 2] * (1.0f / 384.0f) + RMS_EPS); a = a * rs; b = b * rs;
        if (col >= 1024) rope8(a, b, cosT, sinT, row & seqmask, ((col - 1024) & 63) >> 1);
        st8(Q + (size_t)row * 1536 + col, a, b);
    }
};
struct FKV { bf16_t* KV; const float* ssq;
    __device__ __forceinline__ void operator()(int row, int col, f32x4 a, f32x4 b, int) const {
        const float rs = rsqrtf(ssq[row * 2 + 1] * (1.0f / 256.0f) + RMS_EPS); st8(KV + (size_t)row * 2048 + col, a * rs, b * rs);
    }
};
struct FBf { bf16_t* O; size_t ld;
    __device__ __forceinline__ void operator()(int row, int col, f32x4 a, f32x4 b, int) const { st8(O + (size_t)row * ld + col, a, b); }
};
struct FFilt { bf16_t* FT; int L;
    __device__ __forceinline__ void operator()(int row, int col, f32x4 a, f32x4 b, int) const {
        const int c = row & 1023; const float MIN_DECAY = -3.0701134573253944f, MAX_DECAY = -15.350567286626973f;
        const float kk = -1.4426950408889634f * fabsf(MIN_DECAY + (MAX_DECAY - MIN_DECAY) * ((float)c * (1.0f / 1023.0f))) / (float)(L - 1); const float fc = (float)col;
#pragma unroll
        for (int i = 0; i < 4; ++i) { a[i] *= __builtin_amdgcn_exp2f((fc + (float)i) * kk) + 0.05f; b[i] *= __builtin_amdgcn_exp2f((fc + (float)(4 + i)) * kk) + 0.05f; }
        st8(FT + (size_t)row * L + col, a, b);
    }
};
struct FM1 { bf16_t* MG; const bf16_t* G;
    __device__ __forceinline__ void operator()(int row, int col, f32x4 a, f32x4 b, int) const {
        f32x4 ga, gb; ld8(G + (size_t)row * 2048 + col, ga, gb); st8(MG + (size_t)row * 1024 + col, a * ga, b * gb);
    }
};
struct FM2 { bf16_t* MG; const bf16_t* G;
    __device__ __forceinline__ void operator()(int row, int col, f32x4 a, f32x4 b, int) const {
        f32x4 ga, gb, pa, pb; ld8(G + (size_t)row * 2048 + 1024 + col, ga, gb); ld8(MG + (size_t)row * 1024 + col, pa, pb);
        st8(MG + (size_t)row * 1024 + col, pa + a * ga, pb + b * gb);
    }
};
struct FOut { float* Y; const float* X;
    __device__ __forceinline__ void operator()(int row, int col, f32x4 a, f32x4 b, int) const {
        const size_t o = (size_t)row * 1024 + col; const f32x4 xa = *(const f32x4*)(X + o), xb = *(const f32x4*)(X + o + 4);
        *(f32x4*)(Y + o) = xa * DN_ALPHA + a; *(f32x4*)(Y + o + 4) = xb * DN_ALPHA + b;
    }
};
struct FDown { float* Y;
    __device__ __forceinline__ void operator()(int row, int col, f32x4 a, f32x4 b, int) const {
        const size_t o = (size_t)row * 1024 + col; const f32x4 xa = *(const f32x4*)(Y + o), xb = *(const f32x4*)(Y + o + 4);
        *(f32x4*)(Y + o) = xa * DN_ALPHA + a; *(f32x4*)(Y + o + 4) = xb * DN_ALPHA + b;
    }
};
template <int ID, class F> __device__ __forceinline__ void run_gemm(PG8_LAS unsigned char* lds, const bf16_t* A, const bf16_t* Bt, int M, int N, int K, const F& f) {
  if constexpr ((EN_GEMM >> ID) & 1) {
    asm volatile("" : "+s"(M), "+s"(N), "+s"(K));
    pg8::Gemm g{A, Bt, M, N, K}; pg8::StaticOrder S; S.init(M, N, (int)gridDim.x, (int)blockIdx.x);
    Epi8<F> E{f};
    pg8::gemm_phase<Epi8<F>, pg8::StaticOrder, G_ALIGN, (ID != 0 && ID != 3)>(lds, g, S, E);
  }
}

namespace att {
typedef short bf16x8 __attribute__((ext_vector_type(8)));
typedef short s16x4 __attribute__((ext_vector_type(4)));
typedef float f32x16 __attribute__((ext_vector_type(16)));
constexpr int NW = 8, QBLK = 32, KVBLK = 64, LDQ = 1536, LDK = 2048, LDKR = 64, LDO = 1024;
constexpr float SCALE = 0.07216878364870323f, THR = 8.f;
constexpr int SHM_V = 16384, SHM_K = 24576;
#define AKSWZ(row, colB) ((row) * 384 + ((colB) ^ (((row) & 7) << 4)))
#define SBAR() __builtin_amdgcn_sched_barrier(0)
__device__ __forceinline__ int crow(int r, int hi) { return (r & 3) + 8 * (r >> 2) + 4 * hi; }
__device__ __forceinline__ void partialSM(f32x16& p0, f32x16& p1, float& m_reg, float& mn, float& alpha) {
  constexpr float C = SCALE * 1.4426950408889634f;
  float pmax = p0[0]; for (int r = 1; r < 16; ++r) pmax = fmaxf(pmax, p0[r]); for (int r = 0; r < 16; ++r) pmax = fmaxf(pmax, p1[r]);
  { auto rr = __builtin_amdgcn_permlane32_swap(__float_as_uint(pmax), __float_as_uint(pmax), false, false);
    pmax = fmaxf(__uint_as_float(rr[0]), __uint_as_float(rr[1])); }
  if (__builtin_expect(__all(pmax - m_reg <= THR / SCALE), 1)) { mn = m_reg; alpha = 1.f; }
  else { mn = fmaxf(m_reg, pmax); alpha = __builtin_amdgcn_exp2f((m_reg - mn) * C); m_reg = mn; }
  float mnC = -mn * C;
  for (int r = 0; r < 16; ++r) p0[r] = fmaf(p0[r], C, mnC); for (int r = 0; r < 16; ++r) p1[r] = fmaf(p1[r], C, mnC);
  for (int r = 0; r < 16; ++r) p0[r] = __builtin_amdgcn_exp2f(p0[r]);
}
__device__ __forceinline__ void finishSM(f32x16& p0, f32x16& p1, float alpha, float& l_reg, bf16x8& pa0, bf16x8& pa1, bf16x8& pa2, bf16x8& pa3) {
  for (int r = 0; r < 16; ++r) p1[r] = __builtin_amdgcn_exp2f(p1[r]);
  float ps = 0; for (int r = 0; r < 16; ++r) ps += p0[r]; for (int r = 0; r < 16; ++r) ps += p1[r];
  { auto rr = __builtin_amdgcn_permlane32_swap(__float_as_uint(ps), __float_as_uint(ps), false, false);
    ps = __uint_as_float(rr[0]) + __uint_as_float(rr[1]); }
  l_reg = l_reg * alpha + ps;
#define PK4(P, BASE, OUT) do { unsigned a0 = pk(P[BASE + 0], P[BASE + 1]), a1 = pk(P[BASE + 2], P[BASE + 3]);   \
    unsigned b0 = pk(P[BASE + 4], P[BASE + 5]), b1 = pk(P[BASE + 6], P[BASE + 7]);                              \
    auto r0 = __builtin_amdgcn_permlane32_swap(a0, b0, false, false); auto r1 = __builtin_amdgcn_permlane32_swap(a1, b1, false, false); \
    u32x4 w = {r0[0], r1[0], r0[1], r1[1]}; OUT = *reinterpret_cast<bf16x8*>(&w); } while (0)
  PK4(p0, 0, pa0); PK4(p0, 8, pa1); PK4(p1, 0, pa2); PK4(p1, 8, pa3);
#undef PK4
}
__device__ __forceinline__ void qkt(f32x16& p0, f32x16& p1, const char* Ks, const bf16x8* qr, const bf16x8* qrl, int r32, int hi) {
  p0 = f32x16{}; p1 = f32x16{};
  int kb[4];
#pragma unroll
  for (int dl = 0; dl < 4; ++dl) kb[dl] = r32 * 384 + ((dl * 32 + hi * 16) ^ ((r32 & 7) << 4));
#pragma unroll
  for (int d0 = 0; d0 < 12; ++d0) {
    bf16x8 b0 = *reinterpret_cast<const bf16x8*>(Ks + kb[d0 & 3] + (d0 >> 2) * 128);
    bf16x8 b1 = *reinterpret_cast<const bf16x8*>(Ks + kb[d0 & 3] + (d0 >> 2) * 128 + 32 * 384);
    const bf16x8 qv = (d0 < 8) ? qr[d0 & 7] : qrl[(d0 - 8) * 64];
    p0 = __builtin_amdgcn_mfma_f32_32x32x16_bf16(b0, qv, p0, 0, 0, 0);
    p1 = __builtin_amdgcn_mfma_f32_32x32x16_bf16(b1, qv, p1, 0, 0, 0); }
}
__device__ __forceinline__ int v_st(int k, int c) { const int kk = (k & ~0xC) | ((k & 4) << 1) | ((k & 8) >> 1); return ((kk >> 3) * 4 + (c >> 5)) * 512 + ((kk & 7) * 32 + (c & 31)) * 2; }
__device__ __forceinline__ int v_rd_base(int lane) { return ((lane & 3) << 3) | (((lane >> 2) & 3) << 6) | (((lane >> 4) & 1) << 5) | (((lane >> 5) & 1) << 8); }
constexpr int v_rd_off(int d0, int ks, int half) { return d0 * 512 + ks * 4096 + half * 2048; }
template <int OFF> __device__ __forceinline__ s16x4 tr_read(int vb) {
  s16x4 r; asm volatile("ds_read_b64_tr_b16 %0, %1 offset:%2" : "=&v"(r) : "v"(vb), "i"(OFF) : "memory"); return r;
}
template <int D0> __device__ __forceinline__ void pv_one(f32x16& od, int vb, bf16x8 pa0, bf16x8 pa1, bf16x8 pa2, bf16x8 pa3) {
  const s16x4 l0 = tr_read<v_rd_off(D0, 0, 0)>(vb), h0 = tr_read<v_rd_off(D0, 0, 1)>(vb), l1 = tr_read<v_rd_off(D0, 1, 0)>(vb), h1 = tr_read<v_rd_off(D0, 1, 1)>(vb);
  const s16x4 l2 = tr_read<v_rd_off(D0, 2, 0)>(vb), h2 = tr_read<v_rd_off(D0, 2, 1)>(vb), l3 = tr_read<v_rd_off(D0, 3, 0)>(vb), h3 = tr_read<v_rd_off(D0, 3, 1)>(vb);
  asm volatile("s_waitcnt lgkmcnt(0)" ::: "memory"); SBAR();
#define PKV(L, H) (bf16x8){L[0], L[1], L[2], L[3], H[0], H[1], H[2], H[3]}
  od = __builtin_amdgcn_mfma_f32_32x32x16_bf16(pa0, PKV(l0, h0), od, 0, 0, 0);
  od = __builtin_amdgcn_mfma_f32_32x32x16_bf16(pa1, PKV(l1, h1), od, 0, 0, 0);
  od = __builtin_amdgcn_mfma_f32_32x32x16_bf16(pa2, PKV(l2, h2), od, 0, 0, 0);
  od = __builtin_amdgcn_mfma_f32_32x32x16_bf16(pa3, PKV(l3, h3), od, 0, 0, 0);
#undef PKV
}
__device__ __forceinline__ void pv_d0(f32x16* o, int vb, bf16x8 pa0, bf16x8 pa1, bf16x8 pa2, bf16x8 pa3) {
  pv_one<0>(o[0], vb, pa0, pa1, pa2, pa3); pv_one<1>(o[1], vb, pa0, pa1, pa2, pa3); pv_one<2>(o[2], vb, pa0, pa1, pa2, pa3); pv_one<3>(o[3], vb, pa0, pa1, pa2, pa3);
}
__device__ __forceinline__ void attn_unit(const bf16_t* __restrict__ Qb, const bf16_t* __restrict__ Kh, const bf16_t* __restrict__ Vh, const bf16_t* __restrict__ KRb,
                                          bf16_t* __restrict__ Ob, int seq, char* lds, int h) {
  int tid = threadIdx.x; asm volatile("" : "+v"(tid));
  const int wid = tid >> 6, lane = tid & 63, r32 = lane & 31, hi = lane >> 5;
  char* V_lds = lds; char* K_lds = lds + 2 * SHM_V;
  float* ws = (float*)(lds + 2 * SHM_V + 2 * SHM_K) + wid * 64; float* li_l = ws; float* al_l = ws + 32;
  float m_reg = -1e30f, l_reg = 0; f32x16 o[4] = {}; bf16x8 qr[8];
  bf16x8* qrl = (bf16x8*)(lds + 2 * SHM_V + 2 * SHM_K + 2048) + wid * 256 + lane;
  const bf16_t* Qw = Qb + (long)(wid * QBLK + r32) * LDQ + hi * 8 + h * 128;
  const bf16_t* Qwr = Qb + (long)(wid * QBLK + r32) * LDQ + hi * 8 + 1024 + h * 64;
#pragma unroll
  for (int d0 = 0; d0 < 8; ++d0) qr[d0] = *reinterpret_cast<const bf16x8*>(Qw + d0 * 16);
#pragma unroll
  for (int d0 = 8; d0 < 12; ++d0) qrl[(d0 - 8) * 64] = *reinterpret_cast<const bf16x8*>(Qwr + (d0 - 8) * 16);
  const int sr = tid >> 4, sc = (tid & 15) * 8, vst0 = v_st(sr, sc), vst1 = v_st(32 + sr, sc);
  const int rr = tid >> 3, rc = (tid & 7) * 8;
  const int vb0 = (int)(uintptr_t)V_lds + v_rd_base(lane);
  bf16x8 vs0, vs1, ks0, ks1, kr0;
#define SLOAD(k0) do { vs0 = *reinterpret_cast<const bf16x8*>(&Vh[(long)((k0) + sr) * LDK + sc]); vs1 = *reinterpret_cast<const bf16x8*>(&Vh[(long)((k0) + 32 + sr) * LDK + sc]); \
    ks0 = *reinterpret_cast<const bf16x8*>(&Kh[(long)((k0) + sr) * LDK + sc]); ks1 = *reinterpret_cast<const bf16x8*>(&Kh[(long)((k0) + 32 + sr) * LDK + sc]); \
    kr0 = *reinterpret_cast<const bf16x8*>(&KRb[(long)((k0) + rr) * LDKR + rc]); } while (0)
#define SWRITE(b) do { *(bf16x8*)(V_lds + (b) * SHM_V + vst0) = vs0; *(bf16x8*)(V_lds + (b) * SHM_V + vst1) = vs1; int kc = sc * 2; \
    *(bf16x8*)(K_lds + (b) * SHM_K + AKSWZ(sr, kc)) = ks0; *(bf16x8*)(K_lds + (b) * SHM_K + AKSWZ(32 + sr, kc)) = ks1; \
    *(bf16x8*)(K_lds + (b) * SHM_K + AKSWZ(rr, 256 + rc * 2)) = kr0; } while (0)
#define SWAIT() asm volatile("s_waitcnt vmcnt(0)" ::: "memory")
#define RESC(a) do { if (__any((a) < 1.f)) { if (hi == 0) al_l[r32] = (a); asm volatile("s_waitcnt lgkmcnt(0)" ::: "memory"); \
    for (int d = 0; d < 4; ++d) for (int r = 0; r < 16; ++r) o[d][r] *= al_l[crow(r, hi)]; } } while (0)
  f32x16 pA0, pA1, pB0, pB1; float mnA, mnB, alA, alB; bf16x8 pa0, pa1, pa2, pa3; const int NT = seq / KVBLK;
  SLOAD(0); SWAIT(); SWRITE(0); __syncthreads();
  qkt(pA0, pA1, K_lds, qr, qrl, r32, hi); partialSM(pA0, pA1, m_reg, mnA, alA);
  SLOAD(KVBLK);
  SWAIT(); SWRITE(1); __syncthreads();
  for (int j = 1; j + 1 < NT; j += 2) {
    SBAR(); qkt(pB0, pB1, K_lds + SHM_K, qr, qrl, r32, hi);
    finishSM(pA0, pA1, alA, l_reg, pa0, pa1, pa2, pa3); SBAR();
    SLOAD((j + 1) * KVBLK); SBAR();
    pv_d0(o, vb0, pa0, pa1, pa2, pa3); partialSM(pB0, pB1, m_reg, mnB, alB);
    __syncthreads(); SWAIT(); SWRITE(0);
    RESC(alB); __syncthreads();
    SBAR(); qkt(pA0, pA1, K_lds, qr, qrl, r32, hi);
    finishSM(pB0, pB1, alB, l_reg, pa0, pa1, pa2, pa3); SBAR();
    SLOAD((j + 2) * KVBLK); SBAR();
    pv_d0(o, vb0 + SHM_V, pa0, pa1, pa2, pa3); partialSM(pA0, pA1, m_reg, mnA, alA);
    __syncthreads(); SWAIT(); SWRITE(1);
    RESC(alA); __syncthreads();
  }
  SBAR(); qkt(pB0, pB1, K_lds + SHM_K, qr, qrl, r32, hi);
  finishSM(pA0, pA1, alA, l_reg, pa0, pa1, pa2, pa3); SBAR();
  pv_d0(o, vb0, pa0, pa1, pa2, pa3); partialSM(pB0, pB1, m_reg, mnB, alB);
  __syncthreads(); RESC(alB);
  finishSM(pB0, pB1, alB, l_reg, pa0, pa1, pa2, pa3); SBAR();
  pv_d0(o, vb0 + SHM_V, pa0, pa1, pa2, pa3);
  if (hi == 0) li_l[r32] = l_reg; asm volatile("s_waitcnt lgkmcnt(0)" ::: "memory");
  float rli[16];
#pragma unroll
  for (int r = 0; r < 16; ++r) rli[r] = __builtin_amdgcn_rcpf(li_l[crow(r, hi)]);
  bf16_t* Ow = Ob + (long)(wid * QBLK) * LDO;
#pragma unroll
  for (int r = 0; r < 16; ++r) { int orow = crow(r, hi);
#pragma unroll
    for (int d0 = 0; d0 < 4; ++d0) Ow[(long)orow * LDO + d0 * 32 + r32] = f2bf(o[d0][r] * rli[r]); }
  __syncthreads();
#undef SLOAD
#undef SWRITE
#undef SWAIT
#undef RESC
}
}

namespace hy {
__device__ __forceinline__ c2 cmul(c2 a, c2 b) { return (c2){a.x * b.x - a.y * b.y, a.x * b.y + a.y * b.x}; }
__device__ __forceinline__ c2 cmulc(c2 a, c2 b) { return (c2){a.x * b.x + a.y * b.y, a.y * b.x - a.x * b.y}; }
__device__ __forceinline__ c2 twid(float fr) { return (c2){__builtin_amdgcn_cosf(fr), -__builtin_amdgcn_sinf(fr)}; }
__device__ __forceinline__ c2 mulW16(c2 x, int idx) {
    const float C1 = 0.9238795325112867f, S1 = 0.3826834323650898f, R = 0.7071067811865476f;
    switch (idx) {
        case 0: return x;
        case 1: return cmul(x, (c2){C1, -S1});
        case 2: return (c2){(x.x + x.y) * R, (x.y - x.x) * R};
        case 3: return cmul(x, (c2){S1, -C1});
        case 4: return (c2){x.y, -x.x};
        case 5: return cmul(x, (c2){-S1, -C1});
        case 6: return (c2){(x.y - x.x) * R, -(x.x + x.y) * R};
        default: return cmul(x, (c2){-C1, -S1});
    }
}
__device__ __forceinline__ c2 mulW16c(c2 x, int idx) { c2 t = mulW16((c2){x.x, -x.y}, idx); return (c2){t.x, -t.y}; }
template <int R, bool INV> __device__ __forceinline__ void bfly(c2 (&e)[R], c2 th0) {
    constexpr int r = (R == 16) ? 4 : 2;
    c2 th[4]; th[0] = th0; th[1] = cmul(th0, th0); th[2] = cmul(th[1], th[1]); th[3] = cmul(th[2], th[2]);
    if (!INV) {
#pragma unroll
        for (int k = 0; k < r; ++k) { const int half = R >> (k + 1);
#pragma unroll
            for (int a = 0; a < R; ++a) { if (a & half) continue; const int b = a + half;
                const c2 u = e[a], v = e[b]; e[a] = u + v; c2 d = u - v; d = mulW16(d, (a % half) * (8 / half)); e[b] = cmul(d, th[k]); } }
    } else {
#pragma unroll
        for (int k = r - 1; k >= 0; --k) { const int half = R >> (k + 1);
#pragma unroll
            for (int a = 0; a < R; ++a) { if (a & half) continue; const int b = a + half;
                c2 t = cmulc(e[b], th[k]); t = mulW16c(t, (a % half) * (8 / half)); const c2 u = e[a]; e[a] = u + t; e[b] = u - t; } }
    }
}
template <int R, bool INV, int S, int LS, int NSL> __device__ __forceinline__ void fft_pass(LAS c2* X, int seqstride, int nseq, int tid) {
    const int total = nseq << NSL;
    for (int g = tid; g < total; g += 512) {
        const int q = g >> NSL, sg = g & ((1 << NSL) - 1);
        const int j0 = sg & (S - 1), blk = sg >> LS, base = blk * R * S + j0;
        LAS c2* p = X + q * seqstride + base + (base >> 4);
        constexpr int sp = (S >= 16) ? S + (S >> 4) : S;
        c2 e[R];
#pragma unroll
        for (int a = 0; a < R; ++a) e[a] = p[a * sp];
        const c2 th0 = twid((float)j0 * (1.0f / (float)(R * S)));
        bfly<R, INV>(e, th0);
#pragma unroll
        for (int a = 0; a < R; ++a) p[a * sp] = e[a];
    }
    __syncthreads();
}
template <int LOGN> __device__ __forceinline__ void fft_fwd(LAS c2* X, int nseq, int tid) {
    constexpr int N = 1 << LOGN, SS = N + N / 16;
    if constexpr (LOGN == 14) fft_pass<4, false, 4096, 12, LOGN - 2>(X, SS, nseq, tid);
    fft_pass<16, false, 256, 8, LOGN - 4>(X, SS, nseq, tid);
    fft_pass<16, false, 16, 4, LOGN - 4>(X, SS, nseq, tid);
    fft_pass<16, false, 1, 0, LOGN - 4>(X, SS, nseq, tid);
}
template <int LOGN> __device__ __forceinline__ void fft_inv(LAS c2* X, int nseq, int tid) {
    constexpr int N = 1 << LOGN, SS = N + N / 16;
    fft_pass<16, true, 1, 0, LOGN - 4>(X, SS, nseq, tid);
    fft_pass<16, true, 16, 4, LOGN - 4>(X, SS, nseq, tid);
    fft_pass<16, true, 256, 8, LOGN - 4>(X, SS, nseq, tid);
    if constexpr (LOGN == 14) fft_pass<4, true, 4096, 12, LOGN - 2>(X, SS, nseq, tid);
}
template <int L> __device__ __forceinline__ c2 dw3p(const bf16_t* u, int j, float w0, float w1, float w2, float b) {
    const unsigned cur = *(const unsigned*)(u + 2 * j);
    const unsigned prv = j > 0 ? *(const unsigned*)(u + 2 * j - 2) : 0u;
    const unsigned nxt = j < L / 2 - 1 ? *(const unsigned*)(u + 2 * j + 2) : 0u;
    const float xm = bfhi(prv), x0 = bflo(cur), x1 = bfhi(cur), x2 = bflo(nxt);
    return (c2){xm * w0 + x0 * w1 + x1 * w2 + b, x0 * w0 + x1 * w1 + x2 * w2 + b};
}
template <int LOGN> __device__ __forceinline__ void hyena_item(LAS c2* X, const bf16_t* UT, int Tg, const bf16_t* FT, bf16_t* ZT, int c,
                                                               const float* short_w, const float* short_b, const float* hy_skip, c2* KS, c2* YC, int tid) {
    constexpr int L = 1 << LOGN, NSEQ = (LOGN == 12) ? 2 : 1, NP2 = L / 1024, SS = L + L / 16, UNR = (LOGN == 12) ? 2 : 4;
    typedef float f4 __attribute__((ext_vector_type(4)));
    const float invL2 = 0.5f / (float)L, inv2L = 0.5f / (float)L;
    const bf16_t* u1 = UT + (size_t)c * Tg; const bf16_t* u2 = UT + (size_t)(1024 + c) * Tg; const bf16_t* uv = UT + (size_t)(2048 + c) * Tg;
    bf16_t* zt = ZT + (size_t)c * Tg;
    const float v0 = short_w[2048 + c], v1 = short_w[3072 + 2048 + c], v2 = short_w[6144 + 2048 + c], vb = short_b[2048 + c];
#define HY_LOADZ(zA, zB) do { if (n == 0) { zA = dw3p<L>(uv + oA, j, v0, v1, v2, vb); zB = dw3p<L>(uv + oB, j, v0, v1, v2, vb); } \
        else { const unsigned wa = *(const unsigned*)(zt + oA + 2 * j), wb = *(const unsigned*)(zt + oB + 2 * j); zA = (c2){bflo(wa), bfhi(wa)}; zB = (c2){bflo(wb), bfhi(wb)}; } } while (0)
#define HY_LOADK(f0, f1, b0, b1) do { const unsigned wf = *(const unsigned*)(hf + 2 * j), wA = *(const unsigned*)(hb + L - 2 * j - 2); \
        const unsigned wB = j ? *(const unsigned*)(hb + L - 2 * j) : 0u; f0 = bflo(wf); f1 = bfhi(wf); b0 = bflo(wB); b1 = bfhi(wA); } while (0)
    for (int n = 0; n < 2; ++n) {
        const bf16_t* hf = FT + (size_t)(n * 1024 + c) * L; const bf16_t* hb = FT + (size_t)((2 + n) * 1024 + c) * L;
        const float skip = hy_skip[n * 1024 + c];
        const bf16_t* ug = n ? u2 : u1; const int gr = n ? 1024 + c : c;
        const float g0 = short_w[gr], g1 = short_w[3072 + gr], g2 = short_w[6144 + gr], gb = short_b[gr];
#pragma unroll (UNR)
        for (int i = 0; i < NP2; ++i) { const int j = tid + 512 * i; float f0, f1, b0, b1; HY_LOADK(f0, f1, b0, b1);
            LAS c2* p = X + 2 * j + (j >> 3); p[0] = (c2){f0 + b0, 0.f}; p[1] = (c2){f1 + b1, 0.f}; }
        __syncthreads(); fft_fwd<LOGN>(X, 1, tid);
#pragma unroll (UNR)
        for (int i = 0; i < NP2; ++i) { const int j = tid + 512 * i; LAS c2* p = X + 2 * j + (j >> 3); const c2 a = p[0], b = p[1]; *(f4*)(KS + 2 * j) = (f4){a.x, a.y, b.x, b.y}; }
        __syncthreads();
#pragma unroll 1
        for (int q = 0; q < NSEQ; ++q)
#pragma unroll (UNR)
            for (int i = 0; i < NP2; ++i) { const int j = tid + 512 * i; const int oA = (2 * q) * L, oB = (2 * q + 1) * L; c2 zA, zB; HY_LOADZ(zA, zB);
                LAS c2* p = X + q * SS + 2 * j + (j >> 3); p[0] = (c2){zA.x, zB.x}; p[1] = (c2){zA.y, zB.y}; }
        __syncthreads(); fft_fwd<LOGN>(X, NSEQ, tid);
#pragma unroll 1
        for (int q = 0; q < NSEQ; ++q)
#pragma unroll (UNR)
            for (int i = 0; i < NP2; ++i) { const int j = tid + 512 * i; LAS c2* p = X + q * SS + 2 * j + (j >> 3); const f4 k = *(const f4*)(KS + 2 * j);
                p[0] = cmul(p[0], (c2){k[0], k[1]}); p[1] = cmul(p[1], (c2){k[2], k[3]}); }
        __syncthreads(); fft_inv<LOGN>(X, NSEQ, tid);
#pragma unroll 1
        for (int q = 0; q < NSEQ; ++q)
#pragma unroll (UNR)
            for (int i = 0; i < NP2; ++i) { const int j = tid + 512 * i; LAS c2* p = X + q * SS + 2 * j + (j >> 3); const c2 a = p[0], b = p[1]; *(f4*)(YC + q * L + 2 * j) = (f4){a.x, a.y, b.x, b.y}; }
        __syncthreads();
#pragma unroll (UNR)
        for (int i = 0; i < NP2; ++i) { const int j = tid + 512 * i; float f0, f1, b0, b1; HY_LOADK(f0, f1, b0, b1);
            LAS c2* p = X + 2 * j + (j >> 3); p[0] = twid((float)(2 * j) * inv2L) * (f0 - b0); p[1] = twid((float)(2 * j + 1) * inv2L) * (f1 - b1); }
        __syncthreads(); fft_fwd<LOGN>(X, 1, tid);
#pragma unroll (UNR)
        for (int i = 0; i < NP2; ++i) { const int j = tid + 512 * i; LAS c2* p = X + 2 * j + (j >> 3); const c2 a = p[0], b = p[1]; *(f4*)(KS + 2 * j) = (f4){a.x, a.y, b.x, b.y}; }
        __syncthreads();
#pragma unroll 1
        for (int q = 0; q < NSEQ; ++q)
#pragma unroll (UNR)
            for (int i = 0; i < NP2; ++i) { const int j = tid + 512 * i; const int oA = (2 * q) * L, oB = (2 * q + 1) * L; c2 zA, zB; HY_LOADZ(zA, zB);
                LAS c2* p = X + q * SS + 2 * j + (j >> 3); p[0] = cmul((c2){zA.x, zB.x}, twid((float)(2 * j) * inv2L)); p[1] = cmul((c2){zA.y, zB.y}, twid((float)(2 * j + 1) * inv2L)); }
        __syncthreads(); fft_fwd<LOGN>(X, NSEQ, tid);
#pragma unroll 1
        for (int q = 0; q < NSEQ; ++q)
#pragma unroll (UNR)
            for (int i = 0; i < NP2; ++i) { const int j = tid + 512 * i; LAS c2* p = X + q * SS + 2 * j + (j >> 3); const f4 k = *(const f4*)(KS + 2 * j);
                p[0] = cmul(p[0], (c2){k[0], k[1]}); p[1] = cmul(p[1], (c2){k[2], k[3]}); }
        __syncthreads(); fft_inv<LOGN>(X, NSEQ, tid);
#pragma unroll 1
        for (int q = 0; q < NSEQ; ++q)
#pragma unroll 2
            for (int i = 0; i < NP2; ++i) { const int j = tid + 512 * i; const int oA = (2 * q) * L, oB = (2 * q + 1) * L; c2 zA, zB; HY_LOADZ(zA, zB);
                LAS c2* p = X + q * SS + 2 * j + (j >> 3); const c2 yn0 = p[0], yn1 = p[1]; const f4 yc = *(const f4*)(YC + q * L + 2 * j);
                const c2 y0 = ((c2){yc[0], yc[1]} + cmulc(yn0, twid((float)(2 * j) * inv2L))) * invL2 + (c2){zA.x, zB.x} * skip;
                const c2 y1 = ((c2){yc[2], yc[3]} + cmulc(yn1, twid((float)(2 * j + 1) * inv2L))) * invL2 + (c2){zA.y, zB.y} * skip;
                const c2 gA = dw3p<L>(ug + oA, j, g0, g1, g2, gb), gB = dw3p<L>(ug + oB, j, g0, g1, g2, gb);
                *(unsigned*)(zt + oA + 2 * j) = pk(y0.x * gA.x, y1.x * gA.y); *(unsigned*)(zt + oB + 2 * j) = pk(y0.y * gB.x, y1.y * gB.y); }
        __syncthreads();
    }
#undef HY_LOADZ
#undef HY_LOADK
}
}

__device__ __forceinline__ int colmap(int mode, int n) {
    if (mode == 0) return n;
    if (mode == 1) {
        if (n >= 2816) return 704 + (n - 2816);
        if (n < 640) return n;
        if (n < 704) { const int j = n - 640; return 640 + (j >> 1) + 32 * (j & 1); }
        if (n < 2752) return 3776 + (n - 704);
        return -1;
    }
    if (n < 1024) return (n >> 7) * 192 + (n & 127);
    { const int h = (n - 1024) >> 6, j = (n - 1024) & 63; return h * 192 + 128 + (j >> 1) + 32 * (j & 1); }
}
__device__ __forceinline__ void wtrans(float* tile  , const float* src, int ld, int K, int dstN, bf16_t* dst, int mode, const float* scale, int tid) {
    const int tk = K / 64, ntiles = (dstN / 64) * tk;
    for (int t = blockIdx.x; t < ntiles; t += gridDim.x) {
        const int n0 = (t / tk) * 64, k0 = (t % tk) * 64;
        { const int nn = tid & 63, col = colmap(mode, n0 + nn);
#pragma unroll
          for (int i = 0; i < 8; ++i) { const int kk = (tid >> 6) + 8 * i; float v = 0.f; if (col >= 0) { v = src[(size_t)(k0 + kk) * ld + col]; if (scale) v *= scale[k0 + kk]; } tile[kk * 65 + nn] = v; } }
        __syncthreads();
        { const int kk = tid & 63;
#pragma unroll
          for (int i = 0; i < 8; ++i) { const int nn = (tid >> 6) + 8 * i; dst[(size_t)(n0 + nn) * K + k0 + kk] = f2bf(tile[kk * 65 + nn]); } }
        __syncthreads();
    }
}
__device__ __forceinline__ void cvt_rows(const float* src, bf16_t* dst, size_t n8, int gtid, int gthreads) {
    for (size_t i = gtid; i < n8; i += gthreads) { const f32x4 a = *(const f32x4*)(src + i * 8), b = *(const f32x4*)(src + i * 8 + 4); st8(dst + i * 8, a, b); }
}
__device__ __forceinline__ float wsum(float v) { v += __shfl_xor(v, 1); v += __shfl_xor(v, 2); v += __shfl_xor(v, 4); v += __shfl_xor(v, 8); v += __shfl_xor(v, 16); v += __shfl_xor(v, 32); return v; }
__device__ __forceinline__ void ln_rows(float* Y, const float* g, const float* b, bf16_t* Xb, int nrows, int tid) {
    const int wid = tid >> 6, lane = tid & 63;
    f32x4 gv[4], bv[4];
#pragma unroll
    for (int k = 0; k < 4; ++k) { gv[k] = *(const f32x4*)(g + k * 256 + lane * 4); bv[k] = *(const f32x4*)(b + k * 256 + lane * 4); }
    for (int row = blockIdx.x * 8 + wid; row < nrows; row += gridDim.x * 8) {
        float* y = Y + (size_t)row * 1024; f32x4 v[4]; float s = 0.f;
#pragma unroll
        for (int k = 0; k < 4; ++k) { v[k] = *(const f32x4*)(y + k * 256 + lane * 4); s += (v[k][0] + v[k][1]) + (v[k][2] + v[k][3]); }
        const float mean = wsum(s) * (1.0f / 1024.0f); float q = 0.f;
#pragma unroll
        for (int k = 0; k < 4; ++k) { v[k] = v[k] - mean; q += (v[k][0] * v[k][0] + v[k][1] * v[k][1]) + (v[k][2] * v[k][2] + v[k][3] * v[k][3]); }
        const float rstd = rsqrtf(wsum(q) * (1.0f / 1024.0f) + LN_EPS);
#pragma unroll
        for (int k = 0; k < 4; ++k) { const f32x4 o = v[k] * rstd * gv[k] + bv[k]; *(f32x4*)(y + k * 256 + lane * 4) = o;
            if (Xb) { unsigned w0 = pk(o[0], o[1]), w1 = pk(o[2], o[3]); *(uint2*)(Xb + (size_t)row * 1024 + k * 256 + lane * 4) = make_uint2(w0, w1); } }
    }
}
__device__ __forceinline__ void ffn_mid(const bf16_t* AB, bf16_t* HM, const float* dw_w, const float* dw_b, int seqmask, int gtid, int gthreads) {
    typedef float f32x2 __attribute__((ext_vector_type(2)));
    for (int idx = gtid; idx < TC * 352; idx += gthreads) {
        const int row = idx / 352, col = (idx % 352) * 8, pos = row & seqmask;
        const bf16_t* p = AB + (size_t)row * 5632 + col;
        f32x4 a0a = {0.f, 0.f, 0.f, 0.f}, a0b = a0a, a2a = a0a, a2b = a0a, a1a, a1b, ga, gb;
        ld8(p, a1a, a1b); ld8(p + 2816, ga, gb);
        if (pos > 0) ld8(p - 5632, a0a, a0b);
        if (pos < seqmask) ld8(p + 5632, a2a, a2b);
        const f32x4 w0a = *(const f32x4*)(dw_w + col), w0b = *(const f32x4*)(dw_w + col + 4), w1a = *(const f32x4*)(dw_w + 2816 + col), w1b = *(const f32x4*)(dw_w + 2816 + col + 4),
                    w2a = *(const f32x4*)(dw_w + 5632 + col), w2b = *(const f32x4*)(dw_w + 5632 + col + 4), ba = *(const f32x4*)(dw_b + col), bb = *(const f32x4*)(dw_b + col + 4);
        f32x4 ta = a0a * w0a + a1a * w1a + a2a * w2a + ba, tb = a0b * w0b + a1b * w1b + a2b * w2b + bb;
        const f32x2 r0 = pg8::gelu_pk((f32x2){ta[0], ta[1]}), r1 = pg8::gelu_pk((f32x2){ta[2], ta[3]}), r2 = pg8::gelu_pk((f32x2){tb[0], tb[1]}), r3 = pg8::gelu_pk((f32x2){tb[2], tb[3]});
        ta = (f32x4){r0.x, r0.y, r1.x, r1.y} * ga; tb = (f32x4){r2.x, r2.y, r3.x, r3.y} * gb;
        st8(HM + (size_t)row * 2816 + col, ta, tb);
    }
}
__device__ __forceinline__ void transpose_z(LAS bf16_t* tile  , const bf16_t* ZT, bf16_t* Z, int Tg, int tid) {
    const int tt = Tg / 64, ntiles = 16 * tt;
    for (int t = blockIdx.x; t < ntiles; t += gridDim.x) {
        const int c0 = (t / tt) * 64, t0 = (t % tt) * 64;
        { const int cc = tid >> 3, t8 = (tid & 7) * 8; const u32x4 w = *(const u32x4*)(ZT + (size_t)(c0 + cc) * Tg + t0 + t8);
          tile[(t8 + 0) * 72 + cc] = (bf16_t)(w.x & 0xffff); tile[(t8 + 1) * 72 + cc] = (bf16_t)(w.x >> 16); tile[(t8 + 2) * 72 + cc] = (bf16_t)(w.y & 0xffff); tile[(t8 + 3) * 72 + cc] = (bf16_t)(w.y >> 16);
          tile[(t8 + 4) * 72 + cc] = (bf16_t)(w.z & 0xffff); tile[(t8 + 5) * 72 + cc] = (bf16_t)(w.z >> 16); tile[(t8 + 6) * 72 + cc] = (bf16_t)(w.w & 0xffff); tile[(t8 + 7) * 72 + cc] = (bf16_t)(w.w >> 16); }
        __syncthreads();
        { const int r = tid >> 3, c8 = (tid & 7) * 8; const u32x4 w = *(const LAS u32x4*)(tile + r * 72 + c8); *(u32x4*)(Z + (size_t)(t0 + r) * 1024 + c0 + c8) = w; }
        __syncthreads();
    }
}

struct Params { const float* in[27]; float* out; unsigned char* ws; int lo, hi; };

__device__ __forceinline__ void prologue(const Params& P, unsigned char* smem, int tid) {
    unsigned char* ws = P.ws; float* tile = (float*)smem;
    const int gtid = blockIdx.x * 512 + tid, gthreads = gridDim.x * 512;
    wtrans(tile, P.in[2], 5824, 1024, 5888, (bf16_t*)(ws + WS_WIN), 1, nullptr, tid);
    wtrans(tile, P.in[6], 1536, 384, 1536, (bf16_t*)(ws + WS_WUQ), 2, P.in[5], tid);
    wtrans(tile, P.in[8], 2048, 256, 2048, (bf16_t*)(ws + WS_WUKV), 0, P.in[7], tid);
    wtrans(tile, P.in[9], 1024, 1024, 1024, (bf16_t*)(ws + WS_WOMLA), 0, nullptr, tid);
    wtrans(tile, P.in[17], 1024, 1024, 1024, (bf16_t*)(ws + WS_WOHY), 0, nullptr, tid);
    wtrans(tile, P.in[18], 1024, 1024, 1024, (bf16_t*)(ws + WS_WOUT), 0, nullptr, tid);
    wtrans(tile, P.in[21], 5632, 1024, 5632, (bf16_t*)(ws + WS_WUP), 0, nullptr, tid);
    wtrans(tile, P.in[24], 1024, 2816, 1024, (bf16_t*)(ws + WS_WDOWN), 0, nullptr, tid);
    { bf16_t* W3B = (bf16_t*)(ws + WS_W3B); const float* w3 = P.in[15];
      for (int i = gtid; i < 4096 * 128; i += gthreads) { const int k = i >> 12, o = i & 4095; W3B[o * 128 + k] = f2bf(w3[(k & 63) * 4096 + o]); } }
    cvt_rows(P.in[0], (bf16_t*)(P.out + (size_t)1 * TC * 1024), (size_t)TC * 1024 / 8, gtid, gthreads);
    cvt_rows(P.in[1], (bf16_t*)(P.out + (size_t)2 * TC * 1024), (size_t)2 * TC * 1024 / 8, gtid, gthreads);
    { float* cosT = (float*)(ws + WS_COS); float* sinT = (float*)(ws + WS_SIN);
      for (int i = gtid; i < 16384 * 32; i += gthreads) { const int pos = i >> 5, k = i & 31; const float inv = powf(10000.0f, -(float)(2 * k) / 64.0f); const float ang = (float)pos * inv;
          cosT[i] = cosf(ang); sinT[i] = sinf(ang); } }
    { float* ssq = (float*)(ws + WS_SSQ); for (int i = gtid; i < 3 * TC * 2; i += gthreads) ssq[i] = 0.f; }
    { bf16_t* H2B = (bf16_t*)(ws + WS_H2B); const float *w1 = P.in[10], *b1 = P.in[11], *fq = P.in[12], *w2 = P.in[13], *b2 = P.in[14];
      const int wid = tid >> 6, lane = tid & 63; const float fr = fq[lane];
      for (int row = blockIdx.x * 8 + wid; row < 20480; row += gridDim.x * 8) {
          const int L = row < 4096 ? 4096 : 16384, m = row < 4096 ? row : row - 4096;
          const float t = (float)m / (float)(L - 1); const int kb = lane & 15;
          const float band = 1e-4f + (float)kb * ((15.0f - 1e-4f) / 15.0f); const float a0 = (6.283185307179586f * (float)m) / (float)L; const float ang = a0 * band;
          const float cv = cosf(ang), sv = -sinf(ang);
          float acc = b1[lane] + t * w1[lane];
#pragma unroll
          for (int k = 0; k < 16; ++k) { acc += __shfl(cv, k) * w1[(1 + k) * 64 + lane]; acc += __shfl(sv, k) * w1[(17 + k) * 64 + lane]; }
          const float h1 = sinf(fr * acc);
          float acc2 = b2[lane];
#pragma unroll 8
          for (int k = 0; k < 64; ++k) acc2 += __shfl(h1, k) * w2[k * 64 + lane];
          const float h2 = sinf(fr * acc2);
          const bf16_t hi = f2bf(h2); H2B[(size_t)row * 128 + lane] = hi; H2B[(size_t)row * 128 + 64 + lane] = f2bf(h2 - bf2f(hi));
      } }
}

__global__ void __launch_bounds__(512, 2) mega(Params P) {
    extern __shared__ __attribute__((aligned(16))) unsigned char smem[];
    cg::grid_group grid = cg::this_grid();
    PG8_LAS unsigned char* lds = (PG8_LAS unsigned char*)smem;
    unsigned char* ws = P.ws; const int lo = P.lo, hi = P.hi;
    const int gthreads = gridDim.x * 512;
    int ph = 0;
#define PH_BEGIN if (ph >= lo && ph < hi) { int tid = threadIdx.x; asm volatile("" : "+v"(tid)); const int gtid = blockIdx.x * 512 + tid;
#define PH_END } ++ph; if (ph > lo && ph < hi) grid.sync();
    const float* cosT = (const float*)(ws + WS_COS); const float* sinT = (const float*)(ws + WS_SIN);
    bf16_t* WIN = (bf16_t*)(ws + WS_WIN);
    PH_BEGIN
#if EN_PRO
 prologue(P, smem, tid);
#endif
 PH_END
    for (int g = 0; g < 2; ++g) {
        const int L = g ? 16384 : 4096, Tg = g ? 2 * TC : TC, seqmask = L - 1;
        const bf16_t* xb = (const bf16_t*)(P.out + (size_t)(g ? 2 : 1) * TC * 1024);
        const bf16_t* H2 = (const bf16_t*)(ws + WS_H2B) + (g ? (size_t)4096 * 128 : 0);
        bf16_t* UT = (bf16_t*)(ws + WS_UT); bf16_t* FT = (bf16_t*)(ws + WS_FT); bf16_t* ZT = (bf16_t*)(ws + WS_ZT); bf16_t* Z = (bf16_t*)(ws + WS_Z);
        PH_BEGIN
            for (int rep = 0; rep < REP_G; ++rep) run_gemm<0>(lds, (const bf16_t*)(ws + WS_W3B), H2, 4096, L, 128, FFilt{FT, L});
            for (int rep = 0; rep < REP_G; ++rep) run_gemm<1>(lds, WIN + (size_t)2816 * 1024, xb, 3072, Tg, 1024, FBf{UT, (size_t)Tg});
        PH_END
        PH_BEGIN
            for (int rep = 0; rep < REP_HY; ++rep)
            for (int c = blockIdx.x; c < 1024; c += gridDim.x) {
                c2* KS = (c2*)(P.out + (size_t)(g ? 1 : 0) * TC * 1024) + (size_t)blockIdx.x * 32768; c2* YC = KS + 16384;
#if EN_HY14
                if (g) hy::hyena_item<14>((LAS c2*)smem, UT, Tg, FT, ZT, c, P.in[3], P.in[4], P.in[16], KS, YC, tid);
#endif
#if EN_HY12
                if (!g) hy::hyena_item<12>((LAS c2*)smem, UT, Tg, FT, ZT, c, P.in[3], P.in[4], P.in[16], KS, YC, tid);
#endif
            }
        PH_END
        for (int ck = 0; ck < (g ? 2 : 1); ++ck) {
            const int chunk = g ? 1 + ck : 0;
            const bf16_t* xbc = xb + (size_t)ck * TC * 1024;
            const float* xin = g ? P.in[1] + (size_t)ck * TC * 1024 : P.in[0];
            float* Y = P.out + (size_t)chunk * TC * 1024;
            float* ssq = (float*)(ws + WS_SSQ) + (size_t)chunk * TC * 2;
            bf16_t *CQ = (bf16_t*)(ws + WS_CQ), *CKV = (bf16_t*)(ws + WS_CKV), *KR = (bf16_t*)(ws + WS_KR), *G = (bf16_t*)(ws + WS_G), *Q = (bf16_t*)(ws + WS_Q), *KV = (bf16_t*)(ws + WS_KV),
                   *O = (bf16_t*)(ws + WS_O), *MG = (bf16_t*)(ws + WS_MG), *X1B = (bf16_t*)(ws + WS_X1B), *HM = (bf16_t*)(ws + WS_HM), *AB = (bf16_t*)(ws + WS_AB);
            PH_BEGIN
                if (ck == 0) transpose_z((LAS bf16_t*)smem, ZT, Z, Tg, tid);
                run_gemm<2>(lds, xbc, WIN, TC, 2816, 1024, FTm{CQ, CKV, KR, G, ssq, cosT, sinT, seqmask});
            PH_END
            PH_BEGIN
                for (int rep = 0; rep < REP_G; ++rep) run_gemm<3>(lds, CQ, (const bf16_t*)(ws + WS_WUQ), TC, 1536, 384, FQ{Q, ssq, cosT, sinT, seqmask});
                for (int rep = 0; rep < REP_G; ++rep) run_gemm<4>(lds, CKV, (const bf16_t*)(ws + WS_WUKV), TC, 2048, 256, FKV{KV, ssq});
            PH_END
            PH_BEGIN
                const int nqb = L / 256;
                for (int rep = 0; rep < REP_ATT; ++rep)
                for (int i = blockIdx.x; i < 512; i += gridDim.x) {
                    const int h = i & 7, combo = i >> 3, b = combo / nqb, qb = combo % nqb;
                    const size_t r0 = (size_t)b * L;
#if EN_ATT
                    att::attn_unit(Q + (r0 + (size_t)qb * 256) * 1536, KV + r0 * 2048 + h * 256, KV + r0 * 2048 + h * 256 + 128, KR + r0 * 64,
                                   O + (r0 + (size_t)qb * 256) * 1024 + h * 128, L, (char*)smem, h);
#endif
                }
            PH_END
            PH_BEGIN
                run_gemm<5>(lds, Z + (size_t)ck * TC * 1024, (const bf16_t*)(ws + WS_WOHY), TC, 1024, 1024, FM1{MG, G});
                run_gemm<6>(lds, O, (const bf16_t*)(ws + WS_WOMLA), TC, 1024, 1024, FM2{MG, G});
            PH_END
            PH_BEGIN
                for (int rep = 0; rep < REP_G; ++rep) run_gemm<7>(lds, MG, (const bf16_t*)(ws + WS_WOUT), TC, 1024, 1024, FOut{Y, xin});
            PH_END
            PH_BEGIN ln_rows(Y, P.in[19], P.in[20], X1B, TC, tid); PH_END
            PH_BEGIN
                for (int rep = 0; rep < REP_G; ++rep) run_gemm<8>(lds, X1B, (const bf16_t*)(ws + WS_WUP), TC, 5632, 1024, FBf{AB, (size_t)5632});
            PH_END
            PH_BEGIN for (int rep = 0; rep < REP_SM; ++rep) ffn_mid(AB, HM, P.in[22], P.in[23], seqmask, gtid, gthreads); PH_END
            PH_BEGIN
                run_gemm<9>(lds, HM, (const bf16_t*)(ws + WS_WDOWN), TC, 1024, 2816, FDown{Y});
            PH_END
            PH_BEGIN ln_rows(Y, P.in[25], P.in[26], nullptr, TC, tid); PH_END
        }
    }
}
constexpr int N_PHASES = 1 + 2 * 2 + 3 * 10;

extern "C" void kernel_launch(void* const* d_in, const int* in_sizes, int n_in, void* d_out, int out_size, void* d_ws, size_t ws_size, hipStream_t stream) {
    static int grid = 0;
    if (grid == 0) {
        if (n_in != 27 || out_size != 3 * TC * 1024 || ws_size < WS_END) { fprintf(stderr, "kernel_launch: unexpected shapes: n_in %d out %d ws %zu\n", n_in, out_size, ws_size); grid = -1; return; }
        int dev = 0, cus = 0, per_cu = 0;
        hipGetDevice(&dev); hipDeviceGetAttribute(&cus, hipDeviceAttributeMultiprocessorCount, dev);
        if (hipFuncSetAttribute((const void*)mega, hipFuncAttributeMaxDynamicSharedMemorySize, LDS_BYTES) != hipSuccess) { fprintf(stderr, "kernel_launch: hipFuncSetAttribute failed\n"); grid = -1; return; }
        if (hipOccupancyMaxActiveBlocksPerMultiprocessor(&per_cu, (const void*)mega, 512, LDS_BYTES) != hipSuccess || per_cu < 1) { fprintf(stderr, "kernel_launch: occupancy query says %d\n", per_cu); per_cu = 1; }
        (void)hipGetLastError();
        grid = cus * per_cu;
    }
    if (grid < 0) return;
    Params p{};
    for (int i = 0; i < 27; ++i) p.in[i] = (const float*)d_in[i];
    p.out = (float*)d_out; p.ws = (unsigned char*)d_ws;
#if MK_MULTI
    for (int i = 0; i < N_PHASES; ++i) { p.lo = i; p.hi = i + 1; hipLaunchKernelGGL(mega, dim3(grid), dim3(512), LDS_BYTES, stream, p); }
#else
    p.lo = 0; p.hi = N_PHASES;
    void* args[] = {&p};
    hipError_t e = hipLaunchCooperativeKernel((void*)mega, dim3(grid), dim3(512), args, LDS_BYTES, stream);
    if (e != hipSuccess) fprintf(stderr, "cooperative launch failed: %s (grid %d)\n", hipGetErrorString(e), grid);
#endif
}
```

```cpp
#include <hip/hip_runtime.h>
#include <hip/hip_cooperative_groups.h>
#include <cstdio>
#include <cstdint>
namespace cg = cooperative_groups;
namespace pg8 {
#define PG8_LAS __attribute__((address_space(3)))
typedef unsigned short bf16_t;
typedef short bf16x8 __attribute__((ext_vector_type(8)));
typedef float f32x4 __attribute__((ext_vector_type(4)));
typedef unsigned u32x4 __attribute__((ext_vector_type(4)));
constexpr int BM = 256, BK = 64, HALF = 128, HTB = HALF * BK * 2  , STAGE_BYTES = 8 * HTB, NXCD = 8, WGM = 8;

__host__ __device__ __forceinline__ int lds_byte(int r, int c) { const int st = (r >> 4) * 2 + (c >> 5), rr = r & 15, cc = c & 31, ob = rr * 64 + cc * 2; return st * 1024 + (ob ^ (((ob >> 9) & 1) << 5)); }
__host__ __device__ __forceinline__ void stage_rc(int b, int& R, int& C) { const int st = b / 1024, sb = b % 1024, swz = sb ^ (((sb >> 9) & 1) << 5); R = (st >> 1) * 16 + swz / 64; C = (st & 1) * 32 + (swz % 64) / 2; }
__host__ __device__ __forceinline__ int perm32(int rho) { const int n = rho >> 4, i = rho & 15; return 8 * (i >> 2) + 4 * n + (i & 3); }

struct Unit { int pm, pn; };
struct Gemm { const bf16_t* A; const bf16_t* Bt; int M, N, K; };

struct StaticOrder {
    int nM, nN, nwg, G, c;
    __host__ __device__ void init(int M, int N, int G_, int c_) { nM = M / BM; nN = N / BM; nwg = nM * nN; G = G_; c = c_; }
    __host__ __device__ bool next(int i, Unit& u) const {
        const long L = (long)i * G + c; if (L >= nwg) return false;
        int wgid = (int)L; { const int q = nwg / NXCD, r = nwg % NXCD, xcd = wgid % NXCD, off = wgid / NXCD; wgid = (xcd < r ? xcd * (q + 1) : r * (q + 1) + (xcd - r) * q) + off; }
        const int nig = WGM * nN, gid = wgid / nig, fm = gid * WGM, gsz = (nM - fm) < WGM ? (nM - fm) : WGM;
        u.pm = fm + ((wgid % nig) % gsz); u.pn = (wgid % nig) / gsz; return true;
    }
    __device__ __forceinline__ void a_ready(const Unit&) const {}
    __device__ __forceinline__ void done(const Unit&) const {}
};

__device__ __forceinline__ unsigned cvt_pk_bf16(float lo, float hi) { unsigned r; asm volatile("v_cvt_pk_bf16_f32 %0, %1, %2" : "=v"(r) : "v"(lo), "v"(hi)); return r; }
typedef float f32x2 __attribute__((ext_vector_type(2)));
__device__ __forceinline__ f32x2 gelu_pk(f32x2 v) {
    const f32x2 av = __builtin_elementwise_abs(v), d = av * 0.2316418882f + 1.0f;
    f32x2 t; t.x = __builtin_amdgcn_rcpf(d.x); t.y = __builtin_amdgcn_rcpf(d.y);
    f32x2 q = t * 0.5307027145f + (-0.7265760135f); q = q * t + 0.7107068705f; q = q * t + (-0.142248368f); q = q * t + 0.127414796f; q = q * t;
    const f32x2 s = (v * v) * (-0.72134752044f);
    f32x2 e; e.x = __builtin_amdgcn_exp2f(s.x); e.y = __builtin_amdgcn_exp2f(s.y);
    const f32x2 m = v * (q * e), r = v - m;
    f32x2 o; o.x = v.x < 0.f ? m.x : r.x; o.y = v.y < 0.f ? m.y : r.y; return o;
}
template <class Epi, class Sched, bool ALIGN_EPI = false, bool SP2 = false>
__device__ __forceinline__ void gemm_phase(PG8_LAS unsigned char* lds, const Gemm g, const Sched& S, const Epi& E) {
    int tid = threadIdx.x; asm volatile("" : "+v"(tid));
    const int wid = __builtin_amdgcn_readfirstlane(tid >> 6), lane = tid & 63, wr = wid >> 2, wc = wid & 3, fr = lane & 15, fq = lane >> 4;
    const int K = g.K, nt = K / BK;
    unsigned voffA[2], voffB[2];
#pragma unroll
    for (int i = 0; i < 2; ++i) { int R, C; stage_rc(tid * 16 + i * 8192, R, C); const int Rb = Epi::PERM ? ((R & ~31) + perm32(R & 31)) : R;
        voffA[i] = (unsigned)(R * K + C) * 2u; voffB[i] = (unsigned)(Rb * K + C) * 2u; }
    const size_t kstep = (size_t)(BK * 2);
    const size_t hstep = (size_t)HALF * K * 2;
    const size_t tstep = 2 * hstep;
    const unsigned ldsw = (unsigned)wid * 1024u;
    const int aoff = lds_byte(wr * 64 + fr, fq * 8), boff = lds_byte(wc * 32 + fr, fq * 8);
#define PG8_SA(b, h) (((b) * 2 + (h)) * HTB)
#define PG8_SB(b, h) ((4 + (b) * 2 + (h)) * HTB)
#define PG8_STAGE(bufoff, gbase, voff) do { _Pragma("unroll") for (int _i = 0; _i < 2; ++_i) \
        __builtin_amdgcn_global_load_lds((const unsigned*)((const char*)(gbase) + (voff)[_i]), (PG8_LAS unsigned*)(lds + (bufoff) + ldsw + _i * 8192), 16, 0, 0); } while (0)
#define PG8_LDA(dst, b, h) do { _Pragma("unroll") for (int m = 0; m < 4; ++m) _Pragma("unroll") for (int k = 0; k < 2; ++k) dst[m][k] = *(const PG8_LAS bf16x8*)(lds + PG8_SA(b, h) + aoff + m * 2048 + k * 1024); } while (0)
#define PG8_LDB(dst, b, h) do { _Pragma("unroll") for (int n = 0; n < 2; ++n) _Pragma("unroll") for (int k = 0; k < 2; ++k) dst[n][k] = *(const PG8_LAS bf16x8*)(lds + PG8_SB(b, h) + boff + n * 2048 + k * 1024); } while (0)
#define PG8_MMA(ai, bj, At, Bt) do { __builtin_amdgcn_s_setprio(1); _Pragma("unroll") for (int m = 0; m < 4; ++m) _Pragma("unroll") for (int n = 0; n < 2; ++n) _Pragma("unroll") for (int k = 0; k < 2; ++k) \
        acc[ai][bj][m][n] = __builtin_amdgcn_mfma_f32_16x16x32_bf16(Bt[n][k], At[m][k], acc[ai][bj][m][n], 0, 0, 0); __builtin_amdgcn_s_setprio(0); } while (0)
#define PG8_WAIT_V(n) asm volatile("s_waitcnt vmcnt(" #n ")" ::: "memory")
#define PG8_WAIT_L(n) asm volatile("s_waitcnt lgkmcnt(" #n ")" ::: "memory")
#define PG8_BAR __builtin_amdgcn_s_barrier()
#define PG8_SCHED __builtin_amdgcn_sched_barrier(0)
    Unit cur, nxt; int ui = 0;
    if (!S.next(0, cur)) return;
    f32x4 acc[2][2][4][2];
#pragma unroll
    for (int a = 0; a < 2; ++a)
#pragma unroll
        for (int b = 0; b < 2; ++b)
#pragma unroll
            for (int m = 0; m < 4; ++m)
#pragma unroll
                for (int n = 0; n < 2; ++n) acc[a][b][m][n] = (f32x4){0.f, 0.f, 0.f, 0.f};
    bf16x8 At[4][2], B0[2][2], B1[2][2];
    const char* cA = (const char*)g.A + (size_t)cur.pm * tstep; const char* cB = (const char*)g.Bt + (size_t)cur.pn * tstep;
    S.a_ready(cur);
    if constexpr (SP2) {
        PG8_STAGE(PG8_SB(0, 0), cB, voffB); PG8_STAGE(PG8_SB(0, 1), cB + hstep, voffB); PG8_STAGE(PG8_SA(0, 0), cA, voffA); PG8_STAGE(PG8_SA(0, 1), cA + hstep, voffA);
        if (wr == 1) PG8_BAR;
        PG8_WAIT_V(2); PG8_BAR;
        PG8_STAGE(PG8_SB(1, 0), cB + kstep, voffB); PG8_STAGE(PG8_SA(1, 0), cA + kstep, voffA); PG8_STAGE(PG8_SB(1, 1), cB + hstep + kstep, voffB);
        PG8_WAIT_V(6); PG8_BAR;
    } else {
        PG8_STAGE(PG8_SB(0, 0), cB, voffB); PG8_STAGE(PG8_SA(0, 0), cA, voffA); PG8_STAGE(PG8_SB(0, 1), cB + hstep, voffB); PG8_STAGE(PG8_SA(0, 1), cA + hstep, voffA);
        if (wr == 1) PG8_BAR;
        PG8_WAIT_V(4); PG8_BAR;
        PG8_STAGE(PG8_SB(1, 0), cB + kstep, voffB); PG8_STAGE(PG8_SA(1, 0), cA + kstep, voffA); PG8_STAGE(PG8_SB(1, 1), cB + hstep + kstep, voffB);
        PG8_WAIT_V(6); PG8_BAR;
    }
    for (;;) {
        const bool has_next = S.next(ui + 1, nxt);
        const char* nA = has_next ? (const char*)g.A + (size_t)nxt.pm * tstep : cA; const char* nB = has_next ? (const char*)g.Bt + (size_t)nxt.pn * tstep : cB;
        for (int t = 0; t < nt; t += 2) {
            const bool last = (t == nt - 2);
            const char* a1 = cA + (size_t)(t + 1) * kstep;
            const char* a2 = last ? nA : cA + (size_t)(t + 2) * kstep; const char* b2 = last ? nB : cB + (size_t)(t + 2) * kstep;
            const char* a3 = a2 + kstep; const char* b3 = b2 + kstep;
            if (last && has_next) S.a_ready(nxt);
            if constexpr (SP2) {
            PG8_LDB(B0, 0, 0); PG8_LDB(B1, 0, 1); PG8_SCHED; PG8_LDA(At, 0, 0); PG8_STAGE(PG8_SA(1, 1), a1 + hstep, voffA);
            PG8_WAIT_V(8); PG8_WAIT_L(0); PG8_BAR; PG8_MMA(0, 0, At, B0); PG8_MMA(0, 1, At, B1); PG8_BAR; PG8_SCHED;
            PG8_LDA(At, 0, 1); PG8_STAGE(PG8_SB(0, 0), b2, voffB); PG8_STAGE(PG8_SB(0, 1), b2 + hstep, voffB); PG8_STAGE(PG8_SA(0, 0), a2, voffA);
            PG8_WAIT_V(8); PG8_WAIT_L(0); PG8_BAR; PG8_MMA(1, 0, At, B0); PG8_MMA(1, 1, At, B1); PG8_BAR; PG8_SCHED;
            PG8_LDB(B0, 1, 0); PG8_LDB(B1, 1, 1); PG8_SCHED; PG8_LDA(At, 1, 0); PG8_STAGE(PG8_SA(0, 1), a2 + hstep, voffA);
            PG8_WAIT_V(8); PG8_WAIT_L(0); PG8_BAR; PG8_MMA(0, 0, At, B0); PG8_MMA(0, 1, At, B1); PG8_BAR; PG8_SCHED;
            PG8_LDA(At, 1, 1); PG8_STAGE(PG8_SB(1, 0), b3, voffB); PG8_STAGE(PG8_SB(1, 1), b3 + hstep, voffB); PG8_STAGE(PG8_SA(1, 0), a3, voffA);
            PG8_WAIT_V(8); PG8_WAIT_L(0); PG8_BAR; PG8_MMA(1, 0, At, B0); PG8_MMA(1, 1, At, B1); PG8_BAR; PG8_SCHED;
            } else {
            PG8_LDB(B0, 0, 0); PG8_SCHED; PG8_LDA(At, 0, 0); PG8_STAGE(PG8_SA(1, 1), a1 + hstep, voffA);
            PG8_WAIT_L(8); PG8_BAR; PG8_WAIT_L(0); PG8_MMA(0, 0, At, B0); PG8_BAR; PG8_SCHED;
            PG8_LDB(B1, 0, 1); PG8_STAGE(PG8_SB(0, 0), b2, voffB);
            PG8_BAR; PG8_WAIT_L(0); PG8_MMA(0, 1, At, B1); PG8_BAR;
            PG8_LDA(At, 0, 1); PG8_STAGE(PG8_SA(0, 0), a2, voffA);
            PG8_BAR; PG8_WAIT_L(0); PG8_MMA(1, 0, At, B0); PG8_BAR; PG8_SCHED;
            PG8_STAGE(PG8_SB(0, 1), b2 + hstep, voffB);
            PG8_WAIT_V(6); PG8_BAR; PG8_MMA(1, 1, At, B1); PG8_BAR;
            PG8_LDB(B0, 1, 0); PG8_SCHED; PG8_LDA(At, 1, 0); PG8_STAGE(PG8_SA(0, 1), a2 + hstep, voffA);
            PG8_WAIT_L(8); PG8_BAR; PG8_WAIT_L(0); PG8_MMA(0, 0, At, B0); PG8_BAR; PG8_SCHED;
            PG8_LDB(B1, 1, 1); PG8_STAGE(PG8_SB(1, 0), b3, voffB);
            PG8_BAR; PG8_WAIT_L(0); PG8_MMA(0, 1, At, B1); PG8_BAR;
            PG8_LDA(At, 1, 1); PG8_STAGE(PG8_SA(1, 0), a3, voffA);
            PG8_BAR; PG8_WAIT_L(0); PG8_MMA(1, 0, At, B0); PG8_BAR; PG8_SCHED;
            PG8_STAGE(PG8_SB(1, 1), b3 + hstep, voffB);
            PG8_WAIT_V(6); PG8_BAR; PG8_MMA(1, 1, At, B1); PG8_BAR;
            }
        }
        if constexpr (ALIGN_EPI) { if (wr == 0) PG8_BAR; }
        if constexpr (!Epi::AFTER_DRAIN) { E(acc, cur, wr, wc, fr, fq); S.done(cur); }
        if (!has_next) break;
#pragma unroll
        for (int a = 0; a < 2; ++a)
#pragma unroll
            for (int b = 0; b < 2; ++b)
#pragma unroll
                for (int m = 0; m < 4; ++m)
#pragma unroll
                    for (int n = 0; n < 2; ++n) acc[a][b][m][n] = (f32x4){0.f, 0.f, 0.f, 0.f};
        cur = nxt; cA = nA; cB = nB; ++ui;
        if constexpr (ALIGN_EPI) { if (wr == 1) PG8_BAR; }
    }
    PG8_WAIT_V(0);
    if constexpr (!ALIGN_EPI) { if (wr == 0) PG8_BAR; }
    PG8_BAR;
    if constexpr (Epi::AFTER_DRAIN) { E.fused(acc, cur, wr, wc, fr, fq, lds, wid, lane); S.done(cur); }
#undef PG8_SA
#undef PG8_SB
#undef PG8_STAGE
#undef PG8_LDA
#undef PG8_LDB
#undef PG8_MMA
#undef PG8_WAIT_V
#undef PG8_WAIT_L
#undef PG8_BAR
#undef PG8_SCHED
}
}

#ifndef EN_PRO
#define EN_PRO 1
#endif
#ifndef EN_HY14
#define EN_HY14 1
#endif
#ifndef EN_HY12
#define EN_HY12 1
#endif
#ifndef EN_ATT
#define EN_ATT 1
#endif
#ifndef EN_GEMM
#define EN_GEMM 0xffff
#endif
#ifndef EPI_FENCE
#define EPI_FENCE 1
#endif
#ifndef G_ALIGN
#define G_ALIGN true
#endif
#ifndef G_SP2
#define G_SP2 true
#endif
#ifndef REP_ATT
#define REP_ATT 1
#endif
#ifndef REP_HY
#define REP_HY 1
#endif
#ifndef REP_G
#define REP_G 1
#endif
#ifndef REP_SM
#define REP_SM 1
#endif
#ifndef MK_MULTI
#define MK_MULTI 0
#endif
#define LAS __attribute__((address_space(3)))
using pg8::bf16_t; using pg8::f32x4; using pg8::u32x4; using pg8::Unit;
typedef float c2 __attribute__((ext_vector_type(2)));

constexpr int TC = 16384;
constexpr int LDS_BYTES = 139264;
constexpr float DN_ALPHA = 1.189207115002721f, LN_EPS = 1e-5f, RMS_EPS = 1e-6f;
constexpr size_t MiB = 1u << 20;
constexpr size_t WS_WIN = 0, WS_WUQ = 12 * MiB, WS_WUKV = 14 * MiB, WS_WOMLA = 15 * MiB, WS_WOHY = 17 * MiB, WS_WOUT = 19 * MiB, WS_WUP = 21 * MiB,
                 WS_WDOWN = 32 * MiB, WS_W3B = 38 * MiB, WS_COS = 40 * MiB, WS_SIN = 42 * MiB, WS_H2B = 44 * MiB, WS_SSQ = 50 * MiB, WS_Z = 52 * MiB,
                 WS_UT = 116 * MiB, WS_FT = 308 * MiB, WS_ZT = 436 * MiB,
                 WS_CQ = 116 * MiB, WS_CKV = 128 * MiB, WS_KR = 136 * MiB, WS_G = 138 * MiB, WS_Q = 202 * MiB, WS_KV = 250 * MiB, WS_O = 314 * MiB,
                 WS_MG = 346 * MiB, WS_X1B = 378 * MiB, WS_HM = 410 * MiB, WS_AB = 116 * MiB, WS_END = 512 * MiB;

__device__ __forceinline__ float bflo(unsigned w) { return __uint_as_float(w << 16); }
__device__ __forceinline__ float bfhi(unsigned w) { return __uint_as_float(w & 0xffff0000u); }
__device__ __forceinline__ float bf2f(bf16_t v) { return __uint_as_float(((unsigned)v) << 16); }
__device__ __forceinline__ unsigned pk(float lo, float hi) { return pg8::cvt_pk_bf16(lo, hi); }
__device__ __forceinline__ bf16_t f2bf(float v) { return (bf16_t)(pk(v, 0.f) & 0xffffu); }
__device__ __forceinline__ void st8(bf16_t* p, f32x4 a, f32x4 b) { u32x4 w; w.x = pk(a[0], a[1]); w.y = pk(a[2], a[3]); w.z = pk(b[0], b[1]); w.w = pk(b[2], b[3]); *(u32x4*)p = w; }
__device__ __forceinline__ void ld8(const bf16_t* p, f32x4& a, f32x4& b) { const u32x4 w = *(const u32x4*)p;
    a[0] = bflo(w.x); a[1] = bfhi(w.x); a[2] = bflo(w.y); a[3] = bfhi(w.y); b[0] = bflo(w.z); b[1] = bfhi(w.z); b[2] = bflo(w.w); b[3] = bfhi(w.w); }

template <class F> struct Epi8 {
    static constexpr bool PERM = true, AFTER_DRAIN = false;
    F f;
    __device__ __forceinline__ void operator()(const f32x4 (&acc)[2][2][4][2], const Unit& u, int wr, int wc, int fr, int fq) const {
        const int row0 = u.pm * pg8::BM + wr * 64 + fr, col0 = u.pn * pg8::BM + wc * 32 + 8 * fq;
#pragma unroll
        for (int ai = 0; ai < 2; ++ai)
#pragma unroll
            for (int m = 0; m < 4; ++m)
#pragma unroll
                for (int bj = 0; bj < 2; ++bj) { f(row0 + ai * pg8::HALF + m * 16, col0 + bj * pg8::HALF, acc[ai][bj][m][0], acc[ai][bj][m][1], fq);
                  if (EPI_FENCE) asm volatile("" ::: "memory"); }
    }
};
__device__ __forceinline__ void rope8(f32x4& a, f32x4& b, const float* cosT, const float* sinT, int pos, int i0) {
    const f32x4 c = *(const f32x4*)(cosT + pos * 32 + i0), s = *(const f32x4*)(sinT + pos * 32 + i0);
    f32x4 oa, ob;
    oa[0] = a[0] * c[0] - a[1] * s[0]; oa[1] = a[0] * s[0] + a[1] * c[0]; oa[2] = a[2] * c[1] - a[3] * s[1]; oa[3] = a[2] * s[1] + a[3] * c[1];
    ob[0] = b[0] * c[2] - b[1] * s[2]; ob[1] = b[0] * s[2] + b[1] * c[2]; ob[2] = b[2] * c[3] - b[3] * s[3]; ob[3] = b[2] * s[3] + b[3] * c[3];
    a = oa; b = ob;
}
__device__ __forceinline__ float sigm(float x) { return 1.0f / (1.0f + __expf(-x)); }
struct FTm { bf16_t *CQ, *CKV, *KR, *G; float* ssq; const float *cosT, *sinT; int seqmask;
    __device__ __forceinline__ void operator()(int row, int col, f32x4 a, f32x4 b, int fq) const {
        if (col < 640) {
            float s = (a[0] * a[0] + a[1] * a[1]) + (a[2] * a[2] + a[3] * a[3]) + (b[0] * b[0] + b[1] * b[1]) + (b[2] * b[2] + b[3] * b[3]);
            s += __shfl_xor(s, 16); s += __shfl_xor(s, 32);
            if (col < 384) { st8(CQ + (size_t)row * 384 + col, a, b); if (fq == 0) __hip_atomic_fetch_add(ssq + row * 2, s, __ATOMIC_RELAXED, __HIP_MEMORY_SCOPE_AGENT); }
            else { st8(CKV + (size_t)row * 256 + (col - 384), a, b); if (fq == 0) __hip_atomic_fetch_add(ssq + row * 2 + 1, s, __ATOMIC_RELAXED, __HIP_MEMORY_SCOPE_AGENT); }
        } else if (col < 704) {
            const int j = col - 640; rope8(a, b, cosT, sinT, row & seqmask, j >> 1); st8(KR + (size_t)row * 64 + j, a, b);
        } else if (col < 2752) {
#pragma unroll
            for (int i = 0; i < 4; ++i) { a[i] = sigm(a[i]); b[i] = sigm(b[i]); }
            st8(G + (size_t)row * 2048 + (col - 704), a, b);
        }
    }
};
struct FQ { bf16_t* Q; const float* ssq; const float *cosT, *sinT; int seqmask;
    __device__ __forceinline__ void operator()(int row, int col, f32x4 a, f32x4 b, int) const {
        const float rs = rsqrtf(ssq[row * 2] * (1.0f / 384.0f) + RMS_EPS); a = a * rs; b = b * rs;
        if (col >= 1024) rope8(a, b, cosT, sinT, row & seqmask, ((col - 1024) & 63) >> 1);
        st8(Q + (size_t)row * 1536 + col, a, b);
    }
};
struct FKV { bf16_t* KV; const float* ssq;
    __device__ __forceinline__ void operator()(int row, int col, f32x4 a, f32x4 b, int) const {
        const float rs = rsqrtf(ssq[row * 2 + 1] * (1.0f / 256.0f) + RMS_EPS); st8(KV + (size_t)row * 2048 + col, a * rs, b * rs);
    }
};
struct FBf { bf16_t* O; size_t ld;
    __device__ __forceinline__ void operator()(int row, int col, f32x4 a, f32x4 b, int) const { st8(O + (size_t)row * ld + col, a, b); }
};
struct FFilt { bf16_t* FT; int L;
    __device__ __forceinline__ void operator()(int row, int col, f32x4 a, f32x4 b, int) const {
        const int c = row & 1023; const float MIN_DECAY = -3.0701134573253944f, MAX_DECAY = -15.350567286626973f;
        const float kk = -1.4426950408889634f * fabsf(MIN_DECAY + (MAX_DECAY - MIN_DECAY) * ((float)c * (1.0f / 1023.0f))) / (float)(L - 1); const float fc = (float)col;
#pragma unroll
        for (int i = 0; i < 4; ++i) { a[i] *= __builtin_amdgcn_exp2f((fc + (float)i) * kk) + 0.05f; b[i] *= __builtin_amdgcn_exp2f((fc + (float)(4 + i)) * kk) + 0.05f; }
        st8(FT + (size_t)row * L + col, a, b);
    }
};
struct FM1 { bf16_t* MG; const bf16_t* G;
    __device__ __forceinline__ void operator()(int row, int col, f32x4 a, f32x4 b, int) const {
        f32x4 ga, gb; ld8(G + (size_t)row * 2048 + col, ga, gb); st8(MG + (size_t)row * 1024 + col, a * ga, b * gb);
    }
};
struct FM2 { bf16_t* MG; const bf16_t* G;
    __device__ __forceinline__ void operator()(int row, int col, f32x4 a, f32x4 b, int) const {
        f32x4 ga, gb, pa, pb; ld8(G + (size_t)row * 2048 + 1024 + col, ga, gb); ld8(MG + (size_t)row * 1024 + col, pa, pb);
        st8(MG + (size_t)row * 1024 + col, pa + a * ga, pb + b * gb);
    }
};
struct FOut { float* Y; const float* X;
    __device__ __forceinline__ void operator()(int row, int col, f32x4 a, f32x4 b, int) const {
        const size_t o = (size_t)row * 1024 + col; const f32x4 xa = *(const f32x4*)(X + o), xb = *(const f32x4*)(X + o + 4);
        *(f32x4*)(Y + o) = xa * DN_ALPHA + a; *(f32x4*)(Y + o + 4) = xb * DN_ALPHA + b;
    }
};
struct FDown { float* Y;
    __device__ __forceinline__ void operator()(int row, int col, f32x4 a, f32x4 b, int) const {
        const size_t o = (size_t)row * 1024 + col; const f32x4 xa = *(const f32x4*)(Y + o), xb = *(const f32x4*)(Y + o + 4);
        *(f32x4*)(Y + o) = xa * DN_ALPHA + a; *(f32x4*)(Y + o + 4) = xb * DN_ALPHA + b;
    }
};
template <int ID, class F> __device__ __forceinline__ void run_gemm(PG8_LAS unsigned char* lds, const bf16_t* A, const bf16_t* Bt, int M, int N, int K, const F& f) {
  if constexpr ((EN_GEMM >> ID) & 1) {
    asm volatile("" : "+s"(M), "+s"(N), "+s"(K));
    pg8::Gemm g{A, Bt, M, N, K}; pg8::StaticOrder S; S.init(M, N, (int)gridDim.x, (int)blockIdx.x);
    Epi8<F> E{f};
    pg8::gemm_phase<Epi8<F>, pg8::StaticOrder, G_ALIGN, (ID != 0 && ID != 3)>(lds, g, S, E);
  }
}

namespace att {
typedef short bf16x8 __attribute__((ext_vector_type(8)));
typedef short s16x4 __attribute__((ext_vector_type(4)));
typedef float f32x16 __attribute__((ext_vector_type(16)));
constexpr int NW = 8, QBLK = 32, KVBLK = 64, LDQ = 1536, LDK = 2048, LDKR = 64, LDO = 1024;
constexpr float SCALE = 0.07216878364870323f, THR = 8.f;
constexpr int SHM_V = 16384, SHM_K = 24576;
#define AKSWZ(row, colB) ((row) * 384 + ((colB) ^ (((row) & 7) << 4)))
#define SBAR() __builtin_amdgcn_sched_barrier(0)
__device__ __forceinline__ int crow(int r, int hi) { return (r & 3) + 8 * (r >> 2) + 4 * hi; }
__device__ __forceinline__ void partialSM(f32x16& p0, f32x16& p1, float& m_reg, float& mn, float& alpha) {
  constexpr float C = SCALE * 1.4426950408889634f;
  float pmax = p0[0]; for (int r = 1; r < 16; ++r) pmax = fmaxf(pmax, p0[r]); for (int r = 0; r < 16; ++r) pmax = fmaxf(pmax, p1[r]);
  { auto rr = __builtin_amdgcn_permlane32_swap(__float_as_uint(pmax), __float_as_uint(pmax), false, false);
    pmax = fmaxf(__uint_as_float(rr[0]), __uint_as_float(rr[1])); }
  if (__builtin_expect(__all(pmax - m_reg <= THR / SCALE), 1)) { mn = m_reg; alpha = 1.f; }
  else { mn = fmaxf(m_reg, pmax); alpha = __builtin_amdgcn_exp2f((m_reg - mn) * C); m_reg = mn; }
  float mnC = -mn * C;
  for (int r = 0; r < 16; ++r) p0[r] = fmaf(p0[r], C, mnC); for (int r = 0; r < 16; ++r) p1[r] = fmaf(p1[r], C, mnC);
  for (int r = 0; r < 16; ++r) p0[r] = __builtin_amdgcn_exp2f(p0[r]);
}
__device__ __forceinline__ void finishSM(f32x16& p0, f32x16& p1, float alpha, float& l_reg, bf16x8& pa0, bf16x8& pa1, bf16x8& pa2, bf16x8& pa3) {
  for (int r = 0; r < 16; ++r) p1[r] = __builtin_amdgcn_exp2f(p1[r]);
  float ps = 0; for (int r = 0; r < 16; ++r) ps += p0[r]; for (int r = 0; r < 16; ++r) ps += p1[r];
  { auto rr = __builtin_amdgcn_permlane32_swap(__float_as_uint(ps), __float_as_uint(ps), false, false);
    ps = __uint_as_float(rr[0]) + __uint_as_float(rr[1]); }
  l_reg = l_reg * alpha + ps;
#define PK4(P, BASE, OUT) do { unsigned a0 = pk(P[BASE + 0], P[BASE + 1]), a1 = pk(P[BASE + 2], P[BASE + 3]);   \
    unsigned b0 = pk(P[BASE + 4], P[BASE + 5]), b1 = pk(P[BASE + 6], P[BASE + 7]);                              \
    auto r0 = __builtin_amdgcn_permlane32_swap(a0, b0, false, false); auto r1 = __builtin_amdgcn_permlane32_swap(a1, b1, false, false); \
    u32x4 w = {r0[0], r1[0], r0[1], r1[1]}; OUT = *reinterpret_cast<bf16x8*>(&w); } while (0)
  PK4(p0, 0, pa0); PK4(p0, 8, pa1); PK4(p1, 0, pa2); PK4(p1, 8, pa3);
#undef PK4
}
__device__ __forceinline__ void qkt(f32x16& p0, f32x16& p1, const char* Ks, const bf16x8* qr, const bf16x8* qrl, int r32, int hi) {
  p0 = f32x16{}; p1 = f32x16{};
  int kb[4];
#pragma unroll
  for (int dl = 0; dl < 4; ++dl) kb[dl] = r32 * 384 + ((dl * 32 + hi * 16) ^ ((r32 & 7) << 4));
#pragma unroll
  for (int d0 = 0; d0 < 12; ++d0) {
    bf16x8 b0 = *reinterpret_cast<const bf16x8*>(Ks + kb[d0 & 3] + (d0 >> 2) * 128);
    bf16x8 b1 = *reinterpret_cast<const bf16x8*>(Ks + kb[d0 & 3] + (d0 >> 2) * 128 + 32 * 384);
    const bf16x8 qv = (d0 < 8) ? qr[d0 & 7] : qrl[(d0 - 8) * 64];
    p0 = __builtin_amdgcn_mfma_f32_32x32x16_bf16(b0, qv, p0, 0, 0, 0);
    p1 = __builtin_amdgcn_mfma_f32_32x32x16_bf16(b1, qv, p1, 0, 0, 0); }
}
__device__ __forceinline__ int v_st(int k, int c) { const int kk = (k & ~0xC) | ((k & 4) << 1) | ((k & 8) >> 1); return ((kk >> 3) * 4 + (c >> 5)) * 512 + ((kk & 7) * 32 + (c & 31)) * 2; }
__device__ __forceinline__ int v_rd_base(int lane) { return ((lane & 3) << 3) | (((lane >> 2) & 3) << 6) | (((lane >> 4) & 1) << 5) | (((lane >> 5) & 1) << 8); }
constexpr int v_rd_off(int d0, int ks, int half) { return d0 * 512 + ks * 4096 + half * 2048; }
template <int OFF> __device__ __forceinline__ s16x4 tr_read(int vb) {
  s16x4 r; asm volatile("ds_read_b64_tr_b16 %0, %1 offset:%2" : "=&v"(r) : "v"(vb), "i"(OFF) : "memory"); return r;
}
template <int D0> __device__ __forceinline__ void pv_one(f32x16& od, int vb, bf16x8 pa0, bf16x8 pa1, bf16x8 pa2, bf16x8 pa3) {
  const s16x4 l0 = tr_read<v_rd_off(D0, 0, 0)>(vb), h0 = tr_read<v_rd_off(D0, 0, 1)>(vb), l1 = tr_read<v_rd_off(D0, 1, 0)>(vb), h1 = tr_read<v_rd_off(D0, 1, 1)>(vb);
  const s16x4 l2 = tr_read<v_rd_off(D0, 2, 0)>(vb), h2 = tr_read<v_rd_off(D0, 2, 1)>(vb), l3 = tr_read<v_rd_off(D0, 3, 0)>(vb), h3 = tr_read<v_rd_off(D0, 3, 1)>(vb);
  asm volatile("s_waitcnt lgkmcnt(0)" ::: "memory"); SBAR();
#define PKV(L, H) (bf16x8){L[0], L[1], L[2], L[3], H[0], H[1], H[2], H[3]}
  od = __builtin_amdgcn_mfma_f32_32x32x16_bf16(pa0, PKV(l0, h0), od, 0, 0, 0);
  od = __builtin_amdgcn_mfma_f32_32x32x16_bf16(pa1, PKV(l1, h1), od, 0, 0, 0);
  od = __builtin_amdgcn_mfma_f32_32x32x16_bf16(pa2, PKV(l2, h2), od, 0, 0, 0);
  od = __builtin_amdgcn_mfma_f32_32x32x16_bf16(pa3, PKV(l3, h3), od, 0, 0, 0);
#undef PKV
}
__device__ __forceinline__ void pv_d0(f32x16* o, int vb, bf16x8 pa0, bf16x8 pa1, bf16x8 pa2, bf16x8 pa3) {
  pv_one<0>(o[0], vb, pa0, pa1, pa2, pa3); pv_one<1>(o[1], vb, pa0, pa1, pa2, pa3); pv_one<2>(o[2], vb, pa0, pa1, pa2, pa3); pv_one<3>(o[3], vb, pa0, pa1, pa2, pa3);
}
__device__ __forceinline__ void attn_unit(const bf16_t* __restrict__ Qb, const bf16_t* __restrict__ Kh, const bf16_t* __restrict__ Vh, const bf16_t* __restrict__ KRb,
                                          bf16_t* __restrict__ Ob, int seq, char* lds, int h) {
  int tid = threadIdx.x; asm volatile("" : "+v"(tid));
  const int wid = tid >> 6, lane = tid & 63, r32 = lane & 31, hi = lane >> 5;
  char* V_lds = lds; char* K_lds = lds + 2 * SHM_V;
  float* ws = (float*)(lds + 2 * SHM_V + 2 * SHM_K) + wid * 64; float* li_l = ws; float* al_l = ws + 32;
  float m_reg = -1e30f, l_reg = 0; f32x16 o[4] = {}; bf16x8 qr[8];
  bf16x8* qrl = (bf16x8*)(lds + 2 * SHM_V + 2 * SHM_K + 2048) + wid * 256 + lane;
  const bf16_t* Qw = Qb + (long)(wid * QBLK + r32) * LDQ + hi * 8 + h * 128;
  const bf16_t* Qwr = Qb + (long)(wid * QBLK + r32) * LDQ + hi * 8 + 1024 + h * 64;
#pragma unroll
  for (int d0 = 0; d0 < 8; ++d0) qr[d0] = *reinterpret_cast<const bf16x8*>(Qw + d0 * 16);
#pragma unroll
  for (int d0 = 8; d0 < 12; ++d0) qrl[(d0 - 8) * 64] = *reinterpret_cast<const bf16x8*>(Qwr + (d0 - 8) * 16);
  const int sr = tid >> 4, sc = (tid & 15) * 8, vst0 = v_st(sr, sc), vst1 = v_st(32 + sr, sc);
  const int rr = tid >> 3, rc = (tid & 7) * 8;
  const int vb0 = (int)(uintptr_t)V_lds + v_rd_base(lane);
  bf16x8 vs0, vs1, ks0, ks1, kr0;
#define SLOAD(k0) do { vs0 = *reinterpret_cast<const bf16x8*>(&Vh[(long)((k0) + sr) * LDK + sc]); vs1 = *reinterpret_cast<const bf16x8*>(&Vh[(long)((k0) + 32 + sr) * LDK + sc]); \
    ks0 = *reinterpret_cast<const bf16x8*>(&Kh[(long)((k0) + sr) * LDK + sc]); ks1 = *reinterpret_cast<const bf16x8*>(&Kh[(long)((k0) + 32 + sr) * LDK + sc]); \
    kr0 = *reinterpret_cast<const bf16x8*>(&KRb[(long)((k0) + rr) * LDKR + rc]); } while (0)
#define SWRITE(b) do { *(bf16x8*)(V_lds + (b) * SHM_V + vst0) = vs0; *(bf16x8*)(V_lds + (b) * SHM_V + vst1) = vs1; int kc = sc * 2; \
    *(bf16x8*)(K_lds + (b) * SHM_K + AKSWZ(sr, kc)) = ks0; *(bf16x8*)(K_lds + (b) * SHM_K + AKSWZ(32 + sr, kc)) = ks1; \
    *(bf16x8*)(K_lds + (b) * SHM_K + AKSWZ(rr, 256 + rc * 2)) = kr0; } while (0)
#define SWAIT() asm volatile("s_waitcnt vmcnt(0)" ::: "memory")
#define RESC(a) do { if (__any((a) < 1.f)) { if (hi == 0) al_l[r32] = (a); asm volatile("s_waitcnt lgkmcnt(0)" ::: "memory"); \
    for (int d = 0; d < 4; ++d) for (int r = 0; r < 16; ++r) o[d][r] *= al_l[crow(r, hi)]; } } while (0)
  f32x16 pA0, pA1, pB0, pB1; float mnA, mnB, alA, alB; bf16x8 pa0, pa1, pa2, pa3; const int NT = seq / KVBLK;
  SLOAD(0); SWAIT(); SWRITE(0); __syncthreads();
  qkt(pA0, pA1, K_lds, qr, qrl, r32, hi); partialSM(pA0, pA1, m_reg, mnA, alA);
  SLOAD(KVBLK);
  SWAIT(); SWRITE(1); __syncthreads();
  for (int j = 1; j + 1 < NT; j += 2) {
    SBAR(); qkt(pB0, pB1, K_lds + SHM_K, qr, qrl, r32, hi);
    finishSM(pA0, pA1, alA, l_reg, pa0, pa1, pa2, pa3); SBAR();
    SLOAD((j + 1) * KVBLK); SBAR();
    pv_d0(o, vb0, pa0, pa1, pa2, pa3); partialSM(pB0, pB1, m_reg, mnB, alB);
    __syncthreads(); SWAIT(); SWRITE(0);
    RESC(alB); __syncthreads();
    SBAR(); qkt(pA0, pA1, K_lds, qr, qrl, r32, hi);
    finishSM(pB0, pB1, alB, l_reg, pa0, pa1, pa2, pa3); SBAR();
    SLOAD((j + 2) * KVBLK); SBAR();
    pv_d0(o, vb0 + SHM_V, pa0, pa1, pa2, pa3); partialSM(pA0, pA1, m_reg, mnA, alA);
    __syncthreads(); SWAIT(); SWRITE(1);
    RESC(alA); __syncthreads();
  }
  SBAR(); qkt(pB0, pB1, K_lds + SHM_K, qr, qrl, r32, hi);
  finishSM(pA0, pA1, alA, l_reg, pa0, pa1, pa2, pa3); SBAR();
  pv_d0(o, vb0, pa0, pa1, pa2, pa3); partialSM(pB0, pB1, m_reg, mnB, alB);
  __syncthreads(); RESC(alB);
  finishSM(pB0, pB1, alB, l_reg, pa0, pa1, pa2, pa3); SBAR();
  pv_d0(o, vb0 + SHM_V, pa0, pa1, pa2, pa3);
  if (hi == 0) li_l[r32] = l_reg; asm volatile("s_waitcnt lgkmcnt(0)" ::: "memory");
  float rli[16];
#pragma unroll
  for (int r = 0; r < 16; ++r) rli[r] = __builtin_amdgcn_rcpf(li_l[crow(r, hi)]);
  bf16_t* Ow = Ob + (long)(wid * QBLK) * LDO;
#pragma unroll
  for (int r = 0; r < 16; ++r) { int orow = crow(r, hi);
#pragma unroll
    for (int d0 = 0; d0 < 4; ++d0) Ow[(long)orow * LDO + d0 * 32 + r32] = f2bf(o[d0][r] * rli[r]); }
  __syncthreads();
#undef SLOAD
#undef SWRITE
#undef SWAIT
#undef RESC
}
}

namespace hy {
__device__ __forceinline__ c2 cmul(c2 a, c2 b) { return (c2){a.x * b.x - a.y * b.y, a.x * b.y + a.y * b.x}; }
__device__ __forceinline__ c2 cmulc(c2 a, c2 b) { return (c2){a.x * b.x + a.y * b.y, a.y * b.x - a.x * b.y}; }
__device__ __forceinline__ c2 twid(float fr) { return (c2){__builtin_amdgcn_cosf(fr), -__builtin_amdgcn_sinf(fr)}; }
struct T2 { c2 w, wr; };
__device__ __forceinline__ T2 mk(c2 w) { T2 t; t.w = w; t.wr = (c2){-w.y, w.x}; return t; }
__device__ __forceinline__ c2 mulT(c2 x, const T2& t) { return x.xx * t.w + x.yy * t.wr; }
template <bool INV> __device__ __forceinline__ void r4(c2& x0, c2& x1, c2& x2, c2& x3) {
    const c2 t0 = x0 + x2, t1 = x0 - x2, t2 = x1 + x3, t3 = x1 - x3;
    const c2 r = INV ? (c2){-t3.y, t3.x} : (c2){t3.y, -t3.x};
    x0 = t0 + t2; x1 = t1 + r; x2 = t0 - t2; x3 = t1 - r;
}
template <bool INV> __device__ __forceinline__ c2 mulw(c2 x, int k) {
    const float C1 = 0.9238795325112867f, S1 = 0.3826834323650898f, R = 0.7071067811865476f;
    const float sg = INV ? -1.f : 1.f; c2 w;
    switch (k) { case 0: return x; case 1: w = (c2){C1, -S1 * sg}; break; case 2: w = (c2){R, -R * sg}; break; case 3: w = (c2){S1, -C1 * sg}; break;
                 case 4: return INV ? (c2){-x.y, x.x} : (c2){x.y, -x.x}; case 6: w = (c2){-R, -R * sg}; break; default: w = (c2){-C1, S1 * sg}; break;   }
    return x.xx * w + x.yy * (c2){-w.y, w.x};
}
template <bool INV> __device__ __forceinline__ void dft16(c2 (&e)[16]) {
#pragma unroll
    for (int a0 = 0; a0 < 4; ++a0) { r4<INV>(e[a0], e[a0 + 4], e[a0 + 8], e[a0 + 12]);
#pragma unroll
        for (int b0 = 1; b0 < 4; ++b0) e[a0 + 4 * b0] = mulw<INV>(e[a0 + 4 * b0], a0 * b0); }
#pragma unroll
    for (int b0 = 0; b0 < 4; ++b0) r4<INV>(e[4 * b0], e[4 * b0 + 1], e[4 * b0 + 2], e[4 * b0 + 3]);
#pragma unroll
    for (int b0 = 0; b0 < 4; ++b0)
#pragma unroll
        for (int b1 = b0 + 1; b1 < 4; ++b1) { const c2 t = e[b1 + 4 * b0]; e[b1 + 4 * b0] = e[b0 + 4 * b1]; e[b0 + 4 * b1] = t; }
}
template <int R, bool INV, bool TW> __device__ __forceinline__ void bfly(c2 (&e)[R], c2 th) {
    T2 t1, t2, t3, T1, T2_, T3;
    if (TW) { t1 = mk(th); t2 = mk(mulT(th, t1)); t3 = mk(mulT(t2.w, t1));
        if (R == 16) { T1 = mk(mulT(t2.w, t2)); T2_ = mk(mulT(T1.w, T1)); T3 = mk(mulT(T2_.w, T1)); } }
#define HY_APPLY_TW() do { if (R == 16) { _Pragma("unroll") for (int b1 = 0; b1 < 4; ++b1) { e[4 * b1 + 1] = mulT(e[4 * b1 + 1], t1); e[4 * b1 + 2] = mulT(e[4 * b1 + 2], t2); e[4 * b1 + 3] = mulT(e[4 * b1 + 3], t3); } \
        _Pragma("unroll") for (int b0 = 0; b0 < 4; ++b0) { e[4 + b0] = mulT(e[4 + b0], T1); e[8 + b0] = mulT(e[8 + b0], T2_); e[12 + b0] = mulT(e[12 + b0], T3); } } \
      else { e[1] = mulT(e[1], t1); e[2] = mulT(e[2], t2); e[3] = mulT(e[3], t3); } } while (0)
    if (INV && TW) HY_APPLY_TW();
    if constexpr (R == 16) dft16<INV>(e); else r4<INV>(e[0], e[1], e[2], e[3]);
    if (!INV && TW) HY_APPLY_TW();
#undef HY_APPLY_TW
}
template <int R, bool INV, int S, int LS, int NSL> __device__ __forceinline__ void fft_pass(LAS c2* X, int seqstride, int nseq, int tid) {
    const int total = nseq << NSL;
    for (int g = tid; g < total; g += 512) {
        const int q = g >> NSL, sg = g & ((1 << NSL) - 1);
        const int j0 = sg & (S - 1), blk = sg >> LS, base = blk * R * S + j0;
        LAS c2* p = X + q * seqstride + base + (base >> 4);
        constexpr int sp = (S >= 16) ? S + (S >> 4) : S;
        c2 e[R];
#pragma unroll
        for (int a = 0; a < R; ++a) e[a] = p[a * sp];
        c2 th0 = twid((float)j0 * (1.0f / (float)(R * S))); if (INV) th0.y = -th0.y;
        bfly<R, INV, (S > 1)>(e, th0);
#pragma unroll
        for (int a = 0; a < R; ++a) p[a * sp] = e[a];
    }
    __syncthreads();
}
template <int LOGN> __device__ __forceinline__ void fft_fwd(LAS c2* X, int nseq, int tid) {
    constexpr int N = 1 << LOGN, SS = N + N / 16;
    if constexpr (LOGN == 14) fft_pass<4, false, 4096, 12, LOGN - 2>(X, SS, nseq, tid);
    fft_pass<16, false, 256, 8, LOGN - 4>(X, SS, nseq, tid);
    fft_pass<16, false, 16, 4, LOGN - 4>(X, SS, nseq, tid);
    fft_pass<16, false, 1, 0, LOGN - 4>(X, SS, nseq, tid);
}
template <int LOGN> __device__ __forceinline__ void fft_inv(LAS c2* X, int nseq, int tid) {
    constexpr int N = 1 << LOGN, SS = N + N / 16;
    fft_pass<16, true, 1, 0, LOGN - 4>(X, SS, nseq, tid);
    fft_pass<16, true, 16, 4, LOGN - 4>(X, SS, nseq, tid);
    fft_pass<16, true, 256, 8, LOGN - 4>(X, SS, nseq, tid);
    if constexpr (LOGN == 14) fft_pass<4, true, 4096, 12, LOGN - 2>(X, SS, nseq, tid);
}
template <int L> __device__ __forceinline__ c2 dw3p(const bf16_t* u, int j, float w0, float w1, float w2, float b) {
    const unsigned cur = *(const unsigned*)(u + 2 * j);
    const unsigned prv = j > 0 ? *(const unsigned*)(u + 2 * j - 2) : 0u;
    const unsigned nxt = j < L / 2 - 1 ? *(const unsigned*)(u + 2 * j + 2) : 0u;
    const float xm = bfhi(prv), x0 = bflo(cur), x1 = bfhi(cur), x2 = bflo(nxt);
    return (c2){xm * w0 + x0 * w1 + x1 * w2 + b, x0 * w0 + x1 * w1 + x2 * w2 + b};
}
template <int LOGN> __device__ __forceinline__ void hyena_item(LAS c2* X, const bf16_t* UT, int Tg, const bf16_t* FT, bf16_t* ZT, int c,
                                                               const float* short_w, const float* short_b, const float* hy_skip, c2* KS, c2* YC, int tid) {
    constexpr int L = 1 << LOGN, NSEQ = (LOGN == 12) ? 2 : 1, NP2 = L / 1024, SS = L + L / 16, UNR = (LOGN == 12) ? 2 : 4;
    typedef float f4 __attribute__((ext_vector_type(4)));
    const float invL2 = 0.5f / (float)L, inv2L = 0.5f / (float)L;
    const bf16_t* u1 = UT + (size_t)c * Tg; const bf16_t* u2 = UT + (size_t)(1024 + c) * Tg; const bf16_t* uv = UT + (size_t)(2048 + c) * Tg;
    bf16_t* zt = ZT + (size_t)c * Tg;
    const float v0 = short_w[2048 + c], v1 = short_w[3072 + 2048 + c], v2 = short_w[6144 + 2048 + c], vb = short_b[2048 + c];
#define HY_LOADZ(zA, zB) do { if (n == 0) { zA = dw3p<L>(uv + oA, j, v0, v1, v2, vb); zB = dw3p<L>(uv + oB, j, v0, v1, v2, vb); } \
        else { const unsigned wa = *(const unsigned*)(zt + oA + 2 * j), wb = *(const unsigned*)(zt + oB + 2 * j); zA = (c2){bflo(wa), bfhi(wa)}; zB = (c2){bflo(wb), bfhi(wb)}; } } while (0)
#define HY_LOADK(f0, f1, b0, b1) do { const unsigned wf = *(const unsigned*)(hf + 2 * j), wA = *(const unsigned*)(hb + L - 2 * j - 2); \
        const unsigned wB = j ? *(const unsigned*)(hb + L - 2 * j) : 0u; f0 = bflo(wf); f1 = bfhi(wf); b0 = bflo(wB); b1 = bfhi(wA); } while (0)
    for (int n = 0; n < 2; ++n) {
        const bf16_t* hf = FT + (size_t)(n * 1024 + c) * L; const bf16_t* hb = FT + (size_t)((2 + n) * 1024 + c) * L;
        const float skip = hy_skip[n * 1024 + c];
        const bf16_t* ug = n ? u2 : u1; const int gr = n ? 1024 + c : c;
        const float g0 = short_w[gr], g1 = short_w[3072 + gr], g2 = short_w[6144 + gr], gb = short_b[gr];
#pragma unroll (UNR)
        for (int i = 0; i < NP2; ++i) { const int j = tid + 512 * i; float f0, f1, b0, b1; HY_LOADK(f0, f1, b0, b1);
            LAS c2* p = X + 2 * j + (j >> 3); p[0] = (c2){f0 + b0, 0.f}; p[1] = (c2){f1 + b1, 0.f}; }
        __syncthreads(); fft_fwd<LOGN>(X, 1, tid);
#pragma unroll (UNR)
        for (int i = 0; i < NP2; ++i) { const int j = tid + 512 * i; LAS c2* p = X + 2 * j + (j >> 3); const c2 a = p[0], b = p[1]; *(f4*)(KS + 2 * j) = (f4){a.x, a.y, b.x, b.y}; }
        __syncthreads();
#pragma unroll 1
        for (int q = 0; q < NSEQ; ++q)
#pragma unroll (UNR)
            for (int i = 0; i < NP2; ++i) { const int j = tid + 512 * i; const int oA = (2 * q) * L, oB = (2 * q + 1) * L; c2 zA, zB; HY_LOADZ(zA, zB);
                LAS c2* p = X + q * SS + 2 * j + (j >> 3); p[0] = (c2){zA.x, zB.x}; p[1] = (c2){zA.y, zB.y}; }
        __syncthreads(); fft_fwd<LOGN>(X, NSEQ, tid);
#pragma unroll 1
        for (int q = 0; q < NSEQ; ++q)
#pragma unroll (UNR)
            for (int i = 0; i < NP2; ++i) { const int j = tid + 512 * i; LAS c2* p = X + q * SS + 2 * j + (j >> 3); const f4 k = *(const f4*)(KS + 2 * j);
                p[0] = cmul(p[0], (c2){k[0], k[1]}); p[1] = cmul(p[1], (c2){k[2], k[3]}); }
        __syncthreads(); fft_inv<LOGN>(X, NSEQ, tid);
#pragma unroll 1
        for (int q = 0; q < NSEQ; ++q)
#pragma unroll (UNR)
            for (int i = 0; i < NP2; ++i) { const int j = tid + 512 * i; LAS c2* p = X + q * SS + 2 * j + (j >> 3); const c2 a = p[0], b = p[1]; *(f4*)(YC + q * L + 2 * j) = (f4){a.x, a.y, b.x, b.y}; }
        __syncthreads();
#pragma unroll (UNR)
        for (int i = 0; i < NP2; ++i) { const int j = tid + 512 * i; float f0, f1, b0, b1; HY_LOADK(f0, f1, b0, b1);
            LAS c2* p = X + 2 * j + (j >> 3); p[0] = twid((float)(2 * j) * inv2L) * (f0 - b0); p[1] = twid((float)(2 * j + 1) * inv2L) * (f1 - b1); }
        __syncthreads(); fft_fwd<LOGN>(X, 1, tid);
#pragma unroll (UNR)
        for (int i = 0; i < NP2; ++i) { const int j = tid + 512 * i; LAS c2* p = X + 2 * j + (j >> 3); const c2 a = p[0], b = p[1]; *(f4*)(KS + 2 * j) = (f4){a.x, a.y, b.x, b.y}; }
        __syncthreads();
#pragma unroll 1
        for (int q = 0; q < NSEQ; ++q)
#pragma unroll (UNR)
            for (int i = 0; i < NP2; ++i) { const int j = tid + 512 * i; const int oA = (2 * q) * L, oB = (2 * q + 1) * L; c2 zA, zB; HY_LOADZ(zA, zB);
                LAS c2* p = X + q * SS + 2 * j + (j >> 3); p[0] = cmul((c2){zA.x, zB.x}, twid((float)(2 * j) * inv2L)); p[1] = cmul((c2){zA.y, zB.y}, twid((float)(2 * j + 1) * inv2L)); }
        __syncthreads(); fft_fwd<LOGN>(X, NSEQ, tid);
#pragma unroll 1
        for (int q = 0; q < NSEQ; ++q)
#pragma unroll (UNR)
            for (int i = 0; i < NP2; ++i) { const int j = tid + 512 * i; LAS c2* p = X + q * SS + 2 * j + (j >> 3); const f4 k = *(const f4*)(KS + 2 * j);
                p[0] = cmul(p[0], (c2){k[0], k[1]}); p[1] = cmul(p[1], (c2){k[2], k[3]}); }
        __syncthreads(); fft_inv<LOGN>(X, NSEQ, tid);
#pragma unroll 1
        for (int q = 0; q < NSEQ; ++q)
#pragma unroll 2
            for (int i = 0; i < NP2; ++i) { const int j = tid + 512 * i; const int oA = (2 * q) * L, oB = (2 * q + 1) * L; c2 zA, zB; HY_LOADZ(zA, zB);
                LAS c2* p = X + q * SS + 2 * j + (j >> 3); const c2 yn0 = p[0], yn1 = p[1]; const f4 yc = *(const f4*)(YC + q * L + 2 * j);
                const c2 y0 = ((c2){yc[0], yc[1]} + cmulc(yn0, twid((float)(2 * j) * inv2L))) * invL2 + (c2){zA.x, zB.x} * skip;
                const c2 y1 = ((c2){yc[2], yc[3]} + cmulc(yn1, twid((float)(2 * j + 1) * inv2L))) * invL2 + (c2){zA.y, zB.y} * skip;
                const c2 gA = dw3p<L>(ug + oA, j, g0, g1, g2, gb), gB = dw3p<L>(ug + oB, j, g0, g1, g2, gb);
                *(unsigned*)(zt + oA + 2 * j) = pk(y0.x * gA.x, y1.x * gA.y); *(unsigned*)(zt + oB + 2 * j) = pk(y0.y * gB.x, y1.y * gB.y); }
        __syncthreads();
    }
#undef HY_LOADZ
#undef HY_LOADK
}
}

__device__ __forceinline__ int colmap(int mode, int n) {
    if (mode == 0) return n;
    if (mode == 1) {
        if (n >= 2816) return 704 + (n - 2816);
        if (n < 640) return n;
        if (n < 704) { const int j = n - 640; return 640 + (j >> 1) + 32 * (j & 1); }
        if (n < 2752) return 3776 + (n - 704);
        return -1;
    }
    if (n < 1024) return (n >> 7) * 192 + (n & 127);
    { const int h = (n - 1024) >> 6, j = (n - 1024) & 63; return h * 192 + 128 + (j >> 1) + 32 * (j & 1); }
}
__device__ __forceinline__ void wtrans(float* tile  , const float* src, int ld, int K, int dstN, bf16_t* dst, int mode, const float* scale, int tid) {
    const int tk = K / 64, ntiles = (dstN / 64) * tk;
    for (int t = blockIdx.x; t < ntiles; t += gridDim.x) {
        const int n0 = (t / tk) * 64, k0 = (t % tk) * 64;
        { const int nn = tid & 63, col = colmap(mode, n0 + nn);
#pragma unroll
          for (int i = 0; i < 8; ++i) { const int kk = (tid >> 6) + 8 * i; float v = 0.f; if (col >= 0) { v = src[(size_t)(k0 + kk) * ld + col]; if (scale) v *= scale[k0 + kk]; } tile[kk * 65 + nn] = v; } }
        __syncthreads();
        { const int kk = tid & 63;
#pragma unroll
          for (int i = 0; i < 8; ++i) { const int nn = (tid >> 6) + 8 * i; dst[(size_t)(n0 + nn) * K + k0 + kk] = f2bf(tile[kk * 65 + nn]); } }
        __syncthreads();
    }
}
__device__ __forceinline__ void cvt_rows(const float* src, bf16_t* dst, size_t n8, int gtid, int gthreads) {
    for (size_t i = gtid; i < n8; i += gthreads) { const f32x4 a = *(const f32x4*)(src + i * 8), b = *(const f32x4*)(src + i * 8 + 4); st8(dst + i * 8, a, b); }
}
__device__ __forceinline__ float wsum(float v) { v += __shfl_xor(v, 1); v += __shfl_xor(v, 2); v += __shfl_xor(v, 4); v += __shfl_xor(v, 8); v += __shfl_xor(v, 16); v += __shfl_xor(v, 32); return v; }
__device__ __forceinline__ void ln_rows(float* Y, const float* g, const float* b, bf16_t* Xb, int nrows, int tid) {
    const int wid = tid >> 6, lane = tid & 63;
    f32x4 gv[4], bv[4];
#pragma unroll
    for (int k = 0; k < 4; ++k) { gv[k] = *(const f32x4*)(g + k * 256 + lane * 4); bv[k] = *(const f32x4*)(b + k * 256 + lane * 4); }
    for (int row = blockIdx.x * 8 + wid; row < nrows; row += gridDim.x * 8) {
        float* y = Y + (size_t)row * 1024; f32x4 v[4]; float s = 0.f;
#pragma unroll
        for (int k = 0; k < 4; ++k) { v[k] = *(const f32x4*)(y + k * 256 + lane * 4); s += (v[k][0] + v[k][1]) + (v[k][2] + v[k][3]); }
        const float mean = wsum(s) * (1.0f / 1024.0f); float q = 0.f;
#pragma unroll
        for (int k = 0; k < 4; ++k) { v[k] = v[k] - mean; q += (v[k][0] * v[k][0] + v[k][1] * v[k][1]) + (v[k][2] * v[k][2] + v[k][3] * v[k][3]); }
        const float rstd = rsqrtf(wsum(q) * (1.0f / 1024.0f) + LN_EPS);
#pragma unroll
        for (int k = 0; k < 4; ++k) { const f32x4 o = v[k] * rstd * gv[k] + bv[k]; *(f32x4*)(y + k * 256 + lane * 4) = o;
            if (Xb) { unsigned w0 = pk(o[0], o[1]), w1 = pk(o[2], o[3]); *(uint2*)(Xb + (size_t)row * 1024 + k * 256 + lane * 4) = make_uint2(w0, w1); } }
    }
}
__device__ __forceinline__ void ffn_mid(const bf16_t* AB, bf16_t* HM, const float* dw_w, const float* dw_b, int seqmask, int gtid, int gthreads) {
    typedef float f32x2 __attribute__((ext_vector_type(2)));
    for (int idx = gtid; idx < TC * 352; idx += gthreads) {
        const int row = idx / 352, col = (idx % 352) * 8, pos = row & seqmask;
        const bf16_t* p = AB + (size_t)row * 5632 + col;
        f32x4 a0a = {0.f, 0.f, 0.f, 0.f}, a0b = a0a, a2a = a0a, a2b = a0a, a1a, a1b, ga, gb;
        ld8(p, a1a, a1b); ld8(p + 2816, ga, gb);
        if (pos > 0) ld8(p - 5632, a0a, a0b);
        if (pos < seqmask) ld8(p + 5632, a2a, a2b);
        const f32x4 w0a = *(const f32x4*)(dw_w + col), w0b = *(const f32x4*)(dw_w + col + 4), w1a = *(const f32x4*)(dw_w + 2816 + col), w1b = *(const f32x4*)(dw_w + 2816 + col + 4),
                    w2a = *(const f32x4*)(dw_w + 5632 + col), w2b = *(const f32x4*)(dw_w + 5632 + col + 4), ba = *(const f32x4*)(dw_b + col), bb = *(const f32x4*)(dw_b + col + 4);
        f32x4 ta = a0a * w0a + a1a * w1a + a2a * w2a + ba, tb = a0b * w0b + a1b * w1b + a2b * w2b + bb;
        const f32x2 r0 = pg8::gelu_pk((f32x2){ta[0], ta[1]}), r1 = pg8::gelu_pk((f32x2){ta[2], ta[3]}), r2 = pg8::gelu_pk((f32x2){tb[0], tb[1]}), r3 = pg8::gelu_pk((f32x2){tb[2], tb[3]});
        ta = (f32x4){r0.x, r0.y, r1.x, r1.y} * ga; tb = (f32x4){r2.x, r2.y, r3.x, r3.y} * gb;
        st8(HM + (size_t)row * 2816 + col, ta, tb);
    }
}
__device__ __forceinline__ void transpose_z(LAS bf16_t* tile  , const bf16_t* ZT, bf16_t* Z, int Tg, int tid) {
    const int tt = Tg / 64, ntiles = 16 * tt;
    for (int t = blockIdx.x; t < ntiles; t += gridDim.x) {
        const int c0 = (t / tt) * 64, t0 = (t % tt) * 64;
        { const int cc = tid >> 3, t8 = (tid & 7) * 8; const u32x4 w = *(const u32x4*)(ZT + (size_t)(c0 + cc) * Tg + t0 + t8);
          tile[(t8 + 0) * 72 + cc] = (bf16_t)(w.x & 0xffff); tile[(t8 + 1) * 72 + cc] = (bf16_t)(w.x >> 16); tile[(t8 + 2) * 72 + cc] = (bf16_t)(w.y & 0xffff); tile[(t8 + 3) * 72 + cc] = (bf16_t)(w.y >> 16);
          tile[(t8 + 4) * 72 + cc] = (bf16_t)(w.z & 0xffff); tile[(t8 + 5) * 72 + cc] = (bf16_t)(w.z >> 16); tile[(t8 + 6) * 72 + cc] = (bf16_t)(w.w & 0xffff); tile[(t8 + 7) * 72 + cc] = (bf16_t)(w.w >> 16); }
        __syncthreads();
        { const int r = tid >> 3, c8 = (tid & 7) * 8; const u32x4 w = *(const LAS u32x4*)(tile + r * 72 + c8); *(u32x4*)(Z + (size_t)(t0 + r) * 1024 + c0 + c8) = w; }
        __syncthreads();
    }
}

struct Params { const float* in[27]; float* out; unsigned char* ws; int lo, hi; };

__device__ __forceinline__ void prologue(const Params& P, unsigned char* smem, int tid) {
    unsigned char* ws = P.ws; float* tile = (float*)smem;
    const int gtid = blockIdx.x * 512 + tid, gthreads = gridDim.x * 512;
    wtrans(tile, P.in[2], 5824, 1024, 5888, (bf16_t*)(ws + WS_WIN), 1, nullptr, tid);
    wtrans(tile, P.in[6], 1536, 384, 1536, (bf16_t*)(ws + WS_WUQ), 2, P.in[5], tid);
    wtrans(tile, P.in[8], 2048, 256, 2048, (bf16_t*)(ws + WS_WUKV), 0, P.in[7], tid);
    wtrans(tile, P.in[9], 1024, 1024, 1024, (bf16_t*)(ws + WS_WOMLA), 0, nullptr, tid);
    wtrans(tile, P.in[17], 1024, 1024, 1024, (bf16_t*)(ws + WS_WOHY), 0, nullptr, tid);
    wtrans(tile, P.in[18], 1024, 1024, 1024, (bf16_t*)(ws + WS_WOUT), 0, nullptr, tid);
    wtrans(tile, P.in[21], 5632, 1024, 5632, (bf16_t*)(ws + WS_WUP), 0, nullptr, tid);
    wtrans(tile, P.in[24], 1024, 2816, 1024, (bf16_t*)(ws + WS_WDOWN), 0, nullptr, tid);
    { bf16_t* W3B = (bf16_t*)(ws + WS_W3B); const float* w3 = P.in[15];
      for (int i = gtid; i < 4096 * 128; i += gthreads) { const int k = i >> 12, o = i & 4095; W3B[o * 128 + k] = f2bf(w3[(k & 63) * 4096 + o]); } }
    cvt_rows(P.in[0], (bf16_t*)(P.out + (size_t)1 * TC * 1024), (size_t)TC * 1024 / 8, gtid, gthreads);
    cvt_rows(P.in[1], (bf16_t*)(P.out + (size_t)2 * TC * 1024), (size_t)2 * TC * 1024 / 8, gtid, gthreads);
    { float* cosT = (float*)(ws + WS_COS); float* sinT = (float*)(ws + WS_SIN);
      for (int i = gtid; i < 16384 * 32; i += gthreads) { const int pos = i >> 5, k = i & 31; const float inv = powf(10000.0f, -(float)(2 * k) / 64.0f); const float ang = (float)pos * inv;
          cosT[i] = cosf(ang); sinT[i] = sinf(ang); } }
    { float* ssq = (float*)(ws + WS_SSQ); for (int i = gtid; i < 3 * TC * 2; i += gthreads) ssq[i] = 0.f; }
    { bf16_t* H2B = (bf16_t*)(ws + WS_H2B); const float *w1 = P.in[10], *b1 = P.in[11], *fq = P.in[12], *w2 = P.in[13], *b2 = P.in[14];
      const int wid = tid >> 6, lane = tid & 63; const float fr = fq[lane];
      for (int row = blockIdx.x * 8 + wid; row < 20480; row += gridDim.x * 8) {
          const int L = row < 4096 ? 4096 : 16384, m = row < 4096 ? row : row - 4096;
          const float t = (float)m / (float)(L - 1); const int kb = lane & 15;
          const float band = 1e-4f + (float)kb * ((15.0f - 1e-4f) / 15.0f); const float a0 = (6.283185307179586f * (float)m) / (float)L; const float ang = a0 * band;
          const float cv = cosf(ang), sv = -sinf(ang);
          float acc = b1[lane] + t * w1[lane];
#pragma unroll
          for (int k = 0; k < 16; ++k) { acc += __shfl(cv, k) * w1[(1 + k) * 64 + lane]; acc += __shfl(sv, k) * w1[(17 + k) * 64 + lane]; }
          const float h1 = sinf(fr * acc);
          float acc2 = b2[lane];
#pragma unroll 8
          for (int k = 0; k < 64; ++k) acc2 += __shfl(h1, k) * w2[k * 64 + lane];
          const float h2 = sinf(fr * acc2);
          const bf16_t hi = f2bf(h2); H2B[(size_t)row * 128 + lane] = hi; H2B[(size_t)row * 128 + 64 + lane] = f2bf(h2 - bf2f(hi));
      } }
}

__global__ void __launch_bounds__(512, 2) mega(Params P) {
    extern __shared__ __attribute__((aligned(16))) unsigned char smem[];
    cg::grid_group grid = cg::this_grid();
    PG8_LAS unsigned char* lds = (PG8_LAS unsigned char*)smem;
    unsigned char* ws = P.ws; const int lo = P.lo, hi = P.hi;
    const int gthreads = gridDim.x * 512;
    int ph = 0;
#define PH_BEGIN if (ph >= lo && ph < hi) { int tid = threadIdx.x; asm volatile("" : "+v"(tid)); const int gtid = blockIdx.x * 512 + tid;
#define PH_END } ++ph; if (ph > lo && ph < hi) grid.sync();
    const float* cosT = (const float*)(ws + WS_COS); const float* sinT = (const float*)(ws + WS_SIN);
    bf16_t* WIN = (bf16_t*)(ws + WS_WIN);
    PH_BEGIN
#if EN_PRO
 prologue(P, smem, tid);
#endif
 PH_END
    for (int g = 0; g < 2; ++g) {
        const int L = g ? 16384 : 4096, Tg = g ? 2 * TC : TC, seqmask = L - 1;
        const bf16_t* xb = (const bf16_t*)(P.out + (size_t)(g ? 2 : 1) * TC * 1024);
        const bf16_t* H2 = (const bf16_t*)(ws + WS_H2B) + (g ? (size_t)4096 * 128 : 0);
        bf16_t* UT = (bf16_t*)(ws + WS_UT); bf16_t* FT = (bf16_t*)(ws + WS_FT); bf16_t* ZT = (bf16_t*)(ws + WS_ZT); bf16_t* Z = (bf16_t*)(ws + WS_Z);
        PH_BEGIN
            for (int rep = 0; rep < REP_G; ++rep) run_gemm<0>(lds, (const bf16_t*)(ws + WS_W3B), H2, 4096, L, 128, FFilt{FT, L});
            for (int rep = 0; rep < REP_G; ++rep) run_gemm<1>(lds, WIN + (size_t)2816 * 1024, xb, 3072, Tg, 1024, FBf{UT, (size_t)Tg});
        PH_END
        PH_BEGIN
            for (int rep = 0; rep < REP_HY; ++rep)
            for (int c = blockIdx.x; c < 1024; c += gridDim.x) {
                c2* KS = (c2*)(P.out + (size_t)(g ? 1 : 0) * TC * 1024) + (size_t)blockIdx.x * 32768; c2* YC = KS + 16384;
#if EN_HY14
                if (g) hy::hyena_item<14>((LAS c2*)smem, UT, Tg, FT, ZT, c, P.in[3], P.in[4], P.in[16], KS, YC, tid);
#endif
#if EN_HY12
                if (!g) hy::hyena_item<12>((LAS c2*)smem, UT, Tg, FT, ZT, c, P.in[3], P.in[4], P.in[16], KS, YC, tid);
#endif
            }
        PH_END
        for (int ck = 0; ck < (g ? 2 : 1); ++ck) {
            const int chunk = g ? 1 + ck : 0;
            const bf16_t* xbc = xb + (size_t)ck * TC * 1024;
            const float* xin = g ? P.in[1] + (size_t)ck * TC * 1024 : P.in[0];
            float* Y = P.out + (size_t)chunk * TC * 1024;
            float* ssq = (float*)(ws + WS_SSQ) + (size_t)chunk * TC * 2;
            bf16_t *CQ = (bf16_t*)(ws + WS_CQ), *CKV = (bf16_t*)(ws + WS_CKV), *KR = (bf16_t*)(ws + WS_KR), *G = (bf16_t*)(ws + WS_G), *Q = (bf16_t*)(ws + WS_Q), *KV = (bf16_t*)(ws + WS_KV),
                   *O = (bf16_t*)(ws + WS_O), *MG = (bf16_t*)(ws + WS_MG), *X1B = (bf16_t*)(ws + WS_X1B), *HM = (bf16_t*)(ws + WS_HM), *AB = (bf16_t*)(ws + WS_AB);
            PH_BEGIN
                if (ck == 0) transpose_z((LAS bf16_t*)smem, ZT, Z, Tg, tid);
                run_gemm<2>(lds, xbc, WIN, TC, 2816, 1024, FTm{CQ, CKV, KR, G, ssq, cosT, sinT, seqmask});
            PH_END
            PH_BEGIN
                for (int rep = 0; rep < REP_G; ++rep) run_gemm<3>(lds, CQ, (const bf16_t*)(ws + WS_WUQ), TC, 1536, 384, FQ{Q, ssq, cosT, sinT, seqmask});
                for (int rep = 0; rep < REP_G; ++rep) run_gemm<4>(lds, CKV, (const bf16_t*)(ws + WS_WUKV), TC, 2048, 256, FKV{KV, ssq});
            PH_END
            PH_BEGIN
                const int nqb = L / 256;
                for (int rep = 0; rep < REP_ATT; ++rep)
                for (int i = blockIdx.x; i < 512; i += gridDim.x) {
                    const int h = i & 7, combo = i >> 3, b = combo / nqb, qb = combo % nqb;
                    const size_t r0 = (size_t)b * L;
#if EN_ATT
                    att::attn_unit(Q + (r0 + (size_t)qb * 256) * 1536, KV + r0 * 2048 + h * 256, KV + r0 * 2048 + h * 256 + 128, KR + r0 * 64,
                                   O + (r0 + (size_t)qb * 256) * 1024 + h * 128, L, (char*)smem, h);
#endif
                }
            PH_END
            PH_BEGIN
                run_gemm<5>(lds, Z + (size_t)ck * TC * 1024, (const bf16_t*)(ws + WS_WOHY), TC, 1024, 1024, FM1{MG, G});
                run_gemm<6>(lds, O, (const bf16_t*)(ws + WS_WOMLA), TC, 1024, 1024, FM2{MG, G});
            PH_END
            PH_BEGIN
                for (int rep = 0; rep < REP_G; ++rep) run_gemm<7>(lds, MG, (const bf16_t*)(ws + WS_WOUT), TC, 1024, 1024, FOut{Y, xin});
            PH_END
            PH_BEGIN ln_rows(Y, P.in[19], P.in[20], X1B, TC, tid); PH_END
            PH_BEGIN
                for (int rep = 0; rep < REP_G; ++rep) run_gemm<8>(lds, X1B, (const bf16_t*)(ws + WS_WUP), TC, 5632, 1024, FBf{AB, (size_t)5632});
            PH_END
            PH_BEGIN for (int rep = 0; rep < REP_SM; ++rep) ffn_mid(AB, HM, P.in[22], P.in[23], seqmask, gtid, gthreads); PH_END
            PH_BEGIN
                run_gemm<9>(lds, HM, (const bf16_t*)(ws + WS_WDOWN), TC, 1024, 2816, FDown{Y});
            PH_END
            PH_BEGIN ln_rows(Y, P.in[25], P.in[26], nullptr, TC, tid); PH_END
        }
    }
}
constexpr int N_PHASES = 1 + 2 * 2 + 3 * 10;

extern "C" void kernel_launch(void* const* d_in, const int* in_sizes, int n_in, void* d_out, int out_size, void* d_ws, size_t ws_size, hipStream_t stream) {
    static int grid = 0;
    if (grid == 0) {
        if (n_in != 27 || out_size != 3 * TC * 1024 || ws_size < WS_END) { fprintf(stderr, "kernel_launch: unexpected shapes: n_in %d out %d ws %zu\n", n_in, out_size, ws_size); grid = -1; return; }
        int dev = 0, cus = 0, per_cu = 0;
        hipGetDevice(&dev); hipDeviceGetAttribute(&cus, hipDeviceAttributeMultiprocessorCount, dev);
        if (hipFuncSetAttribute((const void*)mega, hipFuncAttributeMaxDynamicSharedMemorySize, LDS_BYTES) != hipSuccess) { fprintf(stderr, "kernel_launch: hipFuncSetAttribute failed\n"); grid = -1; return; }
        if (hipOccupancyMaxActiveBlocksPerMultiprocessor(&per_cu, (const void*)mega, 512, LDS_BYTES) != hipSuccess || per_cu < 1) { fprintf(stderr, "kernel_launch: occupancy query says %d\n", per_cu); per_cu = 1; }
        (void)hipGetLastError();
        grid = cus * per_cu;
    }
    if (grid < 0) return;
    Params p{};
    for (int i = 0; i < 27; ++i) p.in[i] = (const float*)d_in[i];
    p.out = (float*)d_out; p.ws = (unsigned char*)d_ws;
#if MK_MULTI
    for (int i = 0; i < N_PHASES; ++i) { p.lo = i; p.hi = i + 1; hipLaunchKernelGGL(mega, dim3(grid), dim3(512), LDS_BYTES, stream, p); }
#else
    p.lo = 0; p.hi = N_PHASES;
    void* args[] = {&p};
    hipError_t e = hipLaunchCooperativeKernel((void*)mega, dim3(grid), dim3(512), args, LDS_BYTES, stream);
    if (e != hipSuccess) fprintf(stderr, "cooperative launch failed: %s (grid %d)\n", hipGetErrorString(e), grid);
#endif
}
```

```cpp
#include <hip/hip_runtime.h>
#include <hip/hip_cooperative_groups.h>
#include <cstdio>
#include <cstdint>
namespace cg = cooperative_groups;
namespace pg8 {
#define PG8_LAS __attribute__((address_space(3)))
typedef unsigned short bf16_t;
typedef short bf16x8 __attribute__((ext_vector_type(8)));
typedef float f32x4 __attribute__((ext_vector_type(4)));
typedef unsigned u32x4 __attribute__((ext_vector_type(4)));
constexpr int BM = 256, BK = 64, HALF = 128, HTB = HALF * BK * 2  , STAGE_BYTES = 8 * HTB, NXCD = 8, WGM = 8;

__host__ __device__ __forceinline__ int lds_byte(int r, int c) { const int st = (r >> 4) * 2 + (c >> 5), rr = r & 15, cc = c & 31, ob = rr * 64 + cc * 2; return st * 1024 + (ob ^ (((ob >> 9) & 1) << 5)); }
__host__ __device__ __forceinline__ void stage_rc(int b, int& R, int& C) { const int st = b / 1024, sb = b % 1024, swz = sb ^ (((sb >> 9) & 1) << 5); R = (st >> 1) * 16 + swz / 64; C = (st & 1) * 32 + (swz % 64) / 2; }
__host__ __device__ __forceinline__ int perm32(int rho) { const int n = rho >> 4, i = rho & 15; return 8 * (i >> 2) + 4 * n + (i & 3); }

struct Unit { int pm, pn; };
struct Gemm { const bf16_t* A; const bf16_t* Bt; int M, N, K; };

struct StaticOrder {
    int nM, nN, nwg, G, c;
    __host__ __device__ void init(int M, int N, int G_, int c_) { nM = M / BM; nN = N / BM; nwg = nM * nN; G = G_; c = c_; }
    __host__ __device__ bool next(int i, Unit& u) const {
        const long L = (long)i * G + c; if (L >= nwg) return false;
        int wgid = (int)L; { const int q = nwg / NXCD, r = nwg % NXCD, xcd = wgid % NXCD, off = wgid / NXCD; wgid = (xcd < r ? xcd * (q + 1) : r * (q + 1) + (xcd - r) * q) + off; }
        const int nig = WGM * nN, gid = wgid / nig, fm = gid * WGM, gsz = (nM - fm) < WGM ? (nM - fm) : WGM;
        u.pm = fm + ((wgid % nig) % gsz); u.pn = (wgid % nig) / gsz; return true;
    }
    __device__ __forceinline__ void a_ready(const Unit&) const {}
    __device__ __forceinline__ void done(const Unit&) const {}
};

__device__ __forceinline__ unsigned cvt_pk_bf16(float lo, float hi) { unsigned r; asm volatile("v_cvt_pk_bf16_f32 %0, %1, %2" : "=v"(r) : "v"(lo), "v"(hi)); return r; }
typedef float f32x2 __attribute__((ext_vector_type(2)));
__device__ __forceinline__ f32x2 gelu_pk(f32x2 v) {
    const f32x2 av = __builtin_elementwise_abs(v), d = av * 0.2316418882f + 1.0f;
    f32x2 t; t.x = __builtin_amdgcn_rcpf(d.x); t.y = __builtin_amdgcn_rcpf(d.y);
    f32x2 q = t * 0.5307027145f + (-0.7265760135f); q = q * t + 0.7107068705f; q = q * t + (-0.142248368f); q = q * t + 0.127414796f; q = q * t;
    const f32x2 s = (v * v) * (-0.72134752044f);
    f32x2 e; e.x = __builtin_amdgcn_exp2f(s.x); e.y = __builtin_amdgcn_exp2f(s.y);
    const f32x2 m = v * (q * e), r = v - m;
    f32x2 o; o.x = v.x < 0.f ? m.x : r.x; o.y = v.y < 0.f ? m.y : r.y; return o;
}
template <class Epi, class Sched, bool ALIGN_EPI = false, bool SP2 = false>
__device__ __forceinline__ void gemm_phase(PG8_LAS unsigned char* lds, const Gemm g, const Sched& S, const Epi& E) {
    int tid = threadIdx.x; asm volatile("" : "+v"(tid));
    const int wid = __builtin_amdgcn_readfirstlane(tid >> 6), lane = tid & 63, wr = wid >> 2, wc = wid & 3, fr = lane & 15, fq = lane >> 4;
    const int K = g.K, nt = K / BK;
    unsigned voffA[2], voffB[2];
#pragma unroll
    for (int i = 0; i < 2; ++i) { int R, C; stage_rc(tid * 16 + i * 8192, R, C); const int Rb = Epi::PERM ? ((R & ~31) + perm32(R & 31)) : R;
        voffA[i] = (unsigned)(R * K + C) * 2u; voffB[i] = (unsigned)(Rb * K + C) * 2u; }
    const size_t kstep = (size_t)(BK * 2);
    const size_t hstep = (size_t)HALF * K * 2;
    const size_t tstep = 2 * hstep;
    const unsigned ldsw = (unsigned)wid * 1024u;
    const int aoff = lds_byte(wr * 64 + fr, fq * 8), boff = lds_byte(wc * 32 + fr, fq * 8);
#define PG8_SA(b, h) (((b) * 2 + (h)) * HTB)
#define PG8_SB(b, h) ((4 + (b) * 2 + (h)) * HTB)
#define PG8_STAGE(bufoff, gbase, voff) do { _Pragma("unroll") for (int _i = 0; _i < 2; ++_i) \
        __builtin_amdgcn_global_load_lds((const unsigned*)((const char*)(gbase) + (voff)[_i]), (PG8_LAS unsigned*)(lds + (bufoff) + ldsw + _i * 8192), 16, 0, 0); } while (0)
#define PG8_LDA(dst, b, h) do { _Pragma("unroll") for (int m = 0; m < 4; ++m) _Pragma("unroll") for (int k = 0; k < 2; ++k) dst[m][k] = *(const PG8_LAS bf16x8*)(lds + PG8_SA(b, h) + aoff + m * 2048 + k * 1024); } while (0)
#define PG8_LDB(dst, b, h) do { _Pragma("unroll") for (int n = 0; n < 2; ++n) _Pragma("unroll") for (int k = 0; k < 2; ++k) dst[n][k] = *(const PG8_LAS bf16x8*)(lds + PG8_SB(b, h) + boff + n * 2048 + k * 1024); } while (0)
#define PG8_MMA(ai, bj, At, Bt) do { __builtin_amdgcn_s_setprio(1); _Pragma("unroll") for (int m = 0; m < 4; ++m) _Pragma("unroll") for (int n = 0; n < 2; ++n) _Pragma("unroll") for (int k = 0; k < 2; ++k) \
        acc[ai][bj][m][n] = __builtin_amdgcn_mfma_f32_16x16x32_bf16(Bt[n][k], At[m][k], acc[ai][bj][m][n], 0, 0, 0); __builtin_amdgcn_s_setprio(0); } while (0)
#define PG8_WAIT_V(n) asm volatile("s_waitcnt vmcnt(" #n ")" ::: "memory")
#define PG8_WAIT_L(n) asm volatile("s_waitcnt lgkmcnt(" #n ")" ::: "memory")
#define PG8_BAR __builtin_amdgcn_s_barrier()
#define PG8_SCHED __builtin_amdgcn_sched_barrier(0)
    Unit cur, nxt; int ui = 0;
    if (!S.next(0, cur)) return;
    f32x4 acc[2][2][4][2];
#pragma unroll
    for (int a = 0; a < 2; ++a)
#pragma unroll
        for (int b = 0; b < 2; ++b)
#pragma unroll
            for (int m = 0; m < 4; ++m)
#pragma unroll
                for (int n = 0; n < 2; ++n) acc[a][b][m][n] = (f32x4){0.f, 0.f, 0.f, 0.f};
    bf16x8 At[4][2], B0[2][2], B1[2][2];
    const char* cA = (const char*)g.A + (size_t)cur.pm * tstep; const char* cB = (const char*)g.Bt + (size_t)cur.pn * tstep;
    S.a_ready(cur);
    if constexpr (SP2) {
        PG8_STAGE(PG8_SB(0, 0), cB, voffB); PG8_STAGE(PG8_SB(0, 1), cB + hstep, voffB); PG8_STAGE(PG8_SA(0, 0), cA, voffA); PG8_STAGE(PG8_SA(0, 1), cA + hstep, voffA);
        if (wr == 1) PG8_BAR;
        PG8_WAIT_V(2); PG8_BAR;
        PG8_STAGE(PG8_SB(1, 0), cB + kstep, voffB); PG8_STAGE(PG8_SA(1, 0), cA + kstep, voffA); PG8_STAGE(PG8_SB(1, 1), cB + hstep + kstep, voffB);
        PG8_WAIT_V(6); PG8_BAR;
    } else {
        PG8_STAGE(PG8_SB(0, 0), cB, voffB); PG8_STAGE(PG8_SA(0, 0), cA, voffA); PG8_STAGE(PG8_SB(0, 1), cB + hstep, voffB); PG8_STAGE(PG8_SA(0, 1), cA + hstep, voffA);
        if (wr == 1) PG8_BAR;
        PG8_WAIT_V(4); PG8_BAR;
        PG8_STAGE(PG8_SB(1, 0), cB + kstep, voffB); PG8_STAGE(PG8_SA(1, 0), cA + kstep, voffA); PG8_STAGE(PG8_SB(1, 1), cB + hstep + kstep, voffB);
        PG8_WAIT_V(6); PG8_BAR;
    }
    for (;;) {
        const bool has_next = S.next(ui + 1, nxt);
        const char* nA = has_next ? (const char*)g.A + (size_t)nxt.pm * tstep : cA; const char* nB = has_next ? (const char*)g.Bt + (size_t)nxt.pn * tstep : cB;
        for (int t = 0; t < nt; t += 2) {
            const bool last = (t == nt - 2);
            const char* a1 = cA + (size_t)(t + 1) * kstep;
            const char* a2 = last ? nA : cA + (size_t)(t + 2) * kstep; const char* b2 = last ? nB : cB + (size_t)(t + 2) * kstep;
            const char* a3 = a2 + kstep; const char* b3 = b2 + kstep;
            if (last && has_next) S.a_ready(nxt);
            if constexpr (SP2) {
            PG8_LDB(B0, 0, 0); PG8_LDB(B1, 0, 1); PG8_SCHED; PG8_LDA(At, 0, 0); PG8_STAGE(PG8_SA(1, 1), a1 + hstep, voffA);
            PG8_WAIT_V(8); PG8_WAIT_L(0); PG8_BAR; PG8_MMA(0, 0, At, B0); PG8_MMA(0, 1, At, B1); PG8_BAR; PG8_SCHED;
            PG8_LDA(At, 0, 1); PG8_STAGE(PG8_SB(0, 0), b2, voffB); PG8_STAGE(PG8_SB(0, 1), b2 + hstep, voffB); PG8_STAGE(PG8_SA(0, 0), a2, voffA);
            PG8_WAIT_V(8); PG8_WAIT_L(0); PG8_BAR; PG8_MMA(1, 0, At, B0); PG8_MMA(1, 1, At, B1); PG8_BAR; PG8_SCHED;
            PG8_LDB(B0, 1, 0); PG8_LDB(B1, 1, 1); PG8_SCHED; PG8_LDA(At, 1, 0); PG8_STAGE(PG8_SA(0, 1), a2 + hstep, voffA);
            PG8_WAIT_V(8); PG8_WAIT_L(0); PG8_BAR; PG8_MMA(0, 0, At, B0); PG8_MMA(0, 1, At, B1); PG8_BAR; PG8_SCHED;
            PG8_LDA(At, 1, 1); PG8_STAGE(PG8_SB(1, 0), b3, voffB); PG8_STAGE(PG8_SB(1, 1), b3 + hstep, voffB); PG8_STAGE(PG8_SA(1, 0), a3, voffA);
            PG8_WAIT_V(8); PG8_WAIT_L(0); PG8_BAR; PG8_MMA(1, 0, At, B0); PG8_MMA(1, 1, At, B1); PG8_BAR; PG8_SCHED;
            } else {
            PG8_LDB(B0, 0, 0); PG8_SCHED; PG8_LDA(At, 0, 0); PG8_STAGE(PG8_SA(1, 1), a1 + hstep, voffA);
            PG8_WAIT_L(8); PG8_BAR; PG8_WAIT_L(0); PG8_MMA(0, 0, At, B0); PG8_BAR; PG8_SCHED;
            PG8_LDB(B1, 0, 1); PG8_STAGE(PG8_SB(0, 0), b2, voffB);
            PG8_BAR; PG8_WAIT_L(0); PG8_MMA(0, 1, At, B1); PG8_BAR;
            PG8_LDA(At, 0, 1); PG8_STAGE(PG8_SA(0, 0), a2, voffA);
            PG8_BAR; PG8_WAIT_L(0); PG8_MMA(1, 0, At, B0); PG8_BAR; PG8_SCHED;
            PG8_STAGE(PG8_SB(0, 1), b2 + hstep, voffB);
            PG8_WAIT_V(6); PG8_BAR; PG8_MMA(1, 1, At, B1); PG8_BAR;
            PG8_LDB(B0, 1, 0); PG8_SCHED; PG8_LDA(At, 1, 0); PG8_STAGE(PG8_SA(0, 1), a2 + hstep, voffA);
            PG8_WAIT_L(8); PG8_BAR; PG8_WAIT_L(0); PG8_MMA(0, 0, At, B0); PG8_BAR; PG8_SCHED;
            PG8_LDB(B1, 1, 1); PG8_STAGE(PG8_SB(1, 0), b3, voffB);
            PG8_BAR; PG8_WAIT_L(0); PG8_MMA(0, 1, At, B1); PG8_BAR;
            PG8_LDA(At, 1, 1); PG8_STAGE(PG8_SA(1, 0), a3, voffA);
            PG8_BAR; PG8_WAIT_L(0); PG8_MMA(1, 0, At, B0); PG8_BAR; PG8_SCHED;
            PG8_STAGE(PG8_SB(1, 1), b3 + hstep, voffB);
            PG8_WAIT_V(6); PG8_BAR; PG8_MMA(1, 1, At, B1); PG8_BAR;
            }
        }
        if constexpr (ALIGN_EPI) { if (wr == 0) PG8_BAR; }
        if constexpr (!Epi::AFTER_DRAIN) { E(acc, cur, wr, wc, fr, fq); S.done(cur); }
        if (!has_next) break;
#pragma unroll
        for (int a = 0; a < 2; ++a)
#pragma unroll
            for (int b = 0; b < 2; ++b)
#pragma unroll
                for (int m = 0; m < 4; ++m)
#pragma unroll
                    for (int n = 0; n < 2; ++n) acc[a][b][m][n] = (f32x4){0.f, 0.f, 0.f, 0.f};
        cur = nxt; cA = nA; cB = nB; ++ui;
        if constexpr (ALIGN_EPI) { if (wr == 1) PG8_BAR; }
    }
    PG8_WAIT_V(0);
    if constexpr (!ALIGN_EPI) { if (wr == 0) PG8_BAR; }
    PG8_BAR;
    if constexpr (Epi::AFTER_DRAIN) { E.fused(acc, cur, wr, wc, fr, fq, lds, wid, lane); S.done(cur); }
#undef PG8_SA
#undef PG8_SB
#undef PG8_STAGE
#undef PG8_LDA
#undef PG8_LDB
#undef PG8_MMA
#undef PG8_WAIT_V
#undef PG8_WAIT_L
#undef PG8_BAR
#undef PG8_SCHED
}
}

#ifndef EN_PRO
#define EN_PRO 1
#endif
#ifndef EN_HY14
#define EN_HY14 1
#endif
#ifndef EN_HY12
#define EN_HY12 1
#endif
#ifndef EN_ATT
#define EN_ATT 1
#endif
#ifndef EN_GEMM
#define EN_GEMM 0xffff
#endif
#ifndef EPI_FENCE
#define EPI_FENCE 1
#endif
#ifndef G_ALIGN
#define G_ALIGN true
#endif
#ifndef G_SP2
#define G_SP2 true
#endif
#ifndef REP_ATT
#define REP_ATT 1
#endif
#ifndef REP_HY
#define REP_HY 1
#endif
#ifndef REP_G
#define REP_G 1
#endif
#ifndef REP_SM
#define REP_SM 1
#endif
#ifndef MK_MULTI
#define MK_MULTI 0
#endif
#define LAS __attribute__((address_space(3)))
#define XB_TMO      128
#define XB_XCNT(j)  (256  + 64 * (j))
#define XB_XSUB(j)  (1280 + 64 * (j))
#define XB_XGEN(j)  (2304 + 64 * (j))
#define XB_TOP      3328
#define XB_TOPGEN   3392
#define XCD_BAR_WORDS 3456
#define XB_SPIN_CAP (1u << 18)
__device__ __forceinline__ unsigned xb_ld(unsigned* p)              { return __hip_atomic_load(p, __ATOMIC_RELAXED, __HIP_MEMORY_SCOPE_AGENT); }
__device__ __forceinline__ unsigned xb_add(unsigned* p, unsigned v) { return __hip_atomic_fetch_add(p, v, __ATOMIC_RELAXED, __HIP_MEMORY_SCOPE_AGENT); }
__device__ __forceinline__ unsigned xb_xcc_id() { return (unsigned)__builtin_amdgcn_s_getreg((3 << 11) | 20) & 0xFu; }
#define XB_SPIN(cond, bar) do { unsigned _sp = 0; while (cond) { __builtin_amdgcn_s_sleep(1); \
    if ((++_sp & 255u) == 0u) { if (xb_ld(&(bar)[XB_TMO])) break; if (_sp > XB_SPIN_CAP) { atomicAdd(&(bar)[XB_TMO], 1u); break; } } } } while (0)

struct XcdBarrier {
    unsigned* bar; unsigned x;
    volatile LAS unsigned* st;
};

__device__ __forceinline__ XcdBarrier xcd_barrier_post(unsigned* bar, volatile LAS unsigned* st) {
    XcdBarrier b; b.bar = bar; b.x = xb_xcc_id(); b.st = st;
    if (threadIdx.x == 0) (void)xb_add(&bar[XB_XCNT(b.x)], 1u);
    return b;
}
__device__ __forceinline__ void xcd_barrier_complete(unsigned* bar, unsigned x, unsigned& nloc, unsigned& nx) {
    const unsigned G = gridDim.x * gridDim.y * gridDim.z;
    unsigned sum, cnt, mine, sp = 0u;
    for (;;) {
        sum = 0u; cnt = 0u; mine = 0u;
#pragma unroll
        for (unsigned j = 0; j < 16; ++j) { const unsigned c = xb_ld(&bar[XB_XCNT(j)]); sum += c; cnt += (c > 0u) ? 1u : 0u; mine = (j == x) ? c : mine; }
        if (sum == G) break;
        __builtin_amdgcn_s_sleep(1);
        if ((++sp & 255u) == 0u) { if (xb_ld(&bar[XB_TMO])) break; if (sp > XB_SPIN_CAP) { atomicAdd(&bar[XB_TMO], 1u); break; } }
    }
    nloc = mine > 0u ? mine : 1u; nx = cnt > 0u ? cnt : 1u;
}

__device__ __forceinline__ void xcd_barrier(const XcdBarrier& b) {
    asm volatile("s_waitcnt vmcnt(0)" ::: "memory");
    __syncthreads();
    if (threadIdx.x == 0) {
        unsigned* bar = b.bar;
        __builtin_amdgcn_s_waitcnt(0);
        unsigned nloc = b.st[0], nx = b.st[1];
        if (nloc == 0u) { xcd_barrier_complete(bar, b.x, nloc, nx); b.st[0] = nloc; b.st[1] = nx; }
        const unsigned old = xb_add(&bar[XB_XSUB(b.x)], 1u);
        const unsigned gen = old / nloc;
        if (old + 1u == (gen + 1u) * nloc) {
            __builtin_amdgcn_fence(__ATOMIC_RELEASE, "agent");
            asm volatile("s_waitcnt vmcnt(0)" ::: "memory");
            const unsigned og = xb_add(&bar[XB_TOP], 1u);
            const unsigned tg = og / nx;
            if (og + 1u == (tg + 1u) * nx) xb_add(&bar[XB_TOPGEN], 1u);
            else XB_SPIN(xb_ld(&bar[XB_TOPGEN]) == tg, bar);
            __builtin_amdgcn_fence(__ATOMIC_ACQUIRE, "agent");
            xb_add(&bar[XB_XGEN(b.x)], 1u);
            asm volatile("s_waitcnt vmcnt(0)" ::: "memory");
        } else {
            XB_SPIN(xb_ld(&bar[XB_XGEN(b.x)]) == gen, bar);
            __builtin_amdgcn_fence(__ATOMIC_ACQUIRE, "agent");
            asm volatile("s_waitcnt vmcnt(0)" ::: "memory");
        }
    }
    __syncthreads();
}

using pg8::bf16_t; using pg8::f32x4; using pg8::u32x4; using pg8::Unit;
typedef float c2 __attribute__((ext_vector_type(2)));

constexpr int TC = 16384;
constexpr int LDS_FFT = 139264;
constexpr int LDS_BYTES = LDS_FFT + 16;
constexpr float DN_ALPHA = 1.189207115002721f, LN_EPS = 1e-5f, RMS_EPS = 1e-6f;
constexpr size_t MiB = 1u << 20;
constexpr size_t WS_WIN = 0, WS_WUQ = 12 * MiB, WS_WUKV = 14 * MiB, WS_WOMLA = 15 * MiB, WS_WOHY = 17 * MiB, WS_WOUT = 19 * MiB, WS_WUP = 21 * MiB,
                 WS_WDOWN = 32 * MiB, WS_W3B = 38 * MiB, WS_COS = 40 * MiB, WS_SIN = 42 * MiB, WS_H2B = 44 * MiB, WS_SSQ = 50 * MiB, WS_BAR = 51 * MiB, WS_Z = 52 * MiB,
                 WS_UT = 116 * MiB, WS_FT = 308 * MiB, WS_ZT = 436 * MiB,
                 WS_CQ = 116 * MiB, WS_CKV = 128 * MiB, WS_KR = 136 * MiB, WS_G = 138 * MiB, WS_Q = 202 * MiB, WS_KV = 250 * MiB, WS_O = 314 * MiB,
                 WS_MG = 346 * MiB, WS_X1B = 378 * MiB, WS_HM = 410 * MiB, WS_AB = 116 * MiB, WS_END = 512 * MiB;

__device__ __forceinline__ float bflo(unsigned w) { return __uint_as_float(w << 16); }
__device__ __forceinline__ float bfhi(unsigned w) { return __uint_as_float(w & 0xffff0000u); }
__device__ __forceinline__ float bf2f(bf16_t v) { return __uint_as_float(((unsigned)v) << 16); }
__device__ __forceinline__ unsigned pk(float lo, float hi) { return pg8::cvt_pk_bf16(lo, hi); }
__device__ __forceinline__ bf16_t f2bf(float v) { return (bf16_t)(pk(v, 0.f) & 0xffffu); }
__device__ __forceinline__ void st8(bf16_t* p, f32x4 a, f32x4 b) { u32x4 w; w.x = pk(a[0], a[1]); w.y = pk(a[2], a[3]); w.z = pk(b[0], b[1]); w.w = pk(b[2], b[3]); *(u32x4*)p = w; }
__device__ __forceinline__ void ld8(const bf16_t* p, f32x4& a, f32x4& b) { const u32x4 w = *(const u32x4*)p;
    a[0] = bflo(w.x); a[1] = bfhi(w.x); a[2] = bflo(w.y); a[3] = bfhi(w.y); b[0] = bflo(w.z); b[1] = bfhi(w.z); b[2] = bflo(w.w); b[3] = bfhi(w.w); }

template <class F> struct Epi8 {
    static constexpr bool PERM = true, AFTER_DRAIN = false;
    F f;
    __device__ __forceinline__ void operator()(const f32x4 (&acc)[2][2][4][2], const Unit& u, int wr, int wc, int fr, int fq) const {
        const int row0 = u.pm * pg8::BM + wr * 64 + fr, col0 = u.pn * pg8::BM + wc * 32 + 8 * fq;
#pragma unroll
        for (int ai = 0; ai < 2; ++ai)
#pragma unroll
            for (int m = 0; m < 4; ++m)
#pragma unroll
                for (int bj = 0; bj < 2; ++bj) { f(row0 + ai * pg8::HALF + m * 16, col0 + bj * pg8::HALF, acc[ai][bj][m][0], acc[ai][bj][m][1], fq);
                  if (EPI_FENCE) asm volatile("" ::: "memory"); }
    }
};
__device__ __forceinline__ void rope8(f32x4& a, f32x4& b, const float* cosT, const float* sinT, int pos, int i0) {
    const f32x4 c = *(const f32x4*)(cosT + pos * 32 + i0), s = *(const f32x4*)(sinT + pos * 32 + i0);
    f32x4 oa, ob;
    oa[0] = a[0] * c[0] - a[1] * s[0]; oa[1] = a[0] * s[0] + a[1] * c[0]; oa[2] = a[2] * c[1] - a[3] * s[1]; oa[3] = a[2] * s[1] + a[3] * c[1];
    ob[0] = b[0] * c[2] - b[1] * s[2]; ob[1] = b[0] * s[2] + b[1] * c[2]; ob[2] = b[2] * c[3] - b[3] * s[3]; ob[3] = b[2] * s[3] + b[3] * c[3];
    a = oa; b = ob;
}
__device__ __forceinline__ float sigm(float x) { return 1.0f / (1.0f + __expf(-x)); }
struct FTm { bf16_t *CQ, *CKV, *KR, *G; float* ssq; const float *cosT, *sinT; int seqmask;
    __device__ __forceinline__ void operator()(int row, int col, f32x4 a, f32x4 b, int fq) const {
        if (col < 640) {
            float s = (a[0] * a[0] + a[1] * a[1]) + (a[2] * a[2] + a[3] * a[3]) + (b[0] * b[0] + b[1] * b[1]) + (b[2] * b[2] + b[3] * b[3]);
            s += __shfl_xor(s, 16); s += __shfl_xor(s, 32);
            if (col < 384) { st8(CQ + (size_t)row * 384 + col, a, b); if (fq == 0) __hip_atomic_fetch_add(ssq + row * 2, s, __ATOMIC_RELAXED, __HIP_MEMORY_SCOPE_AGENT); }
            else { st8(CKV + (size_t)row * 256 + (col - 384), a, b); if (fq == 0) __hip_atomic_fetch_add(ssq + row * 2 + 1, s, __ATOMIC_RELAXED, __HIP_MEMORY_SCOPE_AGENT); }
        } else if (col < 704) {
            const int j = col - 640; rope8(a, b, cosT, sinT, row & seqmask, j >> 1); st8(KR + (size_t)row * 64 + j, a, b);
        } else if (col < 2752) {
#pragma unroll
            for (int i = 0; i < 4; ++i) { a[i] = sigm(a[i]); b[i] = sigm(b[i]); }
            st8(G + (size_t)row * 2048 + (col - 704), a, b);
        }
    }
};
struct FQ { bf16_t* Q; const float* ssq; const float *cosT, *sinT; int seqmask;
    __device__ __forceinline__ void operator()(int row, int col, f32x4 a, f32x4 b, int) const {
        const float rs = rsqrtf(ssq[row * 2] * (1.0f / 384.0f) + RMS_EPS); a = a * rs; b = b * rs;
        if (col >= 1024) rope8(a, b, cosT, sinT, row & seqmask, ((col - 1024) & 63) >> 1);
        st8(Q + (size_t)row * 1536 + col, a, b);
    }
};
struct FKV { bf16_t* KV; const float* ssq;
    __device__ __forceinline__ void operator()(int row, int col, f32x4 a, f32x4 b, int) const {
        const float rs = rsqrtf(ssq[row * 2 + 1] * (1.0f / 256.0f) + RMS_EPS); st8(KV + (size_t)row * 2048 + col, a * rs, b * rs);
    }
};
struct FBf { bf16_t* O; size_t ld;
    __device__ __forceinline__ void operator()(int row, int col, f32x4 a, f32x4 b, int) const { st8(O + (size_t)row * ld + col, a, b); }
};
struct FFilt { bf16_t* FT; int L;
    __device__ __forceinline__ void operator()(int row, int col, f32x4 a, f32x4 b, int) const {
        const int c = row & 1023; const float MIN_DECAY = -3.0701134573253944f, MAX_DECAY = -15.350567286626973f;
        const float kk = -1.4426950408889634f * fabsf(MIN_DECAY + (MAX_DECAY - MIN_DECAY) * ((float)c * (1.0f / 1023.0f))) / (float)(L - 1); const float fc = (float)col;
#pragma unroll
        for (int i = 0; i < 4; ++i) { a[i] *= __builtin_amdgcn_exp2f((fc + (float)i) * kk) + 0.05f; b[i] *= __builtin_amdgcn_exp2f((fc + (float)(4 + i)) * kk) + 0.05f; }
        st8(FT + (size_t)row * L + col, a, b);
    }
};
struct FM1 { bf16_t* MG; const bf16_t* G;
    __device__ __forceinline__ void operator()(int row, int col, f32x4 a, f32x4 b, int) const {
        f32x4 ga, gb; ld8(G + (size_t)row * 2048 + col, ga, gb); st8(MG + (size_t)row * 1024 + col, a * ga, b * gb);
    }
};
struct FM2 { bf16_t* MG; const bf16_t* G;
    __device__ __forceinline__ void operator()(int row, int col, f32x4 a, f32x4 b, int) const {
        f32x4 ga, gb, pa, pb; ld8(G + (size_t)row * 2048 + 1024 + col, ga, gb); ld8(MG + (size_t)row * 1024 + col, pa, pb);
        st8(MG + (size_t)row * 1024 + col, pa + a * ga, pb + b * gb);
    }
};
struct FOut { float* Y; const float* X;
    __device__ __forceinline__ void operator()(int row, int col, f32x4 a, f32x4 b, int) const {
        const size_t o = (size_t)row * 1024 + col; const f32x4 xa = *(const f32x4*)(X + o), xb = *(const f32x4*)(X + o + 4);
        *(f32x4*)(Y + o) = xa * DN_ALPHA + a; *(f32x4*)(Y + o + 4) = xb * DN_ALPHA + b;
    }
};
struct FDown { float* Y;
    __device__ __forceinline__ void operator()(int row, int col, f32x4 a, f32x4 b, int) const {
        const size_t o = (size_t)row * 1024 + col; const f32x4 xa = *(const f32x4*)(Y + o), xb = *(const f32x4*)(Y + o + 4);
        *(f32x4*)(Y + o) = xa * DN_ALPHA + a; *(f32x4*)(Y + o + 4) = xb * DN_ALPHA + b;
    }
};
template <int ID, class F> __device__ __forceinline__ void run_gemm(PG8_LAS unsigned char* lds, const bf16_t* A, const bf16_t* Bt, int M, int N, int K, const F& f) {
  if constexpr ((EN_GEMM >> ID) & 1) {
    asm volatile("" : "+s"(M), "+s"(N), "+s"(K));
    pg8::Gemm g{A, Bt, M, N, K}; pg8::StaticOrder S; S.init(M, N, (int)gridDim.x, (int)blockIdx.x);
    Epi8<F> E{f};
    pg8::gemm_phase<Epi8<F>, pg8::StaticOrder, G_ALIGN, (ID != 0 && ID != 3)>(lds, g, S, E);
  }
}

namespace att {
typedef short bf16x8 __attribute__((ext_vector_type(8)));
typedef short s16x4 __attribute__((ext_vector_type(4)));
typedef float f32x16 __attribute__((ext_vector_type(16)));
constexpr int NW = 8, QBLK = 32, KVBLK = 64, LDQ = 1536, LDK = 2048, LDKR = 64, LDO = 1024;
constexpr float SCALE = 0.07216878364870323f, THR = 8.f;
constexpr int SHM_V = 16384, SHM_K = 24576;
#define AKSWZ(row, colB) ((row) * 384 + ((colB) ^ (((row) & 7) << 4)))
#define SBAR() __builtin_amdgcn_sched_barrier(0)
__device__ __forceinline__ int crow(int r, int hi) { return (r & 3) + 8 * (r >> 2) + 4 * hi; }
__device__ __forceinline__ void partialSM(f32x16& p0, f32x16& p1, float& m_reg, float& mn, float& alpha) {
  constexpr float C = SCALE * 1.4426950408889634f;
  float pmax = p0[0]; for (int r = 1; r < 16; ++r) pmax = fmaxf(pmax, p0[r]); for (int r = 0; r < 16; ++r) pmax = fmaxf(pmax, p1[r]);
  { auto rr = __builtin_amdgcn_permlane32_swap(__float_as_uint(pmax), __float_as_uint(pmax), false, false);
    pmax = fmaxf(__uint_as_float(rr[0]), __uint_as_float(rr[1])); }
  if (__builtin_expect(__all(pmax - m_reg <= THR / SCALE), 1)) { mn = m_reg; alpha = 1.f; }
  else { mn = fmaxf(m_reg, pmax); alpha = __builtin_amdgcn_exp2f((m_reg - mn) * C); m_reg = mn; }
  float mnC = -mn * C;
  for (int r = 0; r < 16; ++r) p0[r] = fmaf(p0[r], C, mnC); for (int r = 0; r < 16; ++r) p1[r] = fmaf(p1[r], C, mnC);
  for (int r = 0; r < 16; ++r) p0[r] = __builtin_amdgcn_exp2f(p0[r]);
}
__device__ __forceinline__ void finishSM(f32x16& p0, f32x16& p1, float alpha, float& l_reg, bf16x8& pa0, bf16x8& pa1, bf16x8& pa2, bf16x8& pa3) {
  for (int r = 0; r < 16; ++r) p1[r] = __builtin_amdgcn_exp2f(p1[r]);
  float ps = 0; for (int r = 0; r < 16; ++r) ps += p0[r]; for (int r = 0; r < 16; ++r) ps += p1[r];
  { auto rr = __builtin_amdgcn_permlane32_swap(__float_as_uint(ps), __float_as_uint(ps), false, false);
    ps = __uint_as_float(rr[0]) + __uint_as_float(rr[1]); }
  l_reg = l_reg * alpha + ps;
#define PK4(P, BASE, OUT) do { unsigned a0 = pk(P[BASE + 0], P[BASE + 1]), a1 = pk(P[BASE + 2], P[BASE + 3]);   \
    unsigned b0 = pk(P[BASE + 4], P[BASE + 5]), b1 = pk(P[BASE + 6], P[BASE + 7]);                              \
    auto r0 = __builtin_amdgcn_permlane32_swap(a0, b0, false, false); auto r1 = __builtin_amdgcn_permlane32_swap(a1, b1, false, false); \
    u32x4 w = {r0[0], r1[0], r0[1], r1[1]}; OUT = *reinterpret_cast<bf16x8*>(&w); } while (0)
  PK4(p0, 0, pa0); PK4(p0, 8, pa1); PK4(p1, 0, pa2); PK4(p1, 8, pa3);
#undef PK4
}
__device__ __forceinline__ void qkt(f32x16& p0, f32x16& p1, const char* Ks, const bf16x8* qr, const bf16x8* qrl, int r32, int hi) {
  p0 = f32x16{}; p1 = f32x16{};
  int kb[4];
#pragma unroll
  for (int dl = 0; dl < 4; ++dl) kb[dl] = r32 * 384 + ((dl * 32 + hi * 16) ^ ((r32 & 7) << 4));
#pragma unroll
  for (int d0 = 0; d0 < 12; ++d0) {
    bf16x8 b0 = *reinterpret_cast<const bf16x8*>(Ks + kb[d0 & 3] + (d0 >> 2) * 128);
    bf16x8 b1 = *reinterpret_cast<const bf16x8*>(Ks + kb[d0 & 3] + (d0 >> 2) * 128 + 32 * 384);
    const bf16x8 qv = (d0 < 8) ? qr[d0 & 7] : qrl[(d0 - 8) * 64];
    p0 = __builtin_amdgcn_mfma_f32_32x32x16_bf16(b0, qv, p0, 0, 0, 0);
    p1 = __builtin_amdgcn_mfma_f32_32x32x16_bf16(b1, qv, p1, 0, 0, 0); }
}
__device__ __forceinline__ int v_st(int k, int c) { const int kk = (k & ~0xC) | ((k & 4) << 1) | ((k & 8) >> 1); return ((kk >> 3) * 4 + (c >> 5)) * 512 + ((kk & 7) * 32 + (c & 31)) * 2; }
__device__ __forceinline__ int v_rd_base(int lane) { return ((lane & 3) << 3) | (((lane >> 2) & 3) << 6) | (((lane >> 4) & 1) << 5) | (((lane >> 5) & 1) << 8); }
constexpr int v_rd_off(int d0, int ks, int half) { return d0 * 512 + ks * 4096 + half * 2048; }
template <int OFF> __device__ __forceinline__ s16x4 tr_read(int vb) {
  s16x4 r; asm volatile("ds_read_b64_tr_b16 %0, %1 offset:%2" : "=&v"(r) : "v"(vb), "i"(OFF) : "memory"); return r;
}
template <int D0> __device__ __forceinline__ void pv_one(f32x16& od, int vb, bf16x8 pa0, bf16x8 pa1, bf16x8 pa2, bf16x8 pa3) {
  const s16x4 l0 = tr_read<v_rd_off(D0, 0, 0)>(vb), h0 = tr_read<v_rd_off(D0, 0, 1)>(vb), l1 = tr_read<v_rd_off(D0, 1, 0)>(vb), h1 = tr_read<v_rd_off(D0, 1, 1)>(vb);
  const s16x4 l2 = tr_read<v_rd_off(D0, 2, 0)>(vb), h2 = tr_read<v_rd_off(D0, 2, 1)>(vb), l3 = tr_read<v_rd_off(D0, 3, 0)>(vb), h3 = tr_read<v_rd_off(D0, 3, 1)>(vb);
  asm volatile("s_waitcnt lgkmcnt(0)" ::: "memory"); SBAR();
#define PKV(L, H) (bf16x8){L[0], L[1], L[2], L[3], H[0], H[1], H[2], H[3]}
  od = __builtin_amdgcn_mfma_f32_32x32x16_bf16(pa0, PKV(l0, h0), od, 0, 0, 0);
  od = __builtin_amdgcn_mfma_f32_32x32x16_bf16(pa1, PKV(l1, h1), od, 0, 0, 0);
  od = __builtin_amdgcn_mfma_f32_32x32x16_bf16(pa2, PKV(l2, h2), od, 0, 0, 0);
  od = __builtin_amdgcn_mfma_f32_32x32x16_bf16(pa3, PKV(l3, h3), od, 0, 0, 0);
#undef PKV
}
__device__ __forceinline__ void pv_d0(f32x16* o, int vb, bf16x8 pa0, bf16x8 pa1, bf16x8 pa2, bf16x8 pa3) {
  pv_one<0>(o[0], vb, pa0, pa1, pa2, pa3); pv_one<1>(o[1], vb, pa0, pa1, pa2, pa3); pv_one<2>(o[2], vb, pa0, pa1, pa2, pa3); pv_one<3>(o[3], vb, pa0, pa1, pa2, pa3);
}
__device__ __forceinline__ void attn_unit(const bf16_t* __restrict__ Qb, const bf16_t* __restrict__ Kh, const bf16_t* __restrict__ Vh, const bf16_t* __restrict__ KRb,
                                          bf16_t* __restrict__ Ob, int seq, char* lds, int h) {
  int tid = threadIdx.x; asm volatile("" : "+v"(tid));
  const int wid = tid >> 6, lane = tid & 63, r32 = lane & 31, hi = lane >> 5;
  char* V_lds = lds; char* K_lds = lds + 2 * SHM_V;
  float* ws = (float*)(lds + 2 * SHM_V + 2 * SHM_K) + wid * 64; float* li_l = ws; float* al_l = ws + 32;
  float m_reg = -1e30f, l_reg = 0; f32x16 o[4] = {}; bf16x8 qr[8];
  bf16x8* qrl = (bf16x8*)(lds + 2 * SHM_V + 2 * SHM_K + 2048) + wid * 256 + lane;
  const bf16_t* Qw = Qb + (long)(wid * QBLK + r32) * LDQ + hi * 8 + h * 128;
  const bf16_t* Qwr = Qb + (long)(wid * QBLK + r32) * LDQ + hi * 8 + 1024 + h * 64;
#pragma unroll
  for (int d0 = 0; d0 < 8; ++d0) qr[d0] = *reinterpret_cast<const bf16x8*>(Qw + d0 * 16);
#pragma unroll
  for (int d0 = 8; d0 < 12; ++d0) qrl[(d0 - 8) * 64] = *reinterpret_cast<const bf16x8*>(Qwr + (d0 - 8) * 16);
  const int sr = tid >> 4, sc = (tid & 15) * 8, vst0 = v_st(sr, sc), vst1 = v_st(32 + sr, sc);
  const int rr = tid >> 3, rc = (tid & 7) * 8;
  const int vb0 = (int)(uintptr_t)V_lds + v_rd_base(lane);
  bf16x8 vs0, vs1, ks0, ks1, kr0;
#define SLOAD(k0) do { vs0 = *reinterpret_cast<const bf16x8*>(&Vh[(long)((k0) + sr) * LDK + sc]); vs1 = *reinterpret_cast<const bf16x8*>(&Vh[(long)((k0) + 32 + sr) * LDK + sc]); \
    ks0 = *reinterpret_cast<const bf16x8*>(&Kh[(long)((k0) + sr) * LDK + sc]); ks1 = *reinterpret_cast<const bf16x8*>(&Kh[(long)((k0) + 32 + sr) * LDK + sc]); \
    kr0 = *reinterpret_cast<const bf16x8*>(&KRb[(long)((k0) + rr) * LDKR + rc]); } while (0)
#define SWRITE(b) do { *(bf16x8*)(V_lds + (b) * SHM_V + vst0) = vs0; *(bf16x8*)(V_lds + (b) * SHM_V + vst1) = vs1; int kc = sc * 2; \
    *(bf16x8*)(K_lds + (b) * SHM_K + AKSWZ(sr, kc)) = ks0; *(bf16x8*)(K_lds + (b) * SHM_K + AKSWZ(32 + sr, kc)) = ks1; \
    *(bf16x8*)(K_lds + (b) * SHM_K + AKSWZ(rr, 256 + rc * 2)) = kr0; } while (0)
#define SWAIT() asm volatile("s_waitcnt vmcnt(0)" ::: "memory")
#define RESC(a) do { if (__any((a) < 1.f)) { if (hi == 0) al_l[r32] = (a); asm volatile("s_waitcnt lgkmcnt(0)" ::: "memory"); \
    for (int d = 0; d < 4; ++d) for (int r = 0; r < 16; ++r) o[d][r] *= al_l[crow(r, hi)]; } } while (0)
  f32x16 pA0, pA1, pB0, pB1; float mnA, mnB, alA, alB; bf16x8 pa0, pa1, pa2, pa3; const int NT = seq / KVBLK;
  SLOAD(0); SWAIT(); SWRITE(0); __syncthreads();
  qkt(pA0, pA1, K_lds, qr, qrl, r32, hi); partialSM(pA0, pA1, m_reg, mnA, alA);
  SLOAD(KVBLK);
  SWAIT(); SWRITE(1); __syncthreads();
  for (int j = 1; j + 1 < NT; j += 2) {
    SBAR(); qkt(pB0, pB1, K_lds + SHM_K, qr, qrl, r32, hi);
    finishSM(pA0, pA1, alA, l_reg, pa0, pa1, pa2, pa3); SBAR();
    SLOAD((j + 1) * KVBLK); SBAR();
    pv_d0(o, vb0, pa0, pa1, pa2, pa3); partialSM(pB0, pB1, m_reg, mnB, alB);
    __syncthreads(); SWAIT(); SWRITE(0);
    RESC(alB); __syncthreads();
    SBAR(); qkt(pA0, pA1, K_lds, qr, qrl, r32, hi);
    finishSM(pB0, pB1, alB, l_reg, pa0, pa1, pa2, pa3); SBAR();
    SLOAD((j + 2) * KVBLK); SBAR();
    pv_d0(o, vb0 + SHM_V, pa0, pa1, pa2, pa3); partialSM(pA0, pA1, m_reg, mnA, alA);
    __syncthreads(); SWAIT(); SWRITE(1);
    RESC(alA); __syncthreads();
  }
  SBAR(); qkt(pB0, pB1, K_lds + SHM_K, qr, qrl, r32, hi);
  finishSM(pA0, pA1, alA, l_reg, pa0, pa1, pa2, pa3); SBAR();
  pv_d0(o, vb0, pa0, pa1, pa2, pa3); partialSM(pB0, pB1, m_reg, mnB, alB);
  __syncthreads(); RESC(alB);
  finishSM(pB0, pB1, alB, l_reg, pa0, pa1, pa2, pa3); SBAR();
  pv_d0(o, vb0 + SHM_V, pa0, pa1, pa2, pa3);
  if (hi == 0) li_l[r32] = l_reg; asm volatile("s_waitcnt lgkmcnt(0)" ::: "memory");
  float rli[16];
#pragma unroll
  for (int r = 0; r < 16; ++r) rli[r] = __builtin_amdgcn_rcpf(li_l[crow(r, hi)]);
  bf16_t* Ow = Ob + (long)(wid * QBLK) * LDO;
#pragma unroll
  for (int r = 0; r < 16; ++r) { int orow = crow(r, hi);
#pragma unroll
    for (int d0 = 0; d0 < 4; ++d0) Ow[(long)orow * LDO + d0 * 32 + r32] = f2bf(o[d0][r] * rli[r]); }
  __syncthreads();
#undef SLOAD
#undef SWRITE
#undef SWAIT
#undef RESC
}
}

namespace hy {
__device__ __forceinline__ c2 cmul(c2 a, c2 b) { return (c2){a.x * b.x - a.y * b.y, a.x * b.y + a.y * b.x}; }
__device__ __forceinline__ c2 cmulc(c2 a, c2 b) { return (c2){a.x * b.x + a.y * b.y, a.y * b.x - a.x * b.y}; }
__device__ __forceinline__ c2 twid(float fr) { return (c2){__builtin_amdgcn_cosf(fr), -__builtin_amdgcn_sinf(fr)}; }
struct T2 { c2 w, wr; };
__device__ __forceinline__ T2 mk(c2 w) { T2 t; t.w = w; t.wr = (c2){-w.y, w.x}; return t; }
__device__ __forceinline__ c2 mulT(c2 x, const T2& t) { return x.xx * t.w + x.yy * t.wr; }
template <bool INV> __device__ __forceinline__ void r4(c2& x0, c2& x1, c2& x2, c2& x3) {
    const c2 t0 = x0 + x2, t1 = x0 - x2, t2 = x1 + x3, t3 = x1 - x3;
    const c2 r = INV ? (c2){-t3.y, t3.x} : (c2){t3.y, -t3.x};
    x0 = t0 + t2; x1 = t1 + r; x2 = t0 - t2; x3 = t1 - r;
}
template <bool INV> __device__ __forceinline__ c2 mulw(c2 x, int k) {
    const float C1 = 0.9238795325112867f, S1 = 0.3826834323650898f, R = 0.7071067811865476f;
    const float sg = INV ? -1.f : 1.f; c2 w;
    switch (k) { case 0: return x; case 1: w = (c2){C1, -S1 * sg}; break; case 2: w = (c2){R, -R * sg}; break; case 3: w = (c2){S1, -C1 * sg}; break;
                 case 4: return INV ? (c2){-x.y, x.x} : (c2){x.y, -x.x}; case 6: w = (c2){-R, -R * sg}; break; default: w = (c2){-C1, S1 * sg}; break;   }
    return x.xx * w + x.yy * (c2){-w.y, w.x};
}
template <bool INV> __device__ __forceinline__ void dft16(c2 (&e)[16]) {
#pragma unroll
    for (int a0 = 0; a0 < 4; ++a0) { r4<INV>(e[a0], e[a0 + 4], e[a0 + 8], e[a0 + 12]);
#pragma unroll
        for (int b0 = 1; b0 < 4; ++b0) e[a0 + 4 * b0] = mulw<INV>(e[a0 + 4 * b0], a0 * b0); }
#pragma unroll
    for (int b0 = 0; b0 < 4; ++b0) r4<INV>(e[4 * b0], e[4 * b0 + 1], e[4 * b0 + 2], e[4 * b0 + 3]);
#pragma unroll
    for (int b0 = 0; b0 < 4; ++b0)
#pragma unroll
        for (int b1 = b0 + 1; b1 < 4; ++b1) { const c2 t = e[b1 + 4 * b0]; e[b1 + 4 * b0] = e[b0 + 4 * b1]; e[b0 + 4 * b1] = t; }
}
template <int R, bool INV, bool TW> __device__ __forceinline__ void bfly(c2 (&e)[R], c2 th) {
    T2 t1, t2, t3, T1, T2_, T3;
    if (TW) { t1 = mk(th); t2 = mk(mulT(th, t1)); t3 = mk(mulT(t2.w, t1));
        if (R == 16) { T1 = mk(mulT(t2.w, t2)); T2_ = mk(mulT(T1.w, T1)); T3 = mk(mulT(T2_.w, T1)); } }
#define HY_APPLY_TW() do { if (R == 16) { _Pragma("unroll") for (int b1 = 0; b1 < 4; ++b1) { e[4 * b1 + 1] = mulT(e[4 * b1 + 1], t1); e[4 * b1 + 2] = mulT(e[4 * b1 + 2], t2); e[4 * b1 + 3] = mulT(e[4 * b1 + 3], t3); } \
        _Pragma("unroll") for (int b0 = 0; b0 < 4; ++b0) { e[4 + b0] = mulT(e[4 + b0], T1); e[8 + b0] = mulT(e[8 + b0], T2_); e[12 + b0] = mulT(e[12 + b0], T3); } } \
      else { e[1] = mulT(e[1], t1); e[2] = mulT(e[2], t2); e[3] = mulT(e[3], t3); } } while (0)
    if (INV && TW) HY_APPLY_TW();
    if constexpr (R == 16) dft16<INV>(e); else r4<INV>(e[0], e[1], e[2], e[3]);
    if (!INV && TW) HY_APPLY_TW();
#undef HY_APPLY_TW
}
template <int R, bool INV, int S, int LS, int NSL> __device__ __forceinline__ void fft_pass(LAS c2* X, int seqstride, int nseq, int tid) {
    const int total = nseq << NSL;
    for (int g = tid; g < total; g += 512) {
        const int q = g >> NSL, sg = g & ((1 << NSL) - 1);
        const int j0 = sg & (S - 1), blk = sg >> LS, base = blk * R * S + j0;
        LAS c2* p = X + q * seqstride + base + (base >> 4);
        constexpr int sp = (S >= 16) ? S + (S >> 4) : S;
        c2 e[R];
#pragma unroll
        for (int a = 0; a < R; ++a) e[a] = p[a * sp];
        c2 th0 = twid((float)j0 * (1.0f / (float)(R * S))); if (INV) th0.y = -th0.y;
        bfly<R, INV, (S > 1)>(e, th0);
#pragma unroll
        for (int a = 0; a < R; ++a) p[a * sp] = e[a];
    }
    __syncthreads();
}
template <int LOGN> __device__ __forceinline__ void fft_fwd(LAS c2* X, int nseq, int tid) {
    constexpr int N = 1 << LOGN, SS = N + N / 16;
    if constexpr (LOGN == 14) fft_pass<4, false, 4096, 12, LOGN - 2>(X, SS, nseq, tid);
    fft_pass<16, false, 256, 8, LOGN - 4>(X, SS, nseq, tid);
    fft_pass<16, false, 16, 4, LOGN - 4>(X, SS, nseq, tid);
    fft_pass<16, false, 1, 0, LOGN - 4>(X, SS, nseq, tid);
}
template <int LOGN> __device__ __forceinline__ void fft_inv(LAS c2* X, int nseq, int tid) {
    constexpr int N = 1 << LOGN, SS = N + N / 16;
    fft_pass<16, true, 1, 0, LOGN - 4>(X, SS, nseq, tid);
    fft_pass<16, true, 16, 4, LOGN - 4>(X, SS, nseq, tid);
    fft_pass<16, true, 256, 8, LOGN - 4>(X, SS, nseq, tid);
    if constexpr (LOGN == 14) fft_pass<4, true, 4096, 12, LOGN - 2>(X, SS, nseq, tid);
}
template <int L> __device__ __forceinline__ c2 dw3p(const bf16_t* u, int j, float w0, float w1, float w2, float b) {
    const unsigned cur = *(const unsigned*)(u + 2 * j);
    const unsigned prv = j > 0 ? *(const unsigned*)(u + 2 * j - 2) : 0u;
    const unsigned nxt = j < L / 2 - 1 ? *(const unsigned*)(u + 2 * j + 2) : 0u;
    const float xm = bfhi(prv), x0 = bflo(cur), x1 = bfhi(cur), x2 = bflo(nxt);
    return (c2){xm * w0 + x0 * w1 + x1 * w2 + b, x0 * w0 + x1 * w1 + x2 * w2 + b};
}
template <int LOGN> __device__ __forceinline__ void hyena_item(LAS c2* X, const bf16_t* UT, int Tg, const bf16_t* FT, bf16_t* ZT, int c,
                                                               const float* short_w, const float* short_b, const float* hy_skip, c2* KS, c2* YC, int tid) {
    constexpr int L = 1 << LOGN, NSEQ = (LOGN == 12) ? 2 : 1, NP2 = L / 1024, SS = L + L / 16, UNR = (LOGN == 12) ? 2 : 4;
    typedef float f4 __attribute__((ext_vector_type(4)));
    const float invL2 = 0.5f / (float)L, inv2L = 0.5f / (float)L;
    const bf16_t* u1 = UT + (size_t)c * Tg; const bf16_t* u2 = UT + (size_t)(1024 + c) * Tg; const bf16_t* uv = UT + (size_t)(2048 + c) * Tg;
    bf16_t* zt = ZT + (size_t)c * Tg;
    const float v0 = short_w[2048 + c], v1 = short_w[3072 + 2048 + c], v2 = short_w[6144 + 2048 + c], vb = short_b[2048 + c];
#define HY_LOADZ(zA, zB) do { if (n == 0) { zA = dw3p<L>(uv + oA, j, v0, v1, v2, vb); zB = dw3p<L>(uv + oB, j, v0, v1, v2, vb); } \
        else { const unsigned wa = *(const unsigned*)(zt + oA + 2 * j), wb = *(const unsigned*)(zt + oB + 2 * j); zA = (c2){bflo(wa), bfhi(wa)}; zB = (c2){bflo(wb), bfhi(wb)}; } } while (0)
#define HY_LOADK(f0, f1, b0, b1) do { const unsigned wf = *(const unsigned*)(hf + 2 * j), wA = *(const unsigned*)(hb + L - 2 * j - 2); \
        const unsigned wB = j ? *(const unsigned*)(hb + L - 2 * j) : 0u; f0 = bflo(wf); f1 = bfhi(wf); b0 = bflo(wB); b1 = bfhi(wA); } while (0)
    for (int n = 0; n < 2; ++n) {
        const bf16_t* hf = FT + (size_t)(n * 1024 + c) * L; const bf16_t* hb = FT + (size_t)((2 + n) * 1024 + c) * L;
        const float skip = hy_skip[n * 1024 + c];
        const bf16_t* ug = n ? u2 : u1; const int gr = n ? 1024 + c : c;
        const float g0 = short_w[gr], g1 = short_w[3072 + gr], g2 = short_w[6144 + gr], gb = short_b[gr];
#pragma unroll (UNR)
        for (int i = 0; i < NP2; ++i) { const int j = tid + 512 * i; float f0, f1, b0, b1; HY_LOADK(f0, f1, b0, b1);
            LAS c2* p = X + 2 * j + (j >> 3); p[0] = (c2){f0 + b0, 0.f}; p[1] = (c2){f1 + b1, 0.f}; }
        __syncthreads(); fft_fwd<LOGN>(X, 1, tid);
#pragma unroll (UNR)
        for (int i = 0; i < NP2; ++i) { const int j = tid + 512 * i; LAS c2* p = X + 2 * j + (j >> 3); const c2 a = p[0], b = p[1]; *(f4*)(KS + 2 * j) = (f4){a.x, a.y, b.x, b.y}; }
        __syncthreads();
#pragma unroll 1
        for (int q = 0; q < NSEQ; ++q)
#pragma unroll (UNR)
            for (int i = 0; i < NP2; ++i) { const int j = tid + 512 * i; const int oA = (2 * q) * L, oB = (2 * q + 1) * L; c2 zA, zB; HY_LOADZ(zA, zB);
                LAS c2* p = X + q * SS + 2 * j + (j >> 3); p[0] = (c2){zA.x, zB.x}; p[1] = (c2){zA.y, zB.y}; }
        __syncthreads(); fft_fwd<LOGN>(X, NSEQ, tid);
#pragma unroll 1
        for (int q = 0; q < NSEQ; ++q)
#pragma unroll (UNR)
            for (int i = 0; i < NP2; ++i) { const int j = tid + 512 * i; LAS c2* p = X + q * SS + 2 * j + (j >> 3); const f4 k = *(const f4*)(KS + 2 * j);
                p[0] = cmul(p[0], (c2){k[0], k[1]}); p[1] = cmul(p[1], (c2){k[2], k[3]}); }
        __syncthreads(); fft_inv<LOGN>(X, NSEQ, tid);
#pragma unroll 1
        for (int q = 0; q < NSEQ; ++q)
#pragma unroll (UNR)
            for (int i = 0; i < NP2; ++i) { const int j = tid + 512 * i; LAS c2* p = X + q * SS + 2 * j + (j >> 3); const c2 a = p[0], b = p[1]; *(f4*)(YC + q * L + 2 * j) = (f4){a.x, a.y, b.x, b.y}; }
        __syncthreads();
#pragma unroll (UNR)
        for (int i = 0; i < NP2; ++i) { const int j = tid + 512 * i; float f0, f1, b0, b1; HY_LOADK(f0, f1, b0, b1);
            LAS c2* p = X + 2 * j + (j >> 3); p[0] = twid((float)(2 * j) * inv2L) * (f0 - b0); p[1] = twid((float)(2 * j + 1) * inv2L) * (f1 - b1); }
        __syncthreads(); fft_fwd<LOGN>(X, 1, tid);
#pragma unroll (UNR)
        for (int i = 0; i < NP2; ++i) { const int j = tid + 512 * i; LAS c2* p = X + 2 * j + (j >> 3); const c2 a = p[0], b = p[1]; *(f4*)(KS + 2 * j) = (f4){a.x, a.y, b.x, b.y}; }
        __syncthreads();
#pragma unroll 1
        for (int q = 0; q < NSEQ; ++q)
#pragma unroll (UNR)
            for (int i = 0; i < NP2; ++i) { const int j = tid + 512 * i; const int oA = (2 * q) * L, oB = (2 * q + 1) * L; c2 zA, zB; HY_LOADZ(zA, zB);
                LAS c2* p = X + q * SS + 2 * j + (j >> 3); p[0] = cmul((c2){zA.x, zB.x}, twid((float)(2 * j) * inv2L)); p[1] = cmul((c2){zA.y, zB.y}, twid((float)(2 * j + 1) * inv2L)); }
        __syncthreads(); fft_fwd<LOGN>(X, NSEQ, tid);
#pragma unroll 1
        for (int q = 0; q < NSEQ; ++q)
#pragma unroll (UNR)
            for (int i = 0; i < NP2; ++i) { const int j = tid + 512 * i; LAS c2* p = X + q * SS + 2 * j + (j >> 3); const f4 k = *(const f4*)(KS + 2 * j);
                p[0] = cmul(p[0], (c2){k[0], k[1]}); p[1] = cmul(p[1], (c2){k[2], k[3]}); }
        __syncthreads(); fft_inv<LOGN>(X, NSEQ, tid);
#pragma unroll 1
        for (int q = 0; q < NSEQ; ++q)
#pragma unroll 2
            for (int i = 0; i < NP2; ++i) { const int j = tid + 512 * i; const int oA = (2 * q) * L, oB = (2 * q + 1) * L; c2 zA, zB; HY_LOADZ(zA, zB);
                LAS c2* p = X + q * SS + 2 * j + (j >> 3); const c2 yn0 = p[0], yn1 = p[1]; const f4 yc = *(const f4*)(YC + q * L + 2 * j);
                const c2 y0 = ((c2){yc[0], yc[1]} + cmulc(yn0, twid((float)(2 * j) * inv2L))) * invL2 + (c2){zA.x, zB.x} * skip;
                const c2 y1 = ((c2){yc[2], yc[3]} + cmulc(yn1, twid((float)(2 * j + 1) * inv2L))) * invL2 + (c2){zA.y, zB.y} * skip;
                const c2 gA = dw3p<L>(ug + oA, j, g0, g1, g2, gb), gB = dw3p<L>(ug + oB, j, g0, g1, g2, gb);
                *(unsigned*)(zt + oA + 2 * j) = pk(y0.x * gA.x, y1.x * gA.y); *(unsigned*)(zt + oB + 2 * j) = pk(y0.y * gB.x, y1.y * gB.y); }
        __syncthreads();
    }
#undef HY_LOADZ
#undef HY_LOADK
}
}

__device__ __forceinline__ int colmap(int mode, int n) {
    if (mode == 0) return n;
    if (mode == 1) {
        if (n >= 2816) return 704 + (n - 2816);
        if (n < 640) return n;
        if (n < 704) { const int j = n - 640; return 640 + (j >> 1) + 32 * (j & 1); }
        if (n < 2752) return 3776 + (n - 704);
        return -1;
    }
    if (n < 1024) return (n >> 7) * 192 + (n & 127);
    { const int h = (n - 1024) >> 6, j = (n - 1024) & 63; return h * 192 + 128 + (j >> 1) + 32 * (j & 1); }
}
__device__ __forceinline__ void wtrans(float* tile  , const float* src, int ld, int K, int dstN, bf16_t* dst, int mode, const float* scale, int tid) {
    const int tk = K / 64, ntiles = (dstN / 64) * tk;
    for (int t = blockIdx.x; t < ntiles; t += gridDim.x) {
        const int n0 = (t / tk) * 64, k0 = (t % tk) * 64;
        { const int nn = tid & 63, col = colmap(mode, n0 + nn);
#pragma unroll
          for (int i = 0; i < 8; ++i) { const int kk = (tid >> 6) + 8 * i; float v = 0.f; if (col >= 0) { v = src[(size_t)(k0 + kk) * ld + col]; if (scale) v *= scale[k0 + kk]; } tile[kk * 65 + nn] = v; } }
        __syncthreads();
        { const int kk = tid & 63;
#pragma unroll
          for (int i = 0; i < 8; ++i) { const int nn = (tid >> 6) + 8 * i; dst[(size_t)(n0 + nn) * K + k0 + kk] = f2bf(tile[kk * 65 + nn]); } }
        __syncthreads();
    }
}
__device__ __forceinline__ void cvt_rows(const float* src, bf16_t* dst, size_t n8, int gtid, int gthreads) {
    for (size_t i = gtid; i < n8; i += gthreads) { const f32x4 a = *(const f32x4*)(src + i * 8), b = *(const f32x4*)(src + i * 8 + 4); st8(dst + i * 8, a, b); }
}
__device__ __forceinline__ float wsum(float v) { v += __shfl_xor(v, 1); v += __shfl_xor(v, 2); v += __shfl_xor(v, 4); v += __shfl_xor(v, 8); v += __shfl_xor(v, 16); v += __shfl_xor(v, 32); return v; }
__device__ __forceinline__ void ln_rows(float* Y, const float* g, const float* b, bf16_t* Xb, int nrows, int tid) {
    const int wid = tid >> 6, lane = tid & 63;
    f32x4 gv[4], bv[4];
#pragma unroll
    for (int k = 0; k < 4; ++k) { gv[k] = *(const f32x4*)(g + k * 256 + lane * 4); bv[k] = *(const f32x4*)(b + k * 256 + lane * 4); }
    for (int row = blockIdx.x * 8 + wid; row < nrows; row += gridDim.x * 8) {
        float* y = Y + (size_t)row * 1024; f32x4 v[4]; float s = 0.f;
#pragma unroll
        for (int k = 0; k < 4; ++k) { v[k] = *(const f32x4*)(y + k * 256 + lane * 4); s += (v[k][0] + v[k][1]) + (v[k][2] + v[k][3]); }
        const float mean = wsum(s) * (1.0f / 1024.0f); float q = 0.f;
#pragma unroll
        for (int k = 0; k < 4; ++k) { v[k] = v[k] - mean; q += (v[k][0] * v[k][0] + v[k][1] * v[k][1]) + (v[k][2] * v[k][2] + v[k][3] * v[k][3]); }
        const float rstd = rsqrtf(wsum(q) * (1.0f / 1024.0f) + LN_EPS);
#pragma unroll
        for (int k = 0; k < 4; ++k) { const f32x4 o = v[k] * rstd * gv[k] + bv[k]; *(f32x4*)(y + k * 256 + lane * 4) = o;
            if (Xb) { unsigned w0 = pk(o[0], o[1]), w1 = pk(o[2], o[3]); *(uint2*)(Xb + (size_t)row * 1024 + k * 256 + lane * 4) = make_uint2(w0, w1); } }
    }
}
__device__ __forceinline__ void ffn_mid(const bf16_t* AB, bf16_t* HM, const float* dw_w, const float* dw_b, int seqmask, int gtid, int gthreads) {
    typedef float f32x2 __attribute__((ext_vector_type(2)));
    for (int idx = gtid; idx < TC * 352; idx += gthreads) {
        const int row = idx / 352, col = (idx % 352) * 8, pos = row & seqmask;
        const bf16_t* p = AB + (size_t)row * 5632 + col;
        f32x4 a0a = {0.f, 0.f, 0.f, 0.f}, a0b = a0a, a2a = a0a, a2b = a0a, a1a, a1b, ga, gb;
        ld8(p, a1a, a1b); ld8(p + 2816, ga, gb);
        if (pos > 0) ld8(p - 5632, a0a, a0b);
        if (pos < seqmask) ld8(p + 5632, a2a, a2b);
        const f32x4 w0a = *(const f32x4*)(dw_w + col), w0b = *(const f32x4*)(dw_w + col + 4), w1a = *(const f32x4*)(dw_w + 2816 + col), w1b = *(const f32x4*)(dw_w + 2816 + col + 4),
                    w2a = *(const f32x4*)(dw_w + 5632 + col), w2b = *(const f32x4*)(dw_w + 5632 + col + 4), ba = *(const f32x4*)(dw_b + col), bb = *(const f32x4*)(dw_b + col + 4);
        f32x4 ta = a0a * w0a + a1a * w1a + a2a * w2a + ba, tb = a0b * w0b + a1b * w1b + a2b * w2b + bb;
        const f32x2 r0 = pg8::gelu_pk((f32x2){ta[0], ta[1]}), r1 = pg8::gelu_pk((f32x2){ta[2], ta[3]}), r2 = pg8::gelu_pk((f32x2){tb[0], tb[1]}), r3 = pg8::gelu_pk((f32x2){tb[2], tb[3]});
        ta = (f32x4){r0.x, r0.y, r1.x, r1.y} * ga; tb = (f32x4){r2.x, r2.y, r3.x, r3.y} * gb;
        st8(HM + (size_t)row * 2816 + col, ta, tb);
    }
}
__device__ __forceinline__ void transpose_z(LAS bf16_t* tile  , const bf16_t* ZT, bf16_t* Z, int Tg, int tid) {
    const int tt = Tg / 64, ntiles = 16 * tt;
    for (int t = blockIdx.x; t < ntiles; t += gridDim.x) {
        const int c0 = (t / tt) * 64, t0 = (t % tt) * 64;
        { const int cc = tid >> 3, t8 = (tid & 7) * 8; const u32x4 w = *(const u32x4*)(ZT + (size_t)(c0 + cc) * Tg + t0 + t8);
          tile[(t8 + 0) * 72 + cc] = (bf16_t)(w.x & 0xffff); tile[(t8 + 1) * 72 + cc] = (bf16_t)(w.x >> 16); tile[(t8 + 2) * 72 + cc] = (bf16_t)(w.y & 0xffff); tile[(t8 + 3) * 72 + cc] = (bf16_t)(w.y >> 16);
          tile[(t8 + 4) * 72 + cc] = (bf16_t)(w.z & 0xffff); tile[(t8 + 5) * 72 + cc] = (bf16_t)(w.z >> 16); tile[(t8 + 6) * 72 + cc] = (bf16_t)(w.w & 0xffff); tile[(t8 + 7) * 72 + cc] = (bf16_t)(w.w >> 16); }
        __syncthreads();
        { const int r = tid >> 3, c8 = (tid & 7) * 8; const u32x4 w = *(const LAS u32x4*)(tile + r * 72 + c8); *(u32x4*)(Z + (size_t)(t0 + r) * 1024 + c0 + c8) = w; }
        __syncthreads();
    }
}

struct Params { const float* in[27]; float* out; unsigned char* ws; int lo, hi; };

__device__ __forceinline__ void prologue(const Params& P, unsigned char* smem, int tid) {
    unsigned char* ws = P.ws; float* tile = (float*)smem;
    const int gtid = blockIdx.x * 512 + tid, gthreads = gridDim.x * 512;
    wtrans(tile, P.in[2], 5824, 1024, 5888, (bf16_t*)(ws + WS_WIN), 1, nullptr, tid);
    wtrans(tile, P.in[6], 1536, 384, 1536, (bf16_t*)(ws + WS_WUQ), 2, P.in[5], tid);
    wtrans(tile, P.in[8], 2048, 256, 2048, (bf16_t*)(ws + WS_WUKV), 0, P.in[7], tid);
    wtrans(tile, P.in[9], 1024, 1024, 1024, (bf16_t*)(ws + WS_WOMLA), 0, nullptr, tid);
    wtrans(tile, P.in[17], 1024, 1024, 1024, (bf16_t*)(ws + WS_WOHY), 0, nullptr, tid);
    wtrans(tile, P.in[18], 1024, 1024, 1024, (bf16_t*)(ws + WS_WOUT), 0, nullptr, tid);
    wtrans(tile, P.in[21], 5632, 1024, 5632, (bf16_t*)(ws + WS_WUP), 0, nullptr, tid);
    wtrans(tile, P.in[24], 1024, 2816, 1024, (bf16_t*)(ws + WS_WDOWN), 0, nullptr, tid);
    { bf16_t* W3B = (bf16_t*)(ws + WS_W3B); const float* w3 = P.in[15];
      for (int i = gtid; i < 4096 * 128; i += gthreads) { const int k = i >> 12, o = i & 4095; W3B[o * 128 + k] = f2bf(w3[(k & 63) * 4096 + o]); } }
    cvt_rows(P.in[0], (bf16_t*)(P.out + (size_t)1 * TC * 1024), (size_t)TC * 1024 / 8, gtid, gthreads);
    cvt_rows(P.in[1], (bf16_t*)(P.out + (size_t)2 * TC * 1024), (size_t)2 * TC * 1024 / 8, gtid, gthreads);
    { float* cosT = (float*)(ws + WS_COS); float* sinT = (float*)(ws + WS_SIN);
      for (int i = gtid; i < 16384 * 32; i += gthreads) { const int pos = i >> 5, k = i & 31; const float inv = powf(10000.0f, -(float)(2 * k) / 64.0f); const float ang = (float)pos * inv;
          cosT[i] = cosf(ang); sinT[i] = sinf(ang); } }
    { float* ssq = (float*)(ws + WS_SSQ); for (int i = gtid; i < 3 * TC * 2; i += gthreads) ssq[i] = 0.f; }
    { bf16_t* H2B = (bf16_t*)(ws + WS_H2B); const float *w1 = P.in[10], *b1 = P.in[11], *fq = P.in[12], *w2 = P.in[13], *b2 = P.in[14];
      const int wid = tid >> 6, lane = tid & 63; const float fr = fq[lane];
      for (int row = blockIdx.x * 8 + wid; row < 20480; row += gridDim.x * 8) {
          const int L = row < 4096 ? 4096 : 16384, m = row < 4096 ? row : row - 4096;
          const float t = (float)m / (float)(L - 1); const int kb = lane & 15;
          const float band = 1e-4f + (float)kb * ((15.0f - 1e-4f) / 15.0f); const float a0 = (6.283185307179586f * (float)m) / (float)L; const float ang = a0 * band;
          const float cv = cosf(ang), sv = -sinf(ang);
          float acc = b1[lane] + t * w1[lane];
#pragma unroll
          for (int k = 0; k < 16; ++k) { acc += __shfl(cv, k) * w1[(1 + k) * 64 + lane]; acc += __shfl(sv, k) * w1[(17 + k) * 64 + lane]; }
          const float h1 = sinf(fr * acc);
          float acc2 = b2[lane];
#pragma unroll 8
          for (int k = 0; k < 64; ++k) acc2 += __shfl(h1, k) * w2[k * 64 + lane];
          const float h2 = sinf(fr * acc2);
          const bf16_t hi = f2bf(h2); H2B[(size_t)row * 128 + lane] = hi; H2B[(size_t)row * 128 + 64 + lane] = f2bf(h2 - bf2f(hi));
      } }
}

__global__ void __launch_bounds__(512, 2) mega(Params P) {
    extern __shared__ __attribute__((aligned(16))) unsigned char smem[];
    cg::grid_group grid = cg::this_grid();
    PG8_LAS unsigned char* lds = (PG8_LAS unsigned char*)smem;
    unsigned char* ws = P.ws; const int lo = P.lo, hi = P.hi;
    const int gthreads = gridDim.x * 512;
    volatile LAS unsigned* xst = (volatile LAS unsigned*)(lds + LDS_FFT);
    if (threadIdx.x == 0) { xst[0] = 0u; xst[1] = 0u; }
    __syncthreads();
    XcdBarrier gbar = xcd_barrier_post((unsigned*)(ws + WS_BAR), xst);
    int ph = 0;
#define PH_BEGIN if (ph >= lo && ph < hi) { int tid = threadIdx.x; asm volatile("" : "+v"(tid)); const int gtid = blockIdx.x * 512 + tid;
#define PH_END } ++ph; if (ph > lo && ph < hi) { if (ph == 1) grid.sync(); else xcd_barrier(gbar); }
    const float* cosT = (const float*)(ws + WS_COS); const float* sinT = (const float*)(ws + WS_SIN);
    bf16_t* WIN = (bf16_t*)(ws + WS_WIN);
    PH_BEGIN
#if EN_PRO
 prologue(P, smem, tid);
#endif
 PH_END
    for (int g = 0; g < 2; ++g) {
        const int L = g ? 16384 : 4096, Tg = g ? 2 * TC : TC, seqmask = L - 1;
        const bf16_t* xb = (const bf16_t*)(P.out + (size_t)(g ? 2 : 1) * TC * 1024);
        const bf16_t* H2 = (const bf16_t*)(ws + WS_H2B) + (g ? (size_t)4096 * 128 : 0);
        bf16_t* UT = (bf16_t*)(ws + WS_UT); bf16_t* FT = (bf16_t*)(ws + WS_FT); bf16_t* ZT = (bf16_t*)(ws + WS_ZT); bf16_t* Z = (bf16_t*)(ws + WS_Z);
        PH_BEGIN
            for (int rep = 0; rep < REP_G; ++rep) run_gemm<0>(lds, (const bf16_t*)(ws + WS_W3B), H2, 4096, L, 128, FFilt{FT, L});
            for (int rep = 0; rep < REP_G; ++rep) run_gemm<1>(lds, WIN + (size_t)2816 * 1024, xb, 3072, Tg, 1024, FBf{UT, (size_t)Tg});
        PH_END
        PH_BEGIN
            for (int rep = 0; rep < REP_HY; ++rep)
            for (int c = blockIdx.x; c < 1024; c += gridDim.x) {
                c2* KS = (c2*)(P.out + (size_t)(g ? 1 : 0) * TC * 1024) + (size_t)blockIdx.x * 32768; c2* YC = KS + 16384;
#if EN_HY14
                if (g) hy::hyena_item<14>((LAS c2*)smem, UT, Tg, FT, ZT, c, P.in[3], P.in[4], P.in[16], KS, YC, tid);
#endif
#if EN_HY12
                if (!g) hy::hyena_item<12>((LAS c2*)smem, UT, Tg, FT, ZT, c, P.in[3], P.in[4], P.in[16], KS, YC, tid);
#endif
            }
        PH_END
        for (int ck = 0; ck < (g ? 2 : 1); ++ck) {
            const int chunk = g ? 1 + ck : 0;
            const bf16_t* xbc = xb + (size_t)ck * TC * 1024;
            const float* xin = g ? P.in[1] + (size_t)ck * TC * 1024 : P.in[0];
            float* Y = P.out + (size_t)chunk * TC * 1024;
            float* ssq = (float*)(ws + WS_SSQ) + (size_t)chunk * TC * 2;
            bf16_t *CQ = (bf16_t*)(ws + WS_CQ), *CKV = (bf16_t*)(ws + WS_CKV), *KR = (bf16_t*)(ws + WS_KR), *G = (bf16_t*)(ws + WS_G), *Q = (bf16_t*)(ws + WS_Q), *KV = (bf16_t*)(ws + WS_KV),
                   *O = (bf16_t*)(ws + WS_O), *MG = (bf16_t*)(ws + WS_MG), *X1B = (bf16_t*)(ws + WS_X1B), *HM = (bf16_t*)(ws + WS_HM), *AB = (bf16_t*)(ws + WS_AB);
            PH_BEGIN
                if (ck == 0) transpose_z((LAS bf16_t*)smem, ZT, Z, Tg, tid);
                run_gemm<2>(lds, xbc, WIN, TC, 2816, 1024, FTm{CQ, CKV, KR, G, ssq, cosT, sinT, seqmask});
            PH_END
            PH_BEGIN
                for (int rep = 0; rep < REP_G; ++rep) run_gemm<3>(lds, CQ, (const bf16_t*)(ws + WS_WUQ), TC, 1536, 384, FQ{Q, ssq, cosT, sinT, seqmask});
                for (int rep = 0; rep < REP_G; ++rep) run_gemm<4>(lds, CKV, (const bf16_t*)(ws + WS_WUKV), TC, 2048, 256, FKV{KV, ssq});
            PH_END
            PH_BEGIN
                const int nqb = L / 256;
                for (int rep = 0; rep < REP_ATT; ++rep)
                for (int i = blockIdx.x; i < 512; i += gridDim.x) {
                    const int h = i & 7, combo = i >> 3, b = combo / nqb, qb = combo % nqb;
                    const size_t r0 = (size_t)b * L;
#if EN_ATT
                    att::attn_unit(Q + (r0 + (size_t)qb * 256) * 1536, KV + r0 * 2048 + h * 256, KV + r0 * 2048 + h * 256 + 128, KR + r0 * 64,
                                   O + (r0 + (size_t)qb * 256) * 1024 + h * 128, L, (char*)smem, h);
#endif
                }
            PH_END
            PH_BEGIN
                run_gemm<5>(lds, Z + (size_t)ck * TC * 1024, (const bf16_t*)(ws + WS_WOHY), TC, 1024, 1024, FM1{MG, G});
                run_gemm<6>(lds, O, (const bf16_t*)(ws + WS_WOMLA), TC, 1024, 1024, FM2{MG, G});
            PH_END
            PH_BEGIN
                for (int rep = 0; rep < REP_G; ++rep) run_gemm<7>(lds, MG, (const bf16_t*)(ws + WS_WOUT), TC, 1024, 1024, FOut{Y, xin});
            PH_END
            PH_BEGIN ln_rows(Y, P.in[19], P.in[20], X1B, TC, tid); PH_END
            PH_BEGIN
                for (int rep = 0; rep < REP_G; ++rep) run_gemm<8>(lds, X1B, (const bf16_t*)(ws + WS_WUP), TC, 5632, 1024, FBf{AB, (size_t)5632});
            PH_END
            PH_BEGIN for (int rep = 0; rep < REP_SM; ++rep) ffn_mid(AB, HM, P.in[22], P.in[23], seqmask, gtid, gthreads); PH_END
            PH_BEGIN
                run_gemm<9>(lds, HM, (const bf16_t*)(ws + WS_WDOWN), TC, 1024, 2816, FDown{Y});
            PH_END
            PH_BEGIN ln_rows(Y, P.in[25], P.in[26], nullptr, TC, tid); PH_END
        }
    }
}
constexpr int N_PHASES = 1 + 2 * 2 + 3 * 10;

extern "C" void kernel_launch(void* const* d_in, const int* in_sizes, int n_in, void* d_out, int out_size, void* d_ws, size_t ws_size, hipStream_t stream) {
    static int grid = 0;
    if (grid == 0) {
        if (n_in != 27 || out_size != 3 * TC * 1024 || ws_size < WS_END) { fprintf(stderr, "kernel_launch: unexpected shapes: n_in %d out %d ws %zu\n", n_in, out_size, ws_size); grid = -1; return; }
        int dev = 0, cus = 0, per_cu = 0;
        hipGetDevice(&dev); hipDeviceGetAttribute(&cus, hipDeviceAttributeMultiprocessorCount, dev);
        if (hipFuncSetAttribute((const void*)mega, hipFuncAttributeMaxDynamicSharedMemorySize, LDS_BYTES) != hipSuccess) { fprintf(stderr, "kernel_launch: hipFuncSetAttribute failed\n"); grid = -1; return; }
        if (hipOccupancyMaxActiveBlocksPerMultiprocessor(&per_cu, (const void*)mega, 512, LDS_BYTES) != hipSuccess || per_cu < 1) { fprintf(stderr, "kernel_launch: occupancy query says %d\n", per_cu); per_cu = 1; }
        (void)hipGetLastError();
        grid = cus * per_cu;
    }
    if (grid < 0) return;
    if (hipMemsetAsync((char*)d_ws + WS_BAR, 0, XCD_BAR_WORDS * 4, stream) != hipSuccess) { fprintf(stderr, "kernel_launch: memset of barrier words failed\n"); return; }
    Params p{};
    for (int i = 0; i < 27; ++i) p.in[i] = (const float*)d_in[i];
    p.out = (float*)d_out; p.ws = (unsigned char*)d_ws;
#if MK_MULTI
    for (int i = 0; i < N_PHASES; ++i) { p.lo = i; p.hi = i + 1; hipLaunchKernelGGL(mega, dim3(grid), dim3(512), LDS_BYTES, stream, p); }
#else
    p.lo = 0; p.hi = N_PHASES;
    void* args[] = {&p};
    hipError_t e = hipLaunchCooperativeKernel((void*)mega, dim3(grid), dim3(512), args, LDS_BYTES, stream);
    if (e != hipSuccess) fprintf(stderr, "cooperative launch failed: %s (grid %d)\n", hipGetErrorString(e), grid);
#endif
}
```

```cpp
#include <hip/hip_runtime.h>
#include <hip/hip_cooperative_groups.h>
#include <cstdio>
#include <cstdint>
namespace cg = cooperative_groups;
namespace pg8 {
#define PG8_LAS __attribute__((address_space(3)))
typedef unsigned short bf16_t;
typedef short bf16x8 __attribute__((ext_vector_type(8)));
typedef float f32x4 __attribute__((ext_vector_type(4)));
typedef unsigned u32x4 __attribute__((ext_vector_type(4)));
constexpr int BM = 256, BK = 64, HALF = 128, HTB = HALF * BK * 2  , STAGE_BYTES = 8 * HTB, NXCD = 8, WGM = 8;

__host__ __device__ __forceinline__ int lds_byte(int r, int c) { const int st = (r >> 4) * 2 + (c >> 5), rr = r & 15, cc = c & 31, ob = rr * 64 + cc * 2; return st * 1024 + (ob ^ (((ob >> 9) & 1) << 5)); }
__host__ __device__ __forceinline__ void stage_rc(int b, int& R, int& C) { const int st = b / 1024, sb = b % 1024, swz = sb ^ (((sb >> 9) & 1) << 5); R = (st >> 1) * 16 + swz / 64; C = (st & 1) * 32 + (swz % 64) / 2; }
__host__ __device__ __forceinline__ int perm32(int rho) { const int n = rho >> 4, i = rho & 15; return 8 * (i >> 2) + 4 * n + (i & 3); }

struct Unit { int pm, pn; };
struct Gemm { const bf16_t* A; const bf16_t* Bt; int M, N, K; };

struct StaticOrder {
    int nM, nN, nwg, G, c;
    __host__ __device__ void init(int M, int N, int G_, int c_) { nM = M / BM; nN = N / BM; nwg = nM * nN; G = G_; c = c_; }
    __host__ __device__ bool next(int i, Unit& u) const {
        const long L = (long)i * G + c; if (L >= nwg) return false;
        int wgid = (int)L; { const int q = nwg / NXCD, r = nwg % NXCD, xcd = wgid % NXCD, off = wgid / NXCD; wgid = (xcd < r ? xcd * (q + 1) : r * (q + 1) + (xcd - r) * q) + off; }
        const int nig = WGM * nN, gid = wgid / nig, fm = gid * WGM, gsz = (nM - fm) < WGM ? (nM - fm) : WGM;
        u.pm = fm + ((wgid % nig) % gsz); u.pn = (wgid % nig) / gsz; return true;
    }
    __device__ __forceinline__ void a_ready(const Unit&) const {}
    __device__ __forceinline__ void done(const Unit&) const {}
};

__device__ __forceinline__ unsigned cvt_pk_bf16(float lo, float hi) { unsigned r; asm volatile("v_cvt_pk_bf16_f32 %0, %1, %2" : "=v"(r) : "v"(lo), "v"(hi)); return r; }
typedef float f32x2 __attribute__((ext_vector_type(2)));
__device__ __forceinline__ f32x2 gelu_pk(f32x2 v) {
    const f32x2 av = __builtin_elementwise_abs(v), d = av * 0.2316418882f + 1.0f;
    f32x2 t; t.x = __builtin_amdgcn_rcpf(d.x); t.y = __builtin_amdgcn_rcpf(d.y);
    f32x2 q = t * 0.5307027145f + (-0.7265760135f); q = q * t + 0.7107068705f; q = q * t + (-0.142248368f); q = q * t + 0.127414796f; q = q * t;
    const f32x2 s = (v * v) * (-0.72134752044f);
    f32x2 e; e.x = __builtin_amdgcn_exp2f(s.x); e.y = __builtin_amdgcn_exp2f(s.y);
    const f32x2 m = v * (q * e), r = v - m;
    f32x2 o; o.x = v.x < 0.f ? m.x : r.x; o.y = v.y < 0.f ? m.y : r.y; return o;
}
template <class Epi, class Sched, bool ALIGN_EPI = false, bool SP2 = false>
__device__ __forceinline__ void gemm_phase(PG8_LAS unsigned char* lds, const Gemm g, const Sched& S, const Epi& E) {
    int tid = threadIdx.x; asm volatile("" : "+v"(tid));
    const int wid = __builtin_amdgcn_readfirstlane(tid >> 6), lane = tid & 63, wr = wid >> 2, wc = wid & 3, fr = lane & 15, fq = lane >> 4;
    const int K = g.K, nt = K / BK;
    unsigned voffA[2], voffB[2];
#pragma unroll
    for (int i = 0; i < 2; ++i) { int R, C; stage_rc(tid * 16 + i * 8192, R, C); const int Rb = Epi::PERM ? ((R & ~31) + perm32(R & 31)) : R;
        voffA[i] = (unsigned)(R * K + C) * 2u; voffB[i] = (unsigned)(Rb * K + C) * 2u; }
    const size_t kstep = (size_t)(BK * 2);
    const size_t hstep = (size_t)HALF * K * 2;
    const size_t tstep = 2 * hstep;
    const unsigned ldsw = (unsigned)wid * 1024u;
    const int aoff = lds_byte(wr * 64 + fr, fq * 8), boff = lds_byte(wc * 32 + fr, fq * 8);
#define PG8_SA(b, h) (((b) * 2 + (h)) * HTB)
#define PG8_SB(b, h) ((4 + (b) * 2 + (h)) * HTB)
#define PG8_STAGE(bufoff, gbase, voff) do { _Pragma("unroll") for (int _i = 0; _i < 2; ++_i) \
        __builtin_amdgcn_global_load_lds((const unsigned*)((const char*)(gbase) + (voff)[_i]), (PG8_LAS unsigned*)(lds + (bufoff) + ldsw + _i * 8192), 16, 0, 0); } while (0)
#define PG8_LDA(dst, b, h) do { _Pragma("unroll") for (int m = 0; m < 4; ++m) _Pragma("unroll") for (int k = 0; k < 2; ++k) dst[m][k] = *(const PG8_LAS bf16x8*)(lds + PG8_SA(b, h) + aoff + m * 2048 + k * 1024); } while (0)
#define PG8_LDB(dst, b, h) do { _Pragma("unroll") for (int n = 0; n < 2; ++n) _Pragma("unroll") for (int k = 0; k < 2; ++k) dst[n][k] = *(const PG8_LAS bf16x8*)(lds + PG8_SB(b, h) + boff + n * 2048 + k * 1024); } while (0)
#define PG8_MMA(ai, bj, At, Bt) do { __builtin_amdgcn_s_setprio(1); _Pragma("unroll") for (int m = 0; m < 4; ++m) _Pragma("unroll") for (int n = 0; n < 2; ++n) _Pragma("unroll") for (int k = 0; k < 2; ++k) \
        acc[ai][bj][m][n] = __builtin_amdgcn_mfma_f32_16x16x32_bf16(Bt[n][k], At[m][k], acc[ai][bj][m][n], 0, 0, 0); __builtin_amdgcn_s_setprio(0); } while (0)
#define PG8_WAIT_V(n) asm volatile("s_waitcnt vmcnt(" #n ")" ::: "memory")
#define PG8_WAIT_L(n) asm volatile("s_waitcnt lgkmcnt(" #n ")" ::: "memory")
#define PG8_BAR __builtin_amdgcn_s_barrier()
#define PG8_SCHED __builtin_amdgcn_sched_barrier(0)
    Unit cur, nxt; int ui = 0;
    if (!S.next(0, cur)) return;
    f32x4 acc[2][2][4][2];
#pragma unroll
    for (int a = 0; a < 2; ++a)
#pragma unroll
        for (int b = 0; b < 2; ++b)
#pragma unroll
            for (int m = 0; m < 4; ++m)
#pragma unroll
                for (int n = 0; n < 2; ++n) acc[a][b][m][n] = (f32x4){0.f, 0.f, 0.f, 0.f};
    bf16x8 At[4][2], B0[2][2], B1[2][2];
    const char* cA = (const char*)g.A + (size_t)cur.pm * tstep; const char* cB = (const char*)g.Bt + (size_t)cur.pn * tstep;
    S.a_ready(cur);
    if constexpr (SP2) {
        PG8_STAGE(PG8_SB(0, 0), cB, voffB); PG8_STAGE(PG8_SB(0, 1), cB + hstep, voffB); PG8_STAGE(PG8_SA(0, 0), cA, voffA); PG8_STAGE(PG8_SA(0, 1), cA + hstep, voffA);
        if (wr == 1) PG8_BAR;
        PG8_WAIT_V(2); PG8_BAR;
        PG8_STAGE(PG8_SB(1, 0), cB + kstep, voffB); PG8_STAGE(PG8_SA(1, 0), cA + kstep, voffA); PG8_STAGE(PG8_SB(1, 1), cB + hstep + kstep, voffB);
        PG8_WAIT_V(6); PG8_BAR;
    } else {
        PG8_STAGE(PG8_SB(0, 0), cB, voffB); PG8_STAGE(PG8_SA(0, 0), cA, voffA); PG8_STAGE(PG8_SB(0, 1), cB + hstep, voffB); PG8_STAGE(PG8_SA(0, 1), cA + hstep, voffA);
        if (wr == 1) PG8_BAR;
        PG8_WAIT_V(4); PG8_BAR;
        PG8_STAGE(PG8_SB(1, 0), cB + kstep, voffB); PG8_STAGE(PG8_SA(1, 0), cA + kstep, voffA); PG8_STAGE(PG8_SB(1, 1), cB + hstep + kstep, voffB);
        PG8_WAIT_V(6); PG8_BAR;
    }
    for (;;) {
        const bool has_next = S.next(ui + 1, nxt);
        const char* nA = has_next ? (const char*)g.A + (size_t)nxt.pm * tstep : cA; const char* nB = has_next ? (const char*)g.Bt + (size_t)nxt.pn * tstep : cB;
        for (int t = 0; t < nt; t += 2) {
            const bool last = (t == nt - 2);
            const char* a1 = cA + (size_t)(t + 1) * kstep;
            const char* a2 = last ? nA : cA + (size_t)(t + 2) * kstep; const char* b2 = last ? nB : cB + (size_t)(t + 2) * kstep;
            const char* a3 = a2 + kstep; const char* b3 = b2 + kstep;
            if (last && has_next) S.a_ready(nxt);
            if constexpr (SP2) {
            PG8_LDB(B0, 0, 0); PG8_LDB(B1, 0, 1); PG8_SCHED; PG8_LDA(At, 0, 0); PG8_STAGE(PG8_SA(1, 1), a1 + hstep, voffA);
            PG8_WAIT_V(8); PG8_WAIT_L(0); PG8_BAR; PG8_MMA(0, 0, At, B0); PG8_MMA(0, 1, At, B1); PG8_BAR; PG8_SCHED;
            PG8_LDA(At, 0, 1); PG8_STAGE(PG8_SB(0, 0), b2, voffB); PG8_STAGE(PG8_SB(0, 1), b2 + hstep, voffB); PG8_STAGE(PG8_SA(0, 0), a2, voffA);
            PG8_WAIT_V(8); PG8_WAIT_L(0); PG8_BAR; PG8_MMA(1, 0, At, B0); PG8_MMA(1, 1, At, B1); PG8_BAR; PG8_SCHED;
            PG8_LDB(B0, 1, 0); PG8_LDB(B1, 1, 1); PG8_SCHED; PG8_LDA(At, 1, 0); PG8_STAGE(PG8_SA(0, 1), a2 + hstep, voffA);
            PG8_WAIT_V(8); PG8_WAIT_L(0); PG8_BAR; PG8_MMA(0, 0, At, B0); PG8_MMA(0, 1, At, B1); PG8_BAR; PG8_SCHED;
            PG8_LDA(At, 1, 1); PG8_STAGE(PG8_SB(1, 0), b3, voffB); PG8_STAGE(PG8_SB(1, 1), b3 + hstep, voffB); PG8_STAGE(PG8_SA(1, 0), a3, voffA);
            PG8_WAIT_V(8); PG8_WAIT_L(0); PG8_BAR; PG8_MMA(1, 0, At, B0); PG8_MMA(1, 1, At, B1); PG8_BAR; PG8_SCHED;
            } else {
            PG8_LDB(B0, 0, 0); PG8_SCHED; PG8_LDA(At, 0, 0); PG8_STAGE(PG8_SA(1, 1), a1 + hstep, voffA);
            PG8_WAIT_L(8); PG8_BAR; PG8_WAIT_L(0); PG8_MMA(0, 0, At, B0); PG8_BAR; PG8_SCHED;
            PG8_LDB(B1, 0, 1); PG8_STAGE(PG8_SB(0, 0), b2, voffB);
            PG8_BAR; PG8_WAIT_L(0); PG8_MMA(0, 1, At, B1); PG8_BAR;
            PG8_LDA(At, 0, 1); PG8_STAGE(PG8_SA(0, 0), a2, voffA);
            PG8_BAR; PG8_WAIT_L(0); PG8_MMA(1, 0, At, B0); PG8_BAR; PG8_SCHED;
            PG8_STAGE(PG8_SB(0, 1), b2 + hstep, voffB);
            PG8_WAIT_V(6); PG8_BAR; PG8_MMA(1, 1, At, B1); PG8_BAR;
            PG8_LDB(B0, 1, 0); PG8_SCHED; PG8_LDA(At, 1, 0); PG8_STAGE(PG8_SA(0, 1), a2 + hstep, voffA);
            PG8_WAIT_L(8); PG8_BAR; PG8_WAIT_L(0); PG8_MMA(0, 0, At, B0); PG8_BAR; PG8_SCHED;
            PG8_LDB(B1, 1, 1); PG8_STAGE(PG8_SB(1, 0), b3, voffB);
            PG8_BAR; PG8_WAIT_L(0); PG8_MMA(0, 1, At, B1); PG8_BAR;
            PG8_LDA(At, 1, 1); PG8_STAGE(PG8_SA(1, 0), a3, voffA);
            PG8_BAR; PG8_WAIT_L(0); PG8_MMA(1, 0, At, B0); PG8_BAR; PG8_SCHED;
            PG8_STAGE(PG8_SB(1, 1), b3 + hstep, voffB);
            PG8_WAIT_V(6); PG8_BAR; PG8_MMA(1, 1, At, B1); PG8_BAR;
            }
        }
        if constexpr (ALIGN_EPI) { if (wr == 0) PG8_BAR; }
        if constexpr (!Epi::AFTER_DRAIN) { E(acc, cur, wr, wc, fr, fq); S.done(cur); }
        if (!has_next) break;
#pragma unroll
        for (int a = 0; a < 2; ++a)
#pragma unroll
            for (int b = 0; b < 2; ++b)
#pragma unroll
                for (int m = 0; m < 4; ++m)
#pragma unroll
                    for (int n = 0; n < 2; ++n) acc[a][b][m][n] = (f32x4){0.f, 0.f, 0.f, 0.f};
        cur = nxt; cA = nA; cB = nB; ++ui;
        if constexpr (ALIGN_EPI) { if (wr == 1) PG8_BAR; }
    }
    PG8_WAIT_V(0);
    if constexpr (!ALIGN_EPI) { if (wr == 0) PG8_BAR; }
    PG8_BAR;
    if constexpr (Epi::AFTER_DRAIN) { E.fused(acc, cur, wr, wc, fr, fq, lds, wid, lane); S.done(cur); }
#undef PG8_SA
#undef PG8_SB
#undef PG8_STAGE
#undef PG8_LDA
#undef PG8_LDB
#undef PG8_MMA
#undef PG8_WAIT_V
#undef PG8_WAIT_L
#undef PG8_BAR
#undef PG8_SCHED
}
}

#ifndef EN_PRO
#define EN_PRO 1
#endif
#ifndef EN_HY14
#define EN_HY14 1
#endif
#ifndef EN_HY12
#define EN_HY12 1
#endif
#ifndef EN_ATT
#define EN_ATT 1
#endif
#ifndef EN_GEMM
#define EN_GEMM 0xffff
#endif
#ifndef EPI_FENCE
#define EPI_FENCE 1
#endif
#ifndef G_ALIGN
#define G_ALIGN true
#endif
#ifndef G_SP2
#define G_SP2 true
#endif
#ifndef REP_ATT
#define REP_ATT 1
#endif
#ifndef REP_HY
#define REP_HY 1
#endif
#ifndef REP_G
#define REP_G 1
#endif
#ifndef REP_SM
#define REP_SM 1
#endif
#ifndef REP_PRO
#define REP_PRO 1
#endif
#ifndef UNR_K
#define UNR_K 8
#endif
#ifndef UNR_Z
#define UNR_Z 8
#endif
#ifndef UNR_Y
#define UNR_Y 8
#endif
#ifndef UNR_F
#define UNR_F 4
#endif
#ifndef MK_MULTI
#define MK_MULTI 0
#endif
#define LAS __attribute__((address_space(3)))
#define XB_TMO      128
#define XB_XCNT(j)  (256  + 64 * (j))
#define XB_XSUB(j)  (1280 + 64 * (j))
#define XB_XGEN(j)  (2304 + 64 * (j))
#define XB_TOP      3328
#define XB_TOPGEN   3392
#define XCD_BAR_WORDS 3456
#define XB_SPIN_CAP (1u << 18)
__device__ __forceinline__ unsigned xb_ld(unsigned* p)              { return __hip_atomic_load(p, __ATOMIC_RELAXED, __HIP_MEMORY_SCOPE_AGENT); }
__device__ __forceinline__ unsigned xb_add(unsigned* p, unsigned v) { return __hip_atomic_fetch_add(p, v, __ATOMIC_RELAXED, __HIP_MEMORY_SCOPE_AGENT); }
__device__ __forceinline__ unsigned xb_xcc_id() { return (unsigned)__builtin_amdgcn_s_getreg((3 << 11) | 20) & 0xFu; }
#define XB_SPIN(cond, bar) do { unsigned _sp = 0; while (cond) { __builtin_amdgcn_s_sleep(1); \
    if ((++_sp & 255u) == 0u) { if (xb_ld(&(bar)[XB_TMO])) break; if (_sp > XB_SPIN_CAP) { atomicAdd(&(bar)[XB_TMO], 1u); break; } } } } while (0)

struct XcdBarrier {
    unsigned* bar; unsigned x;
    volatile LAS unsigned* st;
};

__device__ __forceinline__ XcdBarrier xcd_barrier_post(unsigned* bar, volatile LAS unsigned* st) {
    XcdBarrier b; b.bar = bar; b.x = xb_xcc_id(); b.st = st;
    if (threadIdx.x == 0) (void)xb_add(&bar[XB_XCNT(b.x)], 1u);
    return b;
}
__device__ __forceinline__ void xcd_barrier_complete(unsigned* bar, unsigned x, unsigned& nloc, unsigned& nx) {
    const unsigned G = gridDim.x * gridDim.y * gridDim.z;
    unsigned sum, cnt, mine, sp = 0u;
    for (;;) {
        sum = 0u; cnt = 0u; mine = 0u;
#pragma unroll
        for (unsigned j = 0; j < 16; ++j) { const unsigned c = xb_ld(&bar[XB_XCNT(j)]); sum += c; cnt += (c > 0u) ? 1u : 0u; mine = (j == x) ? c : mine; }
        if (sum == G) break;
        __builtin_amdgcn_s_sleep(1);
        if ((++sp & 255u) == 0u) { if (xb_ld(&bar[XB_TMO])) break; if (sp > XB_SPIN_CAP) { atomicAdd(&bar[XB_TMO], 1u); break; } }
    }
    nloc = mine > 0u ? mine : 1u; nx = cnt > 0u ? cnt : 1u;
}

__device__ __forceinline__ void xcd_barrier(const XcdBarrier& b) {
    asm volatile("s_waitcnt vmcnt(0)" ::: "memory");
    __syncthreads();
    if (threadIdx.x == 0) {
        unsigned* bar = b.bar;
        __builtin_amdgcn_s_waitcnt(0);
        unsigned nloc = b.st[0], nx = b.st[1];
        if (nloc == 0u) { xcd_barrier_complete(bar, b.x, nloc, nx); b.st[0] = nloc; b.st[1] = nx; }
        const unsigned old = xb_add(&bar[XB_XSUB(b.x)], 1u);
        const unsigned gen = old / nloc;
        if (old + 1u == (gen + 1u) * nloc) {
            __builtin_amdgcn_fence(__ATOMIC_RELEASE, "agent");
            asm volatile("s_waitcnt vmcnt(0)" ::: "memory");
            const unsigned og = xb_add(&bar[XB_TOP], 1u);
            const unsigned tg = og / nx;
            if (og + 1u == (tg + 1u) * nx) xb_add(&bar[XB_TOPGEN], 1u);
            else XB_SPIN(xb_ld(&bar[XB_TOPGEN]) == tg, bar);
            __builtin_amdgcn_fence(__ATOMIC_ACQUIRE, "agent");
            xb_add(&bar[XB_XGEN(b.x)], 1u);
            asm volatile("s_waitcnt vmcnt(0)" ::: "memory");
        } else {
            XB_SPIN(xb_ld(&bar[XB_XGEN(b.x)]) == gen, bar);
            __builtin_amdgcn_fence(__ATOMIC_ACQUIRE, "agent");
            asm volatile("s_waitcnt vmcnt(0)" ::: "memory");
        }
    }
    __syncthreads();
}

using pg8::bf16_t; using pg8::f32x4; using pg8::u32x4; using pg8::Unit;
typedef float c2 __attribute__((ext_vector_type(2)));

constexpr int TC = 16384;
constexpr int LDS_FFT = 139264;
constexpr int LDS_BYTES = LDS_FFT + 16;
constexpr float DN_ALPHA = 1.189207115002721f, LN_EPS = 1e-5f, RMS_EPS = 1e-6f;
constexpr size_t MiB = 1u << 20;
constexpr size_t WS_WIN = 0, WS_WUQ = 12 * MiB, WS_WUKV = 14 * MiB, WS_WOMLA = 15 * MiB, WS_WOHY = 17 * MiB, WS_WOUT = 19 * MiB, WS_WUP = 21 * MiB,
                 WS_WDOWN = 32 * MiB, WS_W3B = 38 * MiB, WS_COS = 40 * MiB, WS_SIN = 42 * MiB, WS_H2B = 44 * MiB, WS_SSQ = 50 * MiB, WS_BAR = 51 * MiB, WS_Z = 52 * MiB,
                 WS_UT = 116 * MiB, WS_FT = 308 * MiB, WS_ZT = 436 * MiB,
                 WS_CQ = 116 * MiB, WS_CKV = 128 * MiB, WS_KR = 136 * MiB, WS_G = 138 * MiB, WS_Q = 202 * MiB, WS_KV = 250 * MiB, WS_O = 314 * MiB,
                 WS_MG = 346 * MiB, WS_X1B = 378 * MiB, WS_HM = 410 * MiB, WS_AB = 116 * MiB, WS_END = 512 * MiB;

__device__ __forceinline__ float bflo(unsigned w) { return __uint_as_float(w << 16); }
__device__ __forceinline__ float bfhi(unsigned w) { return __uint_as_float(w & 0xffff0000u); }
__device__ __forceinline__ float bf2f(bf16_t v) { return __uint_as_float(((unsigned)v) << 16); }
__device__ __forceinline__ unsigned pk(float lo, float hi) { return pg8::cvt_pk_bf16(lo, hi); }
__device__ __forceinline__ bf16_t f2bf(float v) { return (bf16_t)(pk(v, 0.f) & 0xffffu); }
__device__ __forceinline__ void st8(bf16_t* p, f32x4 a, f32x4 b) { u32x4 w; w.x = pk(a[0], a[1]); w.y = pk(a[2], a[3]); w.z = pk(b[0], b[1]); w.w = pk(b[2], b[3]); *(u32x4*)p = w; }
__device__ __forceinline__ void ld8(const bf16_t* p, f32x4& a, f32x4& b) { const u32x4 w = *(const u32x4*)p;
    a[0] = bflo(w.x); a[1] = bfhi(w.x); a[2] = bflo(w.y); a[3] = bfhi(w.y); b[0] = bflo(w.z); b[1] = bfhi(w.z); b[2] = bflo(w.w); b[3] = bfhi(w.w); }

template <class F> struct Epi8 {
    static constexpr bool PERM = true, AFTER_DRAIN = false;
    F f;
    __device__ __forceinline__ void operator()(const f32x4 (&acc)[2][2][4][2], const Unit& u, int wr, int wc, int fr, int fq) const {
        const int row0 = u.pm * pg8::BM + wr * 64 + fr, col0 = u.pn * pg8::BM + wc * 32 + 8 * fq;
#pragma unroll
        for (int ai = 0; ai < 2; ++ai)
#pragma unroll
            for (int m = 0; m < 4; ++m)
#pragma unroll
                for (int bj = 0; bj < 2; ++bj) { f(row0 + ai * pg8::HALF + m * 16, col0 + bj * pg8::HALF, acc[ai][bj][m][0], acc[ai][bj][m][1], fq);
                  if (EPI_FENCE) asm volatile("" ::: "memory"); }
    }
};
__device__ __forceinline__ void rope8(f32x4& a, f32x4& b, const float* cosT, const float* sinT, int pos, int i0) {
    const f32x4 c = *(const f32x4*)(cosT + pos * 32 + i0), s = *(const f32x4*)(sinT + pos * 32 + i0);
    f32x4 oa, ob;
    oa[0] = a[0] * c[0] - a[1] * s[0]; oa[1] = a[0] * s[0] + a[1] * c[0]; oa[2] = a[2] * c[1] - a[3] * s[1]; oa[3] = a[2] * s[1] + a[3] * c[1];
    ob[0] = b[0] * c[2] - b[1] * s[2]; ob[1] = b[0] * s[2] + b[1] * c[2]; ob[2] = b[2] * c[3] - b[3] * s[3]; ob[3] = b[2] * s[3] + b[3] * c[3];
    a = oa; b = ob;
}
__device__ __forceinline__ float sigm(float x) { return 1.0f / (1.0f + __expf(-x)); }
struct FTm { bf16_t *CQ, *CKV, *KR, *G; float* ssq; const float *cosT, *sinT; int seqmask;
    __device__ __forceinline__ void operator()(int row, int col, f32x4 a, f32x4 b, int fq) const {
        if (col < 640) {
            float s = (a[0] * a[0] + a[1] * a[1]) + (a[2] * a[2] + a[3] * a[3]) + (b[0] * b[0] + b[1] * b[1]) + (b[2] * b[2] + b[3] * b[3]);
            s += __shfl_xor(s, 16); s += __shfl_xor(s, 32);
            if (col < 384) { st8(CQ + (size_t)row * 384 + col, a, b); if (fq == 0) __hip_atomic_fetch_add(ssq + row * 2, s, __ATOMIC_RELAXED, __HIP_MEMORY_SCOPE_AGENT); }
            else { st8(CKV + (size_t)row * 256 + (col - 384), a, b); if (fq == 0) __hip_atomic_fetch_add(ssq + row * 2 + 1, s, __ATOMIC_RELAXED, __HIP_MEMORY_SCOPE_AGENT); }
        } else if (col < 704) {
            const int j = col - 640; rope8(a, b, cosT, sinT, row & seqmask, j >> 1); st8(KR + (size_t)row * 64 + j, a, b);
        } else if (col < 2752) {
#pragma unroll
            for (int i = 0; i < 4; ++i) { a[i] = sigm(a[i]); b[i] = sigm(b[i]); }
            st8(G + (size_t)row * 2048 + (col - 704), a, b);
        }
    }
};
struct FQ { bf16_t* Q; const float* ssq; const float *cosT, *sinT; int seqmask;
    __device__ __forceinline__ void operator()(int row, int col, f32x4 a, f32x4 b, int) const {
        const float rs = rsqrtf(ssq[row * 2] * (1.0f / 384.0f) + RMS_EPS); a = a * rs; b = b * rs;
        if (col >= 1024) rope8(a, b, cosT, sinT, row & seqmask, ((col - 1024) & 63) >> 1);
        st8(Q + (size_t)row * 1536 + col, a, b);
    }
};
struct FKV { bf16_t* KV; const float* ssq;
    __device__ __forceinline__ void operator()(int row, int col, f32x4 a, f32x4 b, int) const {
        const float rs = rsqrtf(ssq[row * 2 + 1] * (1.0f / 256.0f) + RMS_EPS); st8(KV + (size_t)row * 2048 + col, a * rs, b * rs);
    }
};
struct FBf { bf16_t* O; size_t ld;
    __device__ __forceinline__ void operator()(int row, int col, f32x4 a, f32x4 b, int) const { st8(O + (size_t)row * ld + col, a, b); }
};
struct FFilt { bf16_t* FT; int L;
    __device__ __forceinline__ void operator()(int row, int col, f32x4 a, f32x4 b, int) const {
        const int c = row & 1023; const float MIN_DECAY = -3.0701134573253944f, MAX_DECAY = -15.350567286626973f;
        const float kk = -1.4426950408889634f * fabsf(MIN_DECAY + (MAX_DECAY - MIN_DECAY) * ((float)c * (1.0f / 1023.0f))) / (float)(L - 1); const float fc = (float)col;
#pragma unroll
        for (int i = 0; i < 4; ++i) { a[i] *= __builtin_amdgcn_exp2f((fc + (float)i) * kk) + 0.05f; b[i] *= __builtin_amdgcn_exp2f((fc + (float)(4 + i)) * kk) + 0.05f; }
        st8(FT + (size_t)row * L + col, a, b);
    }
};
struct FM1 { bf16_t* MG; const bf16_t* G;
    __device__ __forceinline__ void operator()(int row, int col, f32x4 a, f32x4 b, int) const {
        f32x4 ga, gb; ld8(G + (size_t)row * 2048 + col, ga, gb); st8(MG + (size_t)row * 1024 + col, a * ga, b * gb);
    }
};
struct FM2 { bf16_t* MG; const bf16_t* G;
    __device__ __forceinline__ void operator()(int row, int col, f32x4 a, f32x4 b, int) const {
        f32x4 ga, gb, pa, pb; ld8(G + (size_t)row * 2048 + 1024 + col, ga, gb); ld8(MG + (size_t)row * 1024 + col, pa, pb);
        st8(MG + (size_t)row * 1024 + col, pa + a * ga, pb + b * gb);
    }
};
struct FOut { float* Y; const float* X;
    __device__ __forceinline__ void operator()(int row, int col, f32x4 a, f32x4 b, int) const {
        const size_t o = (size_t)row * 1024 + col; const f32x4 xa = *(const f32x4*)(X + o), xb = *(const f32x4*)(X + o + 4);
        *(f32x4*)(Y + o) = xa * DN_ALPHA + a; *(f32x4*)(Y + o + 4) = xb * DN_ALPHA + b;
    }
};
struct FDown { float* Y;
    __device__ __forceinline__ void operator()(int row, int col, f32x4 a, f32x4 b, int) const {
        const size_t o = (size_t)row * 1024 + col; const f32x4 xa = *(const f32x4*)(Y + o), xb = *(const f32x4*)(Y + o + 4);
        *(f32x4*)(Y + o) = xa * DN_ALPHA + a; *(f32x4*)(Y + o + 4) = xb * DN_ALPHA + b;
    }
};
template <int ID, class F> __device__ __forceinline__ void run_gemm(PG8_LAS unsigned char* lds, const bf16_t* A, const bf16_t* Bt, int M, int N, int K, const F& f) {
  if constexpr ((EN_GEMM >> ID) & 1) {
    asm volatile("" : "+s"(M), "+s"(N), "+s"(K));
    pg8::Gemm g{A, Bt, M, N, K}; pg8::StaticOrder S; S.init(M, N, (int)gridDim.x, (int)blockIdx.x);
    Epi8<F> E{f};
    pg8::gemm_phase<Epi8<F>, pg8::StaticOrder, G_ALIGN, (ID != 0 && ID != 3)>(lds, g, S, E);
  }
}

namespace att {
typedef short bf16x8 __attribute__((ext_vector_type(8)));
typedef short s16x4 __attribute__((ext_vector_type(4)));
typedef float f32x16 __attribute__((ext_vector_type(16)));
constexpr int NW = 8, QBLK = 32, KVBLK = 64, LDQ = 1536, LDK = 2048, LDKR = 64, LDO = 1024;
constexpr float SCALE = 0.07216878364870323f, THR = 8.f;
constexpr int SHM_V = 16384, SHM_K = 24576;
#define AKSWZ(row, colB) ((row) * 384 + ((colB) ^ (((row) & 7) << 4)))
#define SBAR() __builtin_amdgcn_sched_barrier(0)
__device__ __forceinline__ int crow(int r, int hi) { return (r & 3) + 8 * (r >> 2) + 4 * hi; }
__device__ __forceinline__ void partialSM(f32x16& p0, f32x16& p1, float& m_reg, float& mn, float& alpha) {
  constexpr float C = SCALE * 1.4426950408889634f;
  float pmax = p0[0]; for (int r = 1; r < 16; ++r) pmax = fmaxf(pmax, p0[r]); for (int r = 0; r < 16; ++r) pmax = fmaxf(pmax, p1[r]);
  { auto rr = __builtin_amdgcn_permlane32_swap(__float_as_uint(pmax), __float_as_uint(pmax), false, false);
    pmax = fmaxf(__uint_as_float(rr[0]), __uint_as_float(rr[1])); }
  if (__builtin_expect(__all(pmax - m_reg <= THR / SCALE), 1)) { mn = m_reg; alpha = 1.f; }
  else { mn = fmaxf(m_reg, pmax); alpha = __builtin_amdgcn_exp2f((m_reg - mn) * C); m_reg = mn; }
  float mnC = -mn * C;
  for (int r = 0; r < 16; ++r) p0[r] = fmaf(p0[r], C, mnC); for (int r = 0; r < 16; ++r) p1[r] = fmaf(p1[r], C, mnC);
  for (int r = 0; r < 16; ++r) p0[r] = __builtin_amdgcn_exp2f(p0[r]);
}
__device__ __forceinline__ void finishSM(f32x16& p0, f32x16& p1, float alpha, float& l_reg, bf16x8& pa0, bf16x8& pa1, bf16x8& pa2, bf16x8& pa3) {
  for (int r = 0; r < 16; ++r) p1[r] = __builtin_amdgcn_exp2f(p1[r]);
  float ps = 0; for (int r = 0; r < 16; ++r) ps += p0[r]; for (int r = 0; r < 16; ++r) ps += p1[r];
  { auto rr = __builtin_amdgcn_permlane32_swap(__float_as_uint(ps), __float_as_uint(ps), false, false);
    ps = __uint_as_float(rr[0]) + __uint_as_float(rr[1]); }
  l_reg = l_reg * alpha + ps;
#define PK4(P, BASE, OUT) do { unsigned a0 = pk(P[BASE + 0], P[BASE + 1]), a1 = pk(P[BASE + 2], P[BASE + 3]);   \
    unsigned b0 = pk(P[BASE + 4], P[BASE + 5]), b1 = pk(P[BASE + 6], P[BASE + 7]);                              \
    auto r0 = __builtin_amdgcn_permlane32_swap(a0, b0, false, false); auto r1 = __builtin_amdgcn_permlane32_swap(a1, b1, false, false); \
    u32x4 w = {r0[0], r1[0], r0[1], r1[1]}; OUT = *reinterpret_cast<bf16x8*>(&w); } while (0)
  PK4(p0, 0, pa0); PK4(p0, 8, pa1); PK4(p1, 0, pa2); PK4(p1, 8, pa3);
#undef PK4
}
__device__ __forceinline__ void qkt(f32x16& p0, f32x16& p1, const char* Ks, const bf16x8* qr, const bf16x8* qrl, int r32, int hi) {
  p0 = f32x16{}; p1 = f32x16{};
  int kb[4];
#pragma unroll
  for (int dl = 0; dl < 4; ++dl) kb[dl] = r32 * 384 + ((dl * 32 + hi * 16) ^ ((r32 & 7) << 4));
#pragma unroll
  for (int d0 = 0; d0 < 12; ++d0) {
    bf16x8 b0 = *reinterpret_cast<const bf16x8*>(Ks + kb[d0 & 3] + (d0 >> 2) * 128);
    bf16x8 b1 = *reinterpret_cast<const bf16x8*>(Ks + kb[d0 & 3] + (d0 >> 2) * 128 + 32 * 384);
    const bf16x8 qv = (d0 < 8) ? qr[d0 & 7] : qrl[(d0 - 8) * 64];
    p0 = __builtin_amdgcn_mfma_f32_32x32x16_bf16(b0, qv, p0, 0, 0, 0);
    p1 = __builtin_amdgcn_mfma_f32_32x32x16_bf16(b1, qv, p1, 0, 0, 0); }
}
__device__ __forceinline__ int v_st(int k, int c) { const int kk = (k & ~0xC) | ((k & 4) << 1) | ((k & 8) >> 1); return ((kk >> 3) * 4 + (c >> 5)) * 512 + ((kk & 7) * 32 + (c & 31)) * 2; }
__device__ __forceinline__ int v_rd_base(int lane) { return ((lane & 3) << 3) | (((lane >> 2) & 3) << 6) | (((lane >> 4) & 1) << 5) | (((lane >> 5) & 1) << 8); }
constexpr int v_rd_off(int d0, int ks, int half) { return d0 * 512 + ks * 4096 + half * 2048; }
template <int OFF> __device__ __forceinline__ s16x4 tr_read(int vb) {
  s16x4 r; asm volatile("ds_read_b64_tr_b16 %0, %1 offset:%2" : "=&v"(r) : "v"(vb), "i"(OFF) : "memory"); return r;
}
template <int D0> __device__ __forceinline__ void pv_one(f32x16& od, int vb, bf16x8 pa0, bf16x8 pa1, bf16x8 pa2, bf16x8 pa3) {
  const s16x4 l0 = tr_read<v_rd_off(D0, 0, 0)>(vb), h0 = tr_read<v_rd_off(D0, 0, 1)>(vb), l1 = tr_read<v_rd_off(D0, 1, 0)>(vb), h1 = tr_read<v_rd_off(D0, 1, 1)>(vb);
  const s16x4 l2 = tr_read<v_rd_off(D0, 2, 0)>(vb), h2 = tr_read<v_rd_off(D0, 2, 1)>(vb), l3 = tr_read<v_rd_off(D0, 3, 0)>(vb), h3 = tr_read<v_rd_off(D0, 3, 1)>(vb);
  asm volatile("s_waitcnt lgkmcnt(0)" ::: "memory"); SBAR();
#define PKV(L, H) (bf16x8){L[0], L[1], L[2], L[3], H[0], H[1], H[2], H[3]}
  od = __builtin_amdgcn_mfma_f32_32x32x16_bf16(pa0, PKV(l0, h0), od, 0, 0, 0);
  od = __builtin_amdgcn_mfma_f32_32x32x16_bf16(pa1, PKV(l1, h1), od, 0, 0, 0);
  od = __builtin_amdgcn_mfma_f32_32x32x16_bf16(pa2, PKV(l2, h2), od, 0, 0, 0);
  od = __builtin_amdgcn_mfma_f32_32x32x16_bf16(pa3, PKV(l3, h3), od, 0, 0, 0);
#undef PKV
}
__device__ __forceinline__ void pv_d0(f32x16* o, int vb, bf16x8 pa0, bf16x8 pa1, bf16x8 pa2, bf16x8 pa3) {
  pv_one<0>(o[0], vb, pa0, pa1, pa2, pa3); pv_one<1>(o[1], vb, pa0, pa1, pa2, pa3); pv_one<2>(o[2], vb, pa0, pa1, pa2, pa3); pv_one<3>(o[3], vb, pa0, pa1, pa2, pa3);
}
__device__ __forceinline__ void attn_unit(const bf16_t* __restrict__ Qb, const bf16_t* __restrict__ Kh, const bf16_t* __restrict__ Vh, const bf16_t* __restrict__ KRb,
                                          bf16_t* __restrict__ Ob, int seq, char* lds, int h) {
  int tid = threadIdx.x; asm volatile("" : "+v"(tid));
  const int wid = tid >> 6, lane = tid & 63, r32 = lane & 31, hi = lane >> 5;
  char* V_lds = lds; char* K_lds = lds + 2 * SHM_V;
  float* ws = (float*)(lds + 2 * SHM_V + 2 * SHM_K) + wid * 64; float* li_l = ws; float* al_l = ws + 32;
  float m_reg = -1e30f, l_reg = 0; f32x16 o[4] = {}; bf16x8 qr[8];
  bf16x8* qrl = (bf16x8*)(lds + 2 * SHM_V + 2 * SHM_K + 2048) + wid * 256 + lane;
  const bf16_t* Qw = Qb + (long)(wid * QBLK + r32) * LDQ + hi * 8 + h * 128;
  const bf16_t* Qwr = Qb + (long)(wid * QBLK + r32) * LDQ + hi * 8 + 1024 + h * 64;
#pragma unroll
  for (int d0 = 0; d0 < 8; ++d0) qr[d0] = *reinterpret_cast<const bf16x8*>(Qw + d0 * 16);
#pragma unroll
  for (int d0 = 8; d0 < 12; ++d0) qrl[(d0 - 8) * 64] = *reinterpret_cast<const bf16x8*>(Qwr + (d0 - 8) * 16);
  const int sr = tid >> 4, sc = (tid & 15) * 8, vst0 = v_st(sr, sc), vst1 = v_st(32 + sr, sc);
  const int rr = tid >> 3, rc = (tid & 7) * 8;
  const int vb0 = (int)(uintptr_t)V_lds + v_rd_base(lane);
  bf16x8 vs0, vs1, ks0, ks1, kr0;
#define SLOAD(k0) do { vs0 = *reinterpret_cast<const bf16x8*>(&Vh[(long)((k0) + sr) * LDK + sc]); vs1 = *reinterpret_cast<const bf16x8*>(&Vh[(long)((k0) + 32 + sr) * LDK + sc]); \
    ks0 = *reinterpret_cast<const bf16x8*>(&Kh[(long)((k0) + sr) * LDK + sc]); ks1 = *reinterpret_cast<const bf16x8*>(&Kh[(long)((k0) + 32 + sr) * LDK + sc]); \
    kr0 = *reinterpret_cast<const bf16x8*>(&KRb[(long)((k0) + rr) * LDKR + rc]); } while (0)
#define SWRITE(b) do { *(bf16x8*)(V_lds + (b) * SHM_V + vst0) = vs0; *(bf16x8*)(V_lds + (b) * SHM_V + vst1) = vs1; int kc = sc * 2; \
    *(bf16x8*)(K_lds + (b) * SHM_K + AKSWZ(sr, kc)) = ks0; *(bf16x8*)(K_lds + (b) * SHM_K + AKSWZ(32 + sr, kc)) = ks1; \
    *(bf16x8*)(K_lds + (b) * SHM_K + AKSWZ(rr, 256 + rc * 2)) = kr0; } while (0)
#define SWAIT() asm volatile("s_waitcnt vmcnt(0)" ::: "memory")
#define RESC(a) do { if (__any((a) < 1.f)) { if (hi == 0) al_l[r32] = (a); asm volatile("s_waitcnt lgkmcnt(0)" ::: "memory"); \
    for (int d = 0; d < 4; ++d) for (int r = 0; r < 16; ++r) o[d][r] *= al_l[crow(r, hi)]; } } while (0)
  f32x16 pA0, pA1, pB0, pB1; float mnA, mnB, alA, alB; bf16x8 pa0, pa1, pa2, pa3; const int NT = seq / KVBLK;
  SLOAD(0); SWAIT(); SWRITE(0); __syncthreads();
  qkt(pA0, pA1, K_lds, qr, qrl, r32, hi); partialSM(pA0, pA1, m_reg, mnA, alA);
  SLOAD(KVBLK);
  SWAIT(); SWRITE(1); __syncthreads();
  for (int j = 1; j + 1 < NT; j += 2) {
    SBAR(); qkt(pB0, pB1, K_lds + SHM_K, qr, qrl, r32, hi);
    finishSM(pA0, pA1, alA, l_reg, pa0, pa1, pa2, pa3); SBAR();
    SLOAD((j + 1) * KVBLK); SBAR();
    pv_d0(o, vb0, pa0, pa1, pa2, pa3); partialSM(pB0, pB1, m_reg, mnB, alB);
    __syncthreads(); SWAIT(); SWRITE(0);
    RESC(alB); __syncthreads();
    SBAR(); qkt(pA0, pA1, K_lds, qr, qrl, r32, hi);
    finishSM(pB0, pB1, alB, l_reg, pa0, pa1, pa2, pa3); SBAR();
    SLOAD((j + 2) * KVBLK); SBAR();
    pv_d0(o, vb0 + SHM_V, pa0, pa1, pa2, pa3); partialSM(pA0, pA1, m_reg, mnA, alA);
    __syncthreads(); SWAIT(); SWRITE(1);
    RESC(alA); __syncthreads();
  }
  SBAR(); qkt(pB0, pB1, K_lds + SHM_K, qr, qrl, r32, hi);
  finishSM(pA0, pA1, alA, l_reg, pa0, pa1, pa2, pa3); SBAR();
  pv_d0(o, vb0, pa0, pa1, pa2, pa3); partialSM(pB0, pB1, m_reg, mnB, alB);
  __syncthreads(); RESC(alB);
  finishSM(pB0, pB1, alB, l_reg, pa0, pa1, pa2, pa3); SBAR();
  pv_d0(o, vb0 + SHM_V, pa0, pa1, pa2, pa3);
  if (hi == 0) li_l[r32] = l_reg; asm volatile("s_waitcnt lgkmcnt(0)" ::: "memory");
  float rli[16];
#pragma unroll
  for (int r = 0; r < 16; ++r) rli[r] = __builtin_amdgcn_rcpf(li_l[crow(r, hi)]);
  bf16_t* Ow = Ob + (long)(wid * QBLK) * LDO;
#pragma unroll
  for (int r = 0; r < 16; ++r) { int orow = crow(r, hi);
#pragma unroll
    for (int d0 = 0; d0 < 4; ++d0) Ow[(long)orow * LDO + d0 * 32 + r32] = f2bf(o[d0][r] * rli[r]); }
  __syncthreads();
#undef SLOAD
#undef SWRITE
#undef SWAIT
#undef RESC
}
}

namespace hy {
__device__ __forceinline__ c2 cmul(c2 a, c2 b) { return (c2){a.x * b.x - a.y * b.y, a.x * b.y + a.y * b.x}; }
__device__ __forceinline__ c2 cmulc(c2 a, c2 b) { return (c2){a.x * b.x + a.y * b.y, a.y * b.x - a.x * b.y}; }
__device__ __forceinline__ c2 twid(float fr) { return (c2){__builtin_amdgcn_cosf(fr), -__builtin_amdgcn_sinf(fr)}; }
struct T2 { c2 w, wr; };
__device__ __forceinline__ T2 mk(c2 w) { T2 t; t.w = w; t.wr = (c2){-w.y, w.x}; return t; }
__device__ __forceinline__ c2 mulT(c2 x, const T2& t) { return x.xx * t.w + x.yy * t.wr; }
template <bool INV> __device__ __forceinline__ void r4(c2& x0, c2& x1, c2& x2, c2& x3) {
    const c2 t0 = x0 + x2, t1 = x0 - x2, t2 = x1 + x3, t3 = x1 - x3;
    const c2 r = INV ? (c2){-t3.y, t3.x} : (c2){t3.y, -t3.x};
    x0 = t0 + t2; x1 = t1 + r; x2 = t0 - t2; x3 = t1 - r;
}
template <bool INV> __device__ __forceinline__ c2 mulw(c2 x, int k) {
    const float C1 = 0.9238795325112867f, S1 = 0.3826834323650898f, R = 0.7071067811865476f;
    const float sg = INV ? -1.f : 1.f; c2 w;
    switch (k) { case 0: return x; case 1: w = (c2){C1, -S1 * sg}; break; case 2: w = (c2){R, -R * sg}; break; case 3: w = (c2){S1, -C1 * sg}; break;
                 case 4: return INV ? (c2){-x.y, x.x} : (c2){x.y, -x.x}; case 6: w = (c2){-R, -R * sg}; break; default: w = (c2){-C1, S1 * sg}; break;   }
    return x.xx * w + x.yy * (c2){-w.y, w.x};
}
template <bool INV> __device__ __forceinline__ void dft16(c2 (&e)[16]) {
#pragma unroll
    for (int a0 = 0; a0 < 4; ++a0) { r4<INV>(e[a0], e[a0 + 4], e[a0 + 8], e[a0 + 12]);
#pragma unroll
        for (int b0 = 1; b0 < 4; ++b0) e[a0 + 4 * b0] = mulw<INV>(e[a0 + 4 * b0], a0 * b0); }
#pragma unroll
    for (int b0 = 0; b0 < 4; ++b0) r4<INV>(e[4 * b0], e[4 * b0 + 1], e[4 * b0 + 2], e[4 * b0 + 3]);
#pragma unroll
    for (int b0 = 0; b0 < 4; ++b0)
#pragma unroll
        for (int b1 = b0 + 1; b1 < 4; ++b1) { const c2 t = e[b1 + 4 * b0]; e[b1 + 4 * b0] = e[b0 + 4 * b1]; e[b0 + 4 * b1] = t; }
}
template <int R, bool INV, bool TW> __device__ __forceinline__ void bfly(c2 (&e)[R], c2 th) {
    T2 t1, t2, t3, T1, T2_, T3;
    if (TW) { t1 = mk(th); t2 = mk(mulT(th, t1)); t3 = mk(mulT(t2.w, t1));
        if (R == 16) { T1 = mk(mulT(t2.w, t2)); T2_ = mk(mulT(T1.w, T1)); T3 = mk(mulT(T2_.w, T1)); } }
#define HY_APPLY_TW() do { if (R == 16) { _Pragma("unroll") for (int b1 = 0; b1 < 4; ++b1) { e[4 * b1 + 1] = mulT(e[4 * b1 + 1], t1); e[4 * b1 + 2] = mulT(e[4 * b1 + 2], t2); e[4 * b1 + 3] = mulT(e[4 * b1 + 3], t3); } \
        _Pragma("unroll") for (int b0 = 0; b0 < 4; ++b0) { e[4 + b0] = mulT(e[4 + b0], T1); e[8 + b0] = mulT(e[8 + b0], T2_); e[12 + b0] = mulT(e[12 + b0], T3); } } \
      else { e[1] = mulT(e[1], t1); e[2] = mulT(e[2], t2); e[3] = mulT(e[3], t3); } } while (0)
    if (INV && TW) HY_APPLY_TW();
    if constexpr (R == 16) dft16<INV>(e); else r4<INV>(e[0], e[1], e[2], e[3]);
    if (!INV && TW) HY_APPLY_TW();
#undef HY_APPLY_TW
}
struct NoF { static constexpr bool ON = false; };
template <int R, bool INV, int S, int LS, int NSL, class LD, class ST> __device__ __forceinline__ void fft_pass(LAS c2* X, int seqstride, int nseq, int tid, const LD& ld, const ST& st) {
    const int total = nseq << NSL;
    for (int g = tid; g < total; g += 512) {
        const int q = g >> NSL, sg = g & ((1 << NSL) - 1);
        const int j0 = sg & (S - 1), blk = sg >> LS, base = blk * R * S + j0;
        LAS c2* p = X + q * seqstride + base + (base >> 4);
        constexpr int sp = (S >= 16) ? S + (S >> 4) : S;
        c2 e[R];
#pragma unroll
        for (int a = 0; a < R; ++a) { if constexpr (LD::ON) { e[a] = ld(q, base + a * S); if ((a & 3) == 3) asm volatile("" ::: "memory"); } else e[a] = p[a * sp]; }
        c2 th0 = twid((float)j0 * (1.0f / (float)(R * S))); if (INV) th0.y = -th0.y;
        bfly<R, INV, (S > 1)>(e, th0);
#pragma unroll
        for (int a = 0; a < R; ++a) { if constexpr (ST::ON) { st(q, base + a * S, e[a]); if ((a & 1) == 1) asm volatile("" ::: "memory"); } else p[a * sp] = e[a]; }
    }
    __syncthreads();
}
template <int LOGN> __device__ __forceinline__ void fft_mid(LAS c2* X, int nseq, const c2* KS, int tid) {
    constexpr int N = 1 << LOGN, SS = N + N / 16, NSL = LOGN - 4;
    const int total = nseq << NSL;
    for (int g = tid; g < total; g += 512) {
        const int q = g >> NSL, sg = g & ((1 << NSL) - 1);
        LAS c2* p = X + q * SS + sg * 17;
        c2 e[16];
#pragma unroll
        for (int a = 0; a < 16; ++a) e[a] = p[a];
        dft16<false>(e);
        const c2* kp = KS + sg;
#pragma unroll
        for (int a0 = 0; a0 < 16; a0 += 4) { c2 k[4];
#pragma unroll
            for (int a = 0; a < 4; ++a) k[a] = kp[(a0 + a) * (N / 16)];
#pragma unroll
            for (int a = 0; a < 4; ++a) e[a0 + a] = mulT(e[a0 + a], mk(k[a]));
            asm volatile("" ::: "memory"); }
        dft16<true>(e);
#pragma unroll
        for (int a = 0; a < 16; ++a) p[a] = e[a];
    }
    __syncthreads();
}
template <int LOGN, class LD> __device__ __forceinline__ void fft_fwd_head(LAS c2* X, int nseq, int tid, const LD& ld) {
    constexpr int N = 1 << LOGN, SS = N + N / 16; const NoF nf;
    if constexpr (LOGN == 14) { fft_pass<4, false, 4096, 12, LOGN - 2>(X, SS, nseq, tid, ld, nf); fft_pass<16, false, 256, 8, LOGN - 4>(X, SS, nseq, tid, nf, nf); }
    else fft_pass<16, false, 256, 8, LOGN - 4>(X, SS, nseq, tid, ld, nf);
    fft_pass<16, false, 16, 4, LOGN - 4>(X, SS, nseq, tid, nf, nf);
}
template <int LOGN, class ST> __device__ __forceinline__ void fft_inv_tail(LAS c2* X, int nseq, int tid, const ST& st) {
    constexpr int N = 1 << LOGN, SS = N + N / 16; const NoF nf;
    fft_pass<16, true, 16, 4, LOGN - 4>(X, SS, nseq, tid, nf, nf);
    if constexpr (LOGN == 14) { fft_pass<16, true, 256, 8, LOGN - 4>(X, SS, nseq, tid, nf, nf); fft_pass<4, true, 4096, 12, LOGN - 2>(X, SS, nseq, tid, nf, st); }
    else fft_pass<16, true, 256, 8, LOGN - 4>(X, SS, nseq, tid, nf, st);
}
template <int L> __device__ __forceinline__ float dw3(const bf16_t* u, int m, float w0, float w1, float w2, float b) {
    float x = bf2f(u[m]) * w1 + b; if (m > 0) x += bf2f(u[m - 1]) * w0; if (m < L - 1) x += bf2f(u[m + 1]) * w2; return x;
}
template <int L> struct HyCtx {
    const bf16_t *hf, *hb, *uv, *ug; bf16_t* zt; c2 *KS, *YC; float v0, v1, v2, vb, g0, g1, g2, gb, skip; int n;
    __device__ __forceinline__ c2 loadz(int q, int m) const { const int oA = 2 * q * L, oB = oA + L; c2 z;
        if (n == 0) { z.x = dw3<L>(uv + oA, m, v0, v1, v2, vb); z.y = dw3<L>(uv + oB, m, v0, v1, v2, vb); } else { z.x = bf2f(zt[oA + m]); z.y = bf2f(zt[oB + m]); }
        return z; }
};
template <int L, bool NEG> struct LdK { static constexpr bool ON = true; const HyCtx<L>* c;
    __device__ __forceinline__ c2 operator()(int, int m) const { const float f = bf2f(c->hf[m]); const float b = m ? bf2f(c->hb[L - m]) : 0.f;
        if (!NEG) return (c2){f + b, 0.f}; return twid((float)m * (0.5f / (float)L)) * (f - b); } };
template <int L, bool NEG> struct LdZ { static constexpr bool ON = true; const HyCtx<L>* c;
    __device__ __forceinline__ c2 operator()(int q, int m) const { c2 z = c->loadz(q, m); if (NEG) z = mulT(z, mk(twid((float)m * (0.5f / (float)L)))); return z; } };
template <int L> struct StKS { static constexpr bool ON = true; const HyCtx<L>* c;
    __device__ __forceinline__ void operator()(int, int pos, c2 v) const { c->KS[(pos & 15) * (L / 16) + (pos >> 4)] = v; } };
template <int L> struct StYC { static constexpr bool ON = true; const HyCtx<L>* c;
    __device__ __forceinline__ void operator()(int q, int m, c2 v) const { c->YC[q * L + m] = v; } };
template <int L> struct StFin { static constexpr bool ON = true; const HyCtx<L>* c;
    __device__ __forceinline__ void operator()(int q, int m, c2 v) const { const int oA = 2 * q * L, oB = oA + L;
        const c2 z = c->loadz(q, m); c2 tw = twid((float)m * (0.5f / (float)L)); tw.y = -tw.y;
        const c2 y = (c->YC[q * L + m] + mulT(v, mk(tw))) * (0.5f / (float)L) + z * c->skip;
        const float gA = dw3<L>(c->ug + oA, m, c->g0, c->g1, c->g2, c->gb), gB = dw3<L>(c->ug + oB, m, c->g0, c->g1, c->g2, c->gb);
        c->zt[oA + m] = f2bf(y.x * gA); c->zt[oB + m] = f2bf(y.y * gB); } };
__device__ __forceinline__ unsigned ldw(const void* base, unsigned boff) { return *(const unsigned*)((const char*)base + boff); }
template <int L> __device__ __forceinline__ c2 dw3p(const bf16_t* u, unsigned j, float w0, float w1, float w2, float b) {
    const unsigned o = j * 4u; const bool hasp = j > 0u, hasn = j < (unsigned)(L / 2 - 1);
    const unsigned cur = ldw(u, o);
    unsigned prv = ldw(u, hasp ? o - 4u : o), nxt = ldw(u, hasn ? o + 4u : o);
    prv = hasp ? prv : 0u; nxt = hasn ? nxt : 0u;
    const float xm = bfhi(prv), x0 = bflo(cur), x1 = bfhi(cur), x2 = bflo(nxt);
    return (c2){xm * w0 + x0 * w1 + x1 * w2 + b, x0 * w0 + x1 * w1 + x2 * w2 + b};
}
template <int L> __device__ __forceinline__ void loadz2(const HyCtx<L>& c, int q, unsigned j, c2& zA, c2& zB) { const int oA = 2 * q * L, oB = oA + L;
    if (c.n == 0) { zA = dw3p<L>(c.uv + oA, j, c.v0, c.v1, c.v2, c.vb); zB = dw3p<L>(c.uv + oB, j, c.v0, c.v1, c.v2, c.vb); }
    else { const unsigned wa = ldw(c.zt + oA, j * 4u), wb = ldw(c.zt + oB, j * 4u); zA = (c2){bflo(wa), bfhi(wa)}; zB = (c2){bflo(wb), bfhi(wb)}; } }
template <int L, bool NEG> __device__ __forceinline__ void ew_loadk(LAS c2* X, const HyCtx<L>& c, int tid) {
#pragma unroll (L == 4096 ? 2 : UNR_K)
    for (int i = 0; i < L / 1024; ++i) { const unsigned j = (unsigned)tid + 512u * i;
        const unsigned wf = ldw(c.hf, j * 4u), wA = ldw(c.hb, (unsigned)(2 * L - 4) - j * 4u); unsigned wB = ldw(c.hb, j ? (unsigned)(2 * L) - j * 4u : 0u); wB = j ? wB : 0u;
        const float f0 = bflo(wf), f1 = bfhi(wf), b0 = bflo(wB), b1 = bfhi(wA); LAS c2* p = X + 2 * j + (j >> 3);
        if (!NEG) { p[0] = (c2){f0 + b0, 0.f}; p[1] = (c2){f1 + b1, 0.f}; }
        else { p[0] = twid((float)(2 * j) * (0.5f / (float)L)) * (f0 - b0); p[1] = twid((float)(2 * j + 1) * (0.5f / (float)L)) * (f1 - b1); } }
    __syncthreads();
}
template <int L, bool NEG> __device__ __forceinline__ void ew_loadz(LAS c2* X, const HyCtx<L>& c, int nseq, int tid) {
    constexpr int SS = L + L / 16;
#pragma unroll 1
    for (int q = 0; q < nseq; ++q)
#pragma unroll (L == 4096 ? 2 : UNR_Z)
        for (int i = 0; i < L / 1024; ++i) { const unsigned j = (unsigned)tid + 512u * i; c2 zA, zB; loadz2<L>(c, q, j, zA, zB); LAS c2* p = X + q * SS + 2 * j + (j >> 3);
            c2 e0 = (c2){zA.x, zB.x}, e1 = (c2){zA.y, zB.y};
            if (NEG) { e0 = mulT(e0, mk(twid((float)(2 * j) * (0.5f / (float)L)))); e1 = mulT(e1, mk(twid((float)(2 * j + 1) * (0.5f / (float)L)))); }
            p[0] = e0; p[1] = e1; }
    __syncthreads();
}
template <int L> __device__ __forceinline__ void ew_storeyc(LAS c2* X, const HyCtx<L>& c, int nseq, int tid) {
    constexpr int SS = L + L / 16; typedef float f4 __attribute__((ext_vector_type(4)));
#pragma unroll 1
    for (int q = 0; q < nseq; ++q)
#pragma unroll (L == 4096 ? 2 : UNR_Y)
        for (int i = 0; i < L / 1024; ++i) { const unsigned j = (unsigned)tid + 512u * i; LAS c2* p = X + q * SS + 2 * j + (j >> 3); const c2 a = p[0], b = p[1];
            *(f4*)((char*)(c.YC + q * L) + j * 16u) = (f4){a.x, a.y, b.x, b.y}; }
    __syncthreads();
}
template <int L> __device__ __forceinline__ void ew_final(LAS c2* X, const HyCtx<L>& c, int nseq, int tid) {
    constexpr int SS = L + L / 16; typedef float f4 __attribute__((ext_vector_type(4)));
#pragma unroll 1
    for (int q = 0; q < nseq; ++q)
#pragma unroll (L == 4096 ? 1 : UNR_F)
        for (int i = 0; i < L / 1024; ++i) { const unsigned j = (unsigned)tid + 512u * i; const int oA = 2 * q * L, oB = oA + L; c2 zA, zB; loadz2<L>(c, q, j, zA, zB);
            LAS c2* p = X + q * SS + 2 * j + (j >> 3); const c2 yn0 = p[0], yn1 = p[1]; const f4 yc = *(const f4*)((const char*)(c.YC + q * L) + j * 16u);
            c2 t0 = twid((float)(2 * j) * (0.5f / (float)L)), t1 = twid((float)(2 * j + 1) * (0.5f / (float)L)); t0.y = -t0.y; t1.y = -t1.y;
            const c2 y0 = ((c2){yc[0], yc[1]} + mulT(yn0, mk(t0))) * (0.5f / (float)L) + (c2){zA.x, zB.x} * c.skip;
            const c2 y1 = ((c2){yc[2], yc[3]} + mulT(yn1, mk(t1))) * (0.5f / (float)L) + (c2){zA.y, zB.y} * c.skip;
            const c2 gA = dw3p<L>(c.ug + oA, j, c.g0, c.g1, c.g2, c.gb), gB = dw3p<L>(c.ug + oB, j, c.g0, c.g1, c.g2, c.gb);
            *(unsigned*)((char*)(c.zt + oA) + j * 4u) = pk(y0.x * gA.x, y1.x * gA.y); *(unsigned*)((char*)(c.zt + oB) + j * 4u) = pk(y0.y * gB.x, y1.y * gB.y); }
    __syncthreads();
}
template <int LOGN> __device__ __forceinline__ void hyena_item(LAS c2* X, const bf16_t* UT, int Tg, const bf16_t* FT, bf16_t* ZT, int c,
                                                               const float* short_w, const float* short_b, const float* hy_skip, c2* KS, c2* YC, int tid) {
    constexpr int L = 1 << LOGN, NSEQ = (LOGN == 12) ? 2 : 1, SS = L + L / 16; constexpr bool FUSE = false;
    HyCtx<L> cx; cx.uv = UT + (size_t)(2048 + c) * Tg; cx.zt = ZT + (size_t)c * Tg; cx.KS = KS; cx.YC = YC;
    cx.v0 = short_w[2048 + c]; cx.v1 = short_w[3072 + 2048 + c]; cx.v2 = short_w[6144 + 2048 + c]; cx.vb = short_b[2048 + c];
    const NoF nf;
    for (int n = 0; n < 2; ++n) {
        cx.n = n; cx.hf = FT + (size_t)(n * 1024 + c) * L; cx.hb = FT + (size_t)((2 + n) * 1024 + c) * L; cx.skip = hy_skip[n * 1024 + c];
        const int gr = n ? 1024 + c : c; cx.ug = UT + (size_t)gr * Tg;
        cx.g0 = short_w[gr]; cx.g1 = short_w[3072 + gr]; cx.g2 = short_w[6144 + gr]; cx.gb = short_b[gr];
        if constexpr (FUSE) fft_fwd_head<LOGN>(X, 1, tid, LdK<L, false>{&cx}); else { ew_loadk<L, false>(X, cx, tid); fft_fwd_head<LOGN>(X, 1, tid, nf); }
        fft_pass<16, false, 1, 0, LOGN - 4>(X, SS, 1, tid, nf, StKS<L>{&cx});
        if constexpr (FUSE) fft_fwd_head<LOGN>(X, NSEQ, tid, LdZ<L, false>{&cx}); else { ew_loadz<L, false>(X, cx, NSEQ, tid); fft_fwd_head<LOGN>(X, NSEQ, tid, nf); }
        fft_mid<LOGN>(X, NSEQ, KS, tid);
        if constexpr (FUSE) fft_inv_tail<LOGN>(X, NSEQ, tid, StYC<L>{&cx}); else { fft_inv_tail<LOGN>(X, NSEQ, tid, nf); ew_storeyc<L>(X, cx, NSEQ, tid); }
        if constexpr (FUSE) fft_fwd_head<LOGN>(X, 1, tid, LdK<L, true>{&cx}); else { ew_loadk<L, true>(X, cx, tid); fft_fwd_head<LOGN>(X, 1, tid, nf); }
        fft_pass<16, false, 1, 0, LOGN - 4>(X, SS, 1, tid, nf, StKS<L>{&cx});
        if constexpr (FUSE) fft_fwd_head<LOGN>(X, NSEQ, tid, LdZ<L, true>{&cx}); else { ew_loadz<L, true>(X, cx, NSEQ, tid); fft_fwd_head<LOGN>(X, NSEQ, tid, nf); }
        fft_mid<LOGN>(X, NSEQ, KS, tid);
        if constexpr (FUSE) fft_inv_tail<LOGN>(X, NSEQ, tid, StFin<L>{&cx}); else { fft_inv_tail<LOGN>(X, NSEQ, tid, nf); ew_final<L>(X, cx, NSEQ, tid); }
    }
}
}

__device__ __forceinline__ int colmap(int mode, int n) {
    if (mode == 0) return n;
    if (mode == 1) {
        if (n >= 2816) return 704 + (n - 2816);
        if (n < 640) return n;
        if (n < 704) { const int j = n - 640; return 640 + (j >> 1) + 32 * (j & 1); }
        if (n < 2752) return 3776 + (n - 704);
        return -1;
    }
    if (n < 1024) return (n >> 7) * 192 + (n & 127);
    { const int h = (n - 1024) >> 6, j = (n - 1024) & 63; return h * 192 + 128 + (j >> 1) + 32 * (j & 1); }
}
__device__ __forceinline__ void wtrans(float* tile  , const float* src, int ld, int K, int dstN, bf16_t* dst, int mode, const float* scale, int tid) {
    const int tk = K / 64, ntiles = (dstN / 64) * tk;
    for (int t = blockIdx.x; t < ntiles; t += gridDim.x) {
        const int n0 = (t / tk) * 64, k0 = (t % tk) * 64;
        { const int nn = tid & 63, col = colmap(mode, n0 + nn);
#pragma unroll
          for (int i = 0; i < 8; ++i) { const int kk = (tid >> 6) + 8 * i; float v = 0.f; if (col >= 0) { v = src[(size_t)(k0 + kk) * ld + col]; if (scale) v *= scale[k0 + kk]; } tile[kk * 65 + nn] = v; } }
        __syncthreads();
        { const int kk = tid & 63;
#pragma unroll
          for (int i = 0; i < 8; ++i) { const int nn = (tid >> 6) + 8 * i; dst[(size_t)(n0 + nn) * K + k0 + kk] = f2bf(tile[kk * 65 + nn]); } }
        __syncthreads();
    }
}
__device__ __forceinline__ void cvt_rows(const float* src, bf16_t* dst, size_t n8, int gtid, int gthreads) {
    for (size_t i = gtid; i < n8; i += gthreads) { const f32x4 a = *(const f32x4*)(src + i * 8), b = *(const f32x4*)(src + i * 8 + 4); st8(dst + i * 8, a, b); }
}
__device__ __forceinline__ float wsum(float v) { v += __shfl_xor(v, 1); v += __shfl_xor(v, 2); v += __shfl_xor(v, 4); v += __shfl_xor(v, 8); v += __shfl_xor(v, 16); v += __shfl_xor(v, 32); return v; }
__device__ __forceinline__ void ln_rows(float* Y, const float* g, const float* b, bf16_t* Xb, int nrows, int tid) {
    const int wid = tid >> 6, lane = tid & 63;
    f32x4 gv[4], bv[4];
#pragma unroll
    for (int k = 0; k < 4; ++k) { gv[k] = *(const f32x4*)(g + k * 256 + lane * 4); bv[k] = *(const f32x4*)(b + k * 256 + lane * 4); }
    for (int row = (blockIdx.x * 8 + wid) * 2; row < nrows; row += gridDim.x * 16) {
        f32x4 v[2][4];
#pragma unroll
        for (int u = 0; u < 2; ++u)
#pragma unroll
            for (int k = 0; k < 4; ++k) v[u][k] = *(const f32x4*)(Y + (size_t)(row + u) * 1024 + k * 256 + lane * 4);
#pragma unroll
        for (int u = 0; u < 2; ++u) {
            float* y = Y + (size_t)(row + u) * 1024; float s = 0.f;
#pragma unroll
            for (int k = 0; k < 4; ++k) s += (v[u][k][0] + v[u][k][1]) + (v[u][k][2] + v[u][k][3]);
            const float mean = wsum(s) * (1.0f / 1024.0f); float q = 0.f;
#pragma unroll
            for (int k = 0; k < 4; ++k) { v[u][k] = v[u][k] - mean; q += (v[u][k][0] * v[u][k][0] + v[u][k][1] * v[u][k][1]) + (v[u][k][2] * v[u][k][2] + v[u][k][3] * v[u][k][3]); }
            const float rstd = rsqrtf(wsum(q) * (1.0f / 1024.0f) + LN_EPS);
#pragma unroll
            for (int k = 0; k < 4; ++k) { const f32x4 o = v[u][k] * rstd * gv[k] + bv[k]; *(f32x4*)(y + k * 256 + lane * 4) = o;
                if (Xb) { unsigned w0 = pk(o[0], o[1]), w1 = pk(o[2], o[3]); *(uint2*)(Xb + (size_t)(row + u) * 1024 + k * 256 + lane * 4) = make_uint2(w0, w1); } }
        }
    }
}
__device__ __forceinline__ void ffn_mid(const bf16_t* AB, bf16_t* HM, const float* dw_w, const float* dw_b, int seqmask, int tid) {
    typedef float f32x2 __attribute__((ext_vector_type(2)));
    if (tid >= 352) return;
    const int col = tid * 8;
    const f32x4 w0a = *(const f32x4*)(dw_w + col), w0b = *(const f32x4*)(dw_w + col + 4), w1a = *(const f32x4*)(dw_w + 2816 + col), w1b = *(const f32x4*)(dw_w + 2816 + col + 4),
                w2a = *(const f32x4*)(dw_w + 5632 + col), w2b = *(const f32x4*)(dw_w + 5632 + col + 4), ba = *(const f32x4*)(dw_b + col), bb = *(const f32x4*)(dw_b + col + 4);
    const f32x4 zero = {0.f, 0.f, 0.f, 0.f};
    for (int rb = blockIdx.x; rb < TC / 64; rb += gridDim.x) {
        const int r0 = rb * 64; const bf16_t* p = AB + (size_t)r0 * 5632 + col; bf16_t* o = HM + (size_t)r0 * 2816 + col;
        f32x4 pa = zero, pb = zero, ca, cb, na, nb;
        if ((r0 & seqmask) > 0) ld8(p - 5632, pa, pb);
        ld8(p, ca, cb);
#pragma unroll 4
        for (int r = 0; r < 64; ++r) {
            const int pos = (r0 + r) & seqmask;
            if (pos < seqmask) ld8(p + (size_t)(r + 1) * 5632, na, nb); else { na = zero; nb = zero; }
            f32x4 ga, gb; ld8(p + (size_t)r * 5632 + 2816, ga, gb);
            if (pos == 0) { pa = zero; pb = zero; }
            f32x4 ta = pa * w0a + ca * w1a + na * w2a + ba, tb = pb * w0b + cb * w1b + nb * w2b + bb;
            const f32x2 q0 = pg8::gelu_pk((f32x2){ta[0], ta[1]}), q1 = pg8::gelu_pk((f32x2){ta[2], ta[3]}), q2 = pg8::gelu_pk((f32x2){tb[0], tb[1]}), q3 = pg8::gelu_pk((f32x2){tb[2], tb[3]});
            ta = (f32x4){q0.x, q0.y, q1.x, q1.y} * ga; tb = (f32x4){q2.x, q2.y, q3.x, q3.y} * gb;
            st8(o + (size_t)r * 2816, ta, tb);
            pa = ca; pb = cb; ca = na; cb = nb;
        }
    }
}
__device__ __forceinline__ void transpose_z(LAS bf16_t* tile  , const bf16_t* ZT, bf16_t* Z, int Tg, int tid) {
    const int tt = Tg / 64, ngroups = 16 * tt / 4;
    for (int gI = blockIdx.x; gI < ngroups; gI += gridDim.x) {
        const int c0 = (gI / (tt / 4)) * 64, tb = (gI % (tt / 4)) * 256;
        const int cc = tid >> 3, t8 = (tid & 7) * 8;
        u32x4 w[4];
#pragma unroll
        for (int k = 0; k < 4; ++k) w[k] = *(const u32x4*)(ZT + (size_t)(c0 + cc) * Tg + tb + k * 64 + t8);
#pragma unroll
        for (int k = 0; k < 4; ++k) { LAS bf16_t* T = tile + k * 64 * 72;
          T[(t8 + 0) * 72 + cc] = (bf16_t)(w[k].x & 0xffff); T[(t8 + 1) * 72 + cc] = (bf16_t)(w[k].x >> 16); T[(t8 + 2) * 72 + cc] = (bf16_t)(w[k].y & 0xffff); T[(t8 + 3) * 72 + cc] = (bf16_t)(w[k].y >> 16);
          T[(t8 + 4) * 72 + cc] = (bf16_t)(w[k].z & 0xffff); T[(t8 + 5) * 72 + cc] = (bf16_t)(w[k].z >> 16); T[(t8 + 6) * 72 + cc] = (bf16_t)(w[k].w & 0xffff); T[(t8 + 7) * 72 + cc] = (bf16_t)(w[k].w >> 16); }
        __syncthreads();
        { const int r = tid >> 3, c8 = (tid & 7) * 8;
#pragma unroll
          for (int k = 0; k < 4; ++k) { const u32x4 o = *(const LAS u32x4*)(tile + k * 64 * 72 + r * 72 + c8); *(u32x4*)(Z + (size_t)(tb + k * 64 + r) * 1024 + c0 + c8) = o; } }
        __syncthreads();
    }
}

struct Params { const float* in[27]; float* out; unsigned char* ws; int lo, hi; };

__device__ __forceinline__ void prologue(const Params& P, unsigned char* smem, int tid) {
    unsigned char* ws = P.ws; float* tile = (float*)smem;
    const int gtid = blockIdx.x * 512 + tid, gthreads = gridDim.x * 512;
    wtrans(tile, P.in[2], 5824, 1024, 5888, (bf16_t*)(ws + WS_WIN), 1, nullptr, tid);
    wtrans(tile, P.in[6], 1536, 384, 1536, (bf16_t*)(ws + WS_WUQ), 2, P.in[5], tid);
    wtrans(tile, P.in[8], 2048, 256, 2048, (bf16_t*)(ws + WS_WUKV), 0, P.in[7], tid);
    wtrans(tile, P.in[9], 1024, 1024, 1024, (bf16_t*)(ws + WS_WOMLA), 0, nullptr, tid);
    wtrans(tile, P.in[17], 1024, 1024, 1024, (bf16_t*)(ws + WS_WOHY), 0, nullptr, tid);
    wtrans(tile, P.in[18], 1024, 1024, 1024, (bf16_t*)(ws + WS_WOUT), 0, nullptr, tid);
    wtrans(tile, P.in[21], 5632, 1024, 5632, (bf16_t*)(ws + WS_WUP), 0, nullptr, tid);
    wtrans(tile, P.in[24], 1024, 2816, 1024, (bf16_t*)(ws + WS_WDOWN), 0, nullptr, tid);
    { bf16_t* W3B = (bf16_t*)(ws + WS_W3B); const float* w3 = P.in[15];
      for (int i = gtid; i < 4096 * 128; i += gthreads) { const int k = i >> 12, o = i & 4095; W3B[o * 128 + k] = f2bf(w3[(k & 63) * 4096 + o]); } }
    cvt_rows(P.in[0], (bf16_t*)(P.out + (size_t)1 * TC * 1024), (size_t)TC * 1024 / 8, gtid, gthreads);
    cvt_rows(P.in[1], (bf16_t*)(P.out + (size_t)2 * TC * 1024), (size_t)2 * TC * 1024 / 8, gtid, gthreads);
    { float* cosT = (float*)(ws + WS_COS); float* sinT = (float*)(ws + WS_SIN);
      for (int i = gtid; i < 16384 * 32; i += gthreads) { const int pos = i >> 5, k = i & 31; const float inv = powf(10000.0f, -(float)(2 * k) / 64.0f); const float ang = (float)pos * inv;
          cosT[i] = cosf(ang); sinT[i] = sinf(ang); } }
    { float* ssq = (float*)(ws + WS_SSQ); for (int i = gtid; i < 3 * TC * 2; i += gthreads) ssq[i] = 0.f; }
    { bf16_t* H2B = (bf16_t*)(ws + WS_H2B); const float *w1 = P.in[10], *b1 = P.in[11], *fq = P.in[12], *w2 = P.in[13], *b2 = P.in[14];
      const int wid = tid >> 6, lane = tid & 63; const float fr = fq[lane];
      for (int row = blockIdx.x * 8 + wid; row < 20480; row += gridDim.x * 8) {
          const int L = row < 4096 ? 4096 : 16384, m = row < 4096 ? row : row - 4096;
          const float t = (float)m / (float)(L - 1); const int kb = lane & 15;
          const float band = 1e-4f + (float)kb * ((15.0f - 1e-4f) / 15.0f); const float a0 = (6.283185307179586f * (float)m) / (float)L; const float ang = a0 * band;
          const float cv = cosf(ang), sv = -sinf(ang);
          float acc = b1[lane] + t * w1[lane];
#pragma unroll
          for (int k = 0; k < 16; ++k) { acc += __shfl(cv, k) * w1[(1 + k) * 64 + lane]; acc += __shfl(sv, k) * w1[(17 + k) * 64 + lane]; }
          const float h1 = sinf(fr * acc);
          float acc2 = b2[lane];
#pragma unroll 8
          for (int k = 0; k < 64; ++k) acc2 += __shfl(h1, k) * w2[k * 64 + lane];
          const float h2 = sinf(fr * acc2);
          const bf16_t hi = f2bf(h2); H2B[(size_t)row * 128 + lane] = hi; H2B[(size_t)row * 128 + 64 + lane] = f2bf(h2 - bf2f(hi));
      } }
}

__global__ void __launch_bounds__(512, 2) mega(Params P) {
    extern __shared__ __attribute__((aligned(16))) unsigned char smem[];
    cg::grid_group grid = cg::this_grid();
    PG8_LAS unsigned char* lds = (PG8_LAS unsigned char*)smem;
    unsigned char* ws = P.ws; const int lo = P.lo, hi = P.hi;
    const int gthreads = gridDim.x * 512;
    volatile LAS unsigned* xst = (volatile LAS unsigned*)(lds + LDS_FFT);
    if (threadIdx.x == 0) { xst[0] = 0u; xst[1] = 0u; }
    __syncthreads();
    XcdBarrier gbar = xcd_barrier_post((unsigned*)(ws + WS_BAR), xst);
    int ph = 0;
#define PH_BEGIN if (ph >= lo && ph < hi) { int tid = threadIdx.x; asm volatile("" : "+v"(tid)); const int gtid = blockIdx.x * 512 + tid;
#define PH_END } ++ph; if (ph > lo && ph < hi) { if (ph == 1) grid.sync(); else xcd_barrier(gbar); }
#define PH_END_NOSYNC } ++ph;
    const float* cosT = (const float*)(ws + WS_COS); const float* sinT = (const float*)(ws + WS_SIN);
    bf16_t* WIN = (bf16_t*)(ws + WS_WIN);
    PH_BEGIN
#if EN_PRO
 for (int rep = 0; rep < REP_PRO; ++rep) prologue(P, smem, tid);
#endif
 PH_END
    for (int g = 0; g < 2; ++g) {
        const int L = g ? 16384 : 4096, Tg = g ? 2 * TC : TC, seqmask = L - 1;
        const bf16_t* xb = (const bf16_t*)(P.out + (size_t)(g ? 2 : 1) * TC * 1024);
        const bf16_t* H2 = (const bf16_t*)(ws + WS_H2B) + (g ? (size_t)4096 * 128 : 0);
        bf16_t* UT = (bf16_t*)(ws + WS_UT); bf16_t* FT = (bf16_t*)(ws + WS_FT); bf16_t* ZT = (bf16_t*)(ws + WS_ZT); bf16_t* Z = (bf16_t*)(ws + WS_Z);
        PH_BEGIN
            for (int rep = 0; rep < REP_G; ++rep) run_gemm<0>(lds, (const bf16_t*)(ws + WS_W3B), H2, 4096, L, 128, FFilt{FT, L});
            for (int rep = 0; rep < REP_G; ++rep) run_gemm<1>(lds, WIN + (size_t)2816 * 1024, xb, 3072, Tg, 1024, FBf{UT, (size_t)Tg});
        PH_END
        PH_BEGIN
            for (int rep = 0; rep < REP_HY; ++rep)
            for (int c = blockIdx.x; c < 1024; c += gridDim.x) {
                c2* KS = (c2*)(P.out + (size_t)(g ? 1 : 0) * TC * 1024) + (size_t)blockIdx.x * 32768; c2* YC = KS + 16384;
#if EN_HY14
                if (g) hy::hyena_item<14>((LAS c2*)smem, UT, Tg, FT, ZT, c, P.in[3], P.in[4], P.in[16], KS, YC, tid);
#endif
#if EN_HY12
                if (!g) hy::hyena_item<12>((LAS c2*)smem, UT, Tg, FT, ZT, c, P.in[3], P.in[4], P.in[16], KS, YC, tid);
#endif
            }
        PH_END
        for (int ck = 0; ck < (g ? 2 : 1); ++ck) {
            const int chunk = g ? 1 + ck : 0;
            const bf16_t* xbc = xb + (size_t)ck * TC * 1024;
            const float* xin = g ? P.in[1] + (size_t)ck * TC * 1024 : P.in[0];
            float* Y = P.out + (size_t)chunk * TC * 1024;
            float* ssq = (float*)(ws + WS_SSQ) + (size_t)chunk * TC * 2;
            bf16_t *CQ = (bf16_t*)(ws + WS_CQ), *CKV = (bf16_t*)(ws + WS_CKV), *KR = (bf16_t*)(ws + WS_KR), *G = (bf16_t*)(ws + WS_G), *Q = (bf16_t*)(ws + WS_Q), *KV = (bf16_t*)(ws + WS_KV),
                   *O = (bf16_t*)(ws + WS_O), *MG = (bf16_t*)(ws + WS_MG), *X1B = (bf16_t*)(ws + WS_X1B), *HM = (bf16_t*)(ws + WS_HM), *AB = (bf16_t*)(ws + WS_AB);
            PH_BEGIN
                if (ck == 0) transpose_z((LAS bf16_t*)smem, ZT, Z, Tg, tid);
                run_gemm<2>(lds, xbc, WIN, TC, 2816, 1024, FTm{CQ, CKV, KR, G, ssq, cosT, sinT, seqmask});
            PH_END
            PH_BEGIN
                for (int rep = 0; rep < REP_G; ++rep) run_gemm<3>(lds, CQ, (const bf16_t*)(ws + WS_WUQ), TC, 1536, 384, FQ{Q, ssq, cosT, sinT, seqmask});
                for (int rep = 0; rep < REP_G; ++rep) run_gemm<4>(lds, CKV, (const bf16_t*)(ws + WS_WUKV), TC, 2048, 256, FKV{KV, ssq});
            PH_END
            PH_BEGIN
                const int nqb = L / 256;
                for (int rep = 0; rep < REP_ATT; ++rep)
                for (int i = blockIdx.x; i < 512; i += gridDim.x) {
                    const int h = i & 7, combo = i >> 3, b = combo / nqb, qb = combo % nqb;
                    const size_t r0 = (size_t)b * L;
#if EN_ATT
                    att::attn_unit(Q + (r0 + (size_t)qb * 256) * 1536, KV + r0 * 2048 + h * 256, KV + r0 * 2048 + h * 256 + 128, KR + r0 * 64,
                                   O + (r0 + (size_t)qb * 256) * 1024 + h * 128, L, (char*)smem, h);
#endif
                }
            PH_END
            PH_BEGIN
                run_gemm<5>(lds, Z + (size_t)ck * TC * 1024, (const bf16_t*)(ws + WS_WOHY), TC, 1024, 1024, FM1{MG, G});
                run_gemm<6>(lds, O, (const bf16_t*)(ws + WS_WOMLA), TC, 1024, 1024, FM2{MG, G});
            PH_END
            PH_BEGIN
                for (int rep = 0; rep < REP_G; ++rep) run_gemm<7>(lds, MG, (const bf16_t*)(ws + WS_WOUT), TC, 1024, 1024, FOut{Y, xin});
            PH_END
            PH_BEGIN ln_rows(Y, P.in[19], P.in[20], X1B, TC, tid); PH_END
            PH_BEGIN
                for (int rep = 0; rep < REP_G; ++rep) run_gemm<8>(lds, X1B, (const bf16_t*)(ws + WS_WUP), TC, 5632, 1024, FBf{AB, (size_t)5632});
            PH_END
            PH_BEGIN for (int rep = 0; rep < REP_SM; ++rep) ffn_mid(AB, HM, P.in[22], P.in[23], seqmask, tid); PH_END
            PH_BEGIN
                run_gemm<9>(lds, HM, (const bf16_t*)(ws + WS_WDOWN), TC, 1024, 2816, FDown{Y});
            PH_END
            PH_BEGIN ln_rows(Y, P.in[25], P.in[26], nullptr, TC, tid); PH_END_NOSYNC
        }
    }
}
constexpr int N_PHASES = 1 + 2 * 2 + 3 * 10;

extern "C" void kernel_launch(void* const* d_in, const int* in_sizes, int n_in, void* d_out, int out_size, void* d_ws, size_t ws_size, hipStream_t stream) {
    static int grid = 0;
    if (grid == 0) {
        if (n_in != 27 || out_size != 3 * TC * 1024 || ws_size < WS_END) { fprintf(stderr, "kernel_launch: unexpected shapes: n_in %d out %d ws %zu\n", n_in, out_size, ws_size); grid = -1; return; }
        int dev = 0, cus = 0, per_cu = 0;
        hipGetDevice(&dev); hipDeviceGetAttribute(&cus, hipDeviceAttributeMultiprocessorCount, dev);
        if (hipFuncSetAttribute((const void*)mega, hipFuncAttributeMaxDynamicSharedMemorySize, LDS_BYTES) != hipSuccess) { fprintf(stderr, "kernel_launch: hipFuncSetAttribute failed\n"); grid = -1; return; }
        if (hipOccupancyMaxActiveBlocksPerMultiprocessor(&per_cu, (const void*)mega, 512, LDS_BYTES) != hipSuccess || per_cu < 1) { fprintf(stderr, "kernel_launch: occupancy query says %d\n", per_cu); per_cu = 1; }
        (void)hipGetLastError();
        grid = cus * per_cu;
    }
    if (grid < 0) return;
    if (hipMemsetAsync((char*)d_ws + WS_BAR, 0, XCD_BAR_WORDS * 4, stream) != hipSuccess) { fprintf(stderr, "kernel_launch: memset of barrier words failed\n"); return; }
    Params p{};
    for (int i = 0; i < 27; ++i) p.in[i] = (const float*)d_in[i];
    p.out = (float*)d_out; p.ws = (unsigned char*)d_ws;
#if MK_MULTI
    for (int i = 0; i < N_PHASES; ++i) { p.lo = i; p.hi = i + 1; hipLaunchKernelGGL(mega, dim3(grid), dim3(512), LDS_BYTES, stream, p); }
#else
    p.lo = 0; p.hi = N_PHASES;
    void* args[] = {&p};
    hipError_t e = hipLaunchCooperativeKernel((void*)mega, dim3(grid), dim3(512), args, LDS_BYTES, stream);
    if (e != hipSuccess) fprintf(stderr, "cooperative launch failed: %s (grid %d)\n", hipGetErrorString(e), grid);
#endif
}
```

```cpp
#include <hip/hip_runtime.h>
#include <hip/hip_cooperative_groups.h>
#include <cstdio>
#include <cstdint>
namespace cg = cooperative_groups;
namespace pg8 {
#define PG8_LAS __attribute__((address_space(3)))
typedef unsigned short bf16_t;
typedef short bf16x8 __attribute__((ext_vector_type(8)));
typedef float f32x4 __attribute__((ext_vector_type(4)));
typedef unsigned u32x4 __attribute__((ext_vector_type(4)));
constexpr int BM = 256, BK = 64, HALF = 128, HTB = HALF * BK * 2  , STAGE_BYTES = 8 * HTB, NXCD = 8, WGM = 8;

__host__ __device__ __forceinline__ int lds_byte(int r, int c) { const int st = (r >> 4) * 2 + (c >> 5), rr = r & 15, cc = c & 31, ob = rr * 64 + cc * 2; return st * 1024 + (ob ^ (((ob >> 9) & 1) << 5)); }
__host__ __device__ __forceinline__ void stage_rc(int b, int& R, int& C) { const int st = b / 1024, sb = b % 1024, swz = sb ^ (((sb >> 9) & 1) << 5); R = (st >> 1) * 16 + swz / 64; C = (st & 1) * 32 + (swz % 64) / 2; }
__host__ __device__ __forceinline__ int perm32(int rho) { const int n = rho >> 4, i = rho & 15; return 8 * (i >> 2) + 4 * n + (i & 3); }

struct Unit { int pm, pn; };
struct Gemm { const bf16_t* A; const bf16_t* Bt; int M, N, K; };

struct StaticOrder {
    int nM, nN, nwg, G, c;
    __host__ __device__ void init(int M, int N, int G_, int c_) { nM = M / BM; nN = N / BM; nwg = nM * nN; G = G_; c = c_; }
    __host__ __device__ bool next(int i, Unit& u) const {
        const long L = (long)i * G + c; if (L >= nwg) return false;
        int wgid = (int)L; { const int q = nwg / NXCD, r = nwg % NXCD, xcd = wgid % NXCD, off = wgid / NXCD; wgid = (xcd < r ? xcd * (q + 1) : r * (q + 1) + (xcd - r) * q) + off; }
        const int nig = WGM * nN, gid = wgid / nig, fm = gid * WGM, gsz = (nM - fm) < WGM ? (nM - fm) : WGM;
        u.pm = fm + ((wgid % nig) % gsz); u.pn = (wgid % nig) / gsz; return true;
    }
    __device__ __forceinline__ void a_ready(const Unit&) const {}
    __device__ __forceinline__ void done(const Unit&) const {}
};

__device__ __forceinline__ unsigned cvt_pk_bf16(float lo, float hi) { unsigned r; asm volatile("v_cvt_pk_bf16_f32 %0, %1, %2" : "=v"(r) : "v"(lo), "v"(hi)); return r; }
typedef float f32x2 __attribute__((ext_vector_type(2)));
__device__ __forceinline__ f32x2 gelu_pk(f32x2 v) {
    const f32x2 av = __builtin_elementwise_abs(v), d = av * 0.2316418882f + 1.0f;
    f32x2 t; t.x = __builtin_amdgcn_rcpf(d.x); t.y = __builtin_amdgcn_rcpf(d.y);
    f32x2 q = t * 0.5307027145f + (-0.7265760135f); q = q * t + 0.7107068705f; q = q * t + (-0.142248368f); q = q * t + 0.127414796f; q = q * t;
    const f32x2 s = (v * v) * (-0.72134752044f);
    f32x2 e; e.x = __builtin_amdgcn_exp2f(s.x); e.y = __builtin_amdgcn_exp2f(s.y);
    const f32x2 m = v * (q * e), r = v - m;
    f32x2 o; o.x = v.x < 0.f ? m.x : r.x; o.y = v.y < 0.f ? m.y : r.y; return o;
}
template <class Epi, class Sched, bool ALIGN_EPI = false, bool SP2 = false>
__device__ __forceinline__ void gemm_phase(PG8_LAS unsigned char* lds, const Gemm g, const Sched& S, const Epi& E) {
    int tid = threadIdx.x; asm volatile("" : "+v"(tid));
    const int wid = __builtin_amdgcn_readfirstlane(tid >> 6), lane = tid & 63, wr = wid >> 2, wc = wid & 3, fr = lane & 15, fq = lane >> 4;
    const int K = g.K, nt = K / BK;
    unsigned voffA[2], voffB[2];
#pragma unroll
    for (int i = 0; i < 2; ++i) { int R, C; stage_rc(tid * 16 + i * 8192, R, C); const int Rb = Epi::PERM ? ((R & ~31) + perm32(R & 31)) : R;
        voffA[i] = (unsigned)(R * K + C) * 2u; voffB[i] = (unsigned)(Rb * K + C) * 2u; }
    const size_t kstep = (size_t)(BK * 2);
    const size_t hstep = (size_t)HALF * K * 2;
    const size_t tstep = 2 * hstep;
    const unsigned ldsw = (unsigned)wid * 1024u;
    const int aoff = lds_byte(wr * 64 + fr, fq * 8), boff = lds_byte(wc * 32 + fr, fq * 8);
#define PG8_SA(b, h) (((b) * 2 + (h)) * HTB)
#define PG8_SB(b, h) ((4 + (b) * 2 + (h)) * HTB)
#define PG8_STAGE(bufoff, gbase, voff) do { _Pragma("unroll") for (int _i = 0; _i < 2; ++_i) \
        __builtin_amdgcn_global_load_lds((const unsigned*)((const char*)(gbase) + (voff)[_i]), (PG8_LAS unsigned*)(lds + (bufoff) + ldsw + _i * 8192), 16, 0, 0); } while (0)
#define PG8_LDA(dst, b, h) do { _Pragma("unroll") for (int m = 0; m < 4; ++m) _Pragma("unroll") for (int k = 0; k < 2; ++k) dst[m][k] = *(const PG8_LAS bf16x8*)(lds + PG8_SA(b, h) + aoff + m * 2048 + k * 1024); } while (0)
#define PG8_LDB(dst, b, h) do { _Pragma("unroll") for (int n = 0; n < 2; ++n) _Pragma("unroll") for (int k = 0; k < 2; ++k) dst[n][k] = *(const PG8_LAS bf16x8*)(lds + PG8_SB(b, h) + boff + n * 2048 + k * 1024); } while (0)
#define PG8_MMA(ai, bj, At, Bt) do { __builtin_amdgcn_s_setprio(1); _Pragma("unroll") for (int m = 0; m < 4; ++m) _Pragma("unroll") for (int n = 0; n < 2; ++n) _Pragma("unroll") for (int k = 0; k < 2; ++k) \
        acc[ai][bj][m][n] = __builtin_amdgcn_mfma_f32_16x16x32_bf16(Bt[n][k], At[m][k], acc[ai][bj][m][n], 0, 0, 0); __builtin_amdgcn_s_setprio(0); } while (0)
#define PG8_WAIT_V(n) asm volatile("s_waitcnt vmcnt(" #n ")" ::: "memory")
#define PG8_WAIT_L(n) asm volatile("s_waitcnt lgkmcnt(" #n ")" ::: "memory")
#define PG8_BAR __builtin_amdgcn_s_barrier()
#define PG8_SCHED __builtin_amdgcn_sched_barrier(0)
    Unit cur, nxt; int ui = 0;
    if (!S.next(0, cur)) return;
    f32x4 acc[2][2][4][2];
#pragma unroll
    for (int a = 0; a < 2; ++a)
#pragma unroll
        for (int b = 0; b < 2; ++b)
#pragma unroll
            for (int m = 0; m < 4; ++m)
#pragma unroll
                for (int n = 0; n < 2; ++n) acc[a][b][m][n] = (f32x4){0.f, 0.f, 0.f, 0.f};
    bf16x8 At[4][2], B0[2][2], B1[2][2];
    const char* cA = (const char*)g.A + (size_t)cur.pm * tstep; const char* cB = (const char*)g.Bt + (size_t)cur.pn * tstep;
    S.a_ready(cur);
    if constexpr (SP2) {
        PG8_STAGE(PG8_SB(0, 0), cB, voffB); PG8_STAGE(PG8_SB(0, 1), cB + hstep, voffB); PG8_STAGE(PG8_SA(0, 0), cA, voffA); PG8_STAGE(PG8_SA(0, 1), cA + hstep, voffA);
        if (wr == 1) PG8_BAR;
        PG8_WAIT_V(2); PG8_BAR;
        PG8_STAGE(PG8_SB(1, 0), cB + kstep, voffB); PG8_STAGE(PG8_SA(1, 0), cA + kstep, voffA); PG8_STAGE(PG8_SB(1, 1), cB + hstep + kstep, voffB);
        PG8_WAIT_V(6); PG8_BAR;
    } else {
        PG8_STAGE(PG8_SB(0, 0), cB, voffB); PG8_STAGE(PG8_SA(0, 0), cA, voffA); PG8_STAGE(PG8_SB(0, 1), cB + hstep, voffB); PG8_STAGE(PG8_SA(0, 1), cA + hstep, voffA);
        if (wr == 1) PG8_BAR;
        PG8_WAIT_V(4); PG8_BAR;
        PG8_STAGE(PG8_SB(1, 0), cB + kstep, voffB); PG8_STAGE(PG8_SA(1, 0), cA + kstep, voffA); PG8_STAGE(PG8_SB(1, 1), cB + hstep + kstep, voffB);
        PG8_WAIT_V(6); PG8_BAR;
    }
    for (;;) {
        const bool has_next = S.next(ui + 1, nxt);
        const char* nA = has_next ? (const char*)g.A + (size_t)nxt.pm * tstep : cA; const char* nB = has_next ? (const char*)g.Bt + (size_t)nxt.pn * tstep : cB;
        for (int t = 0; t < nt; t += 2) {
            const bool last = (t == nt - 2);
            const char* a1 = cA + (size_t)(t + 1) * kstep;
            const char* a2 = last ? nA : cA + (size_t)(t + 2) * kstep; const char* b2 = last ? nB : cB + (size_t)(t + 2) * kstep;
            const char* a3 = a2 + kstep; const char* b3 = b2 + kstep;
            if (last && has_next) S.a_ready(nxt);
            if constexpr (SP2) {
            PG8_LDB(B0, 0, 0); PG8_LDB(B1, 0, 1); PG8_SCHED; PG8_LDA(At, 0, 0); PG8_STAGE(PG8_SA(1, 1), a1 + hstep, voffA);
            PG8_WAIT_V(8); PG8_WAIT_L(0); PG8_BAR; PG8_MMA(0, 0, At, B0); PG8_MMA(0, 1, At, B1); PG8_BAR; PG8_SCHED;
            PG8_LDA(At, 0, 1); PG8_STAGE(PG8_SB(0, 0), b2, voffB); PG8_STAGE(PG8_SB(0, 1), b2 + hstep, voffB); PG8_STAGE(PG8_SA(0, 0), a2, voffA);
            PG8_WAIT_V(8); PG8_WAIT_L(0); PG8_BAR; PG8_MMA(1, 0, At, B0); PG8_MMA(1, 1, At, B1); PG8_BAR; PG8_SCHED;
            PG8_LDB(B0, 1, 0); PG8_LDB(B1, 1, 1); PG8_SCHED; PG8_LDA(At, 1, 0); PG8_STAGE(PG8_SA(0, 1), a2 + hstep, voffA);
            PG8_WAIT_V(8); PG8_WAIT_L(0); PG8_BAR; PG8_MMA(0, 0, At, B0); PG8_MMA(0, 1, At, B1); PG8_BAR; PG8_SCHED;
            PG8_LDA(At, 1, 1); PG8_STAGE(PG8_SB(1, 0), b3, voffB); PG8_STAGE(PG8_SB(1, 1), b3 + hstep, voffB); PG8_STAGE(PG8_SA(1, 0), a3, voffA);
            PG8_WAIT_V(8); PG8_WAIT_L(0); PG8_BAR; PG8_MMA(1, 0, At, B0); PG8_MMA(1, 1, At, B1); PG8_BAR; PG8_SCHED;
            } else {
            PG8_LDB(B0, 0, 0); PG8_SCHED; PG8_LDA(At, 0, 0); PG8_STAGE(PG8_SA(1, 1), a1 + hstep, voffA);
            PG8_WAIT_L(8); PG8_BAR; PG8_WAIT_L(0); PG8_MMA(0, 0, At, B0); PG8_BAR; PG8_SCHED;
            PG8_LDB(B1, 0, 1); PG8_STAGE(PG8_SB(0, 0), b2, voffB);
            PG8_BAR; PG8_WAIT_L(0); PG8_MMA(0, 1, At, B1); PG8_BAR;
            PG8_LDA(At, 0, 1); PG8_STAGE(PG8_SA(0, 0), a2, voffA);
            PG8_BAR; PG8_WAIT_L(0); PG8_MMA(1, 0, At, B0); PG8_BAR; PG8_SCHED;
            PG8_STAGE(PG8_SB(0, 1), b2 + hstep, voffB);
            PG8_WAIT_V(6); PG8_BAR; PG8_MMA(1, 1, At, B1); PG8_BAR;
            PG8_LDB(B0, 1, 0); PG8_SCHED; PG8_LDA(At, 1, 0); PG8_STAGE(PG8_SA(0, 1), a2 + hstep, voffA);
            PG8_WAIT_L(8); PG8_BAR; PG8_WAIT_L(0); PG8_MMA(0, 0, At, B0); PG8_BAR; PG8_SCHED;
            PG8_LDB(B1, 1, 1); PG8_STAGE(PG8_SB(1, 0), b3, voffB);
            PG8_BAR; PG8_WAIT_L(0); PG8_MMA(0, 1, At, B1); PG8_BAR;
            PG8_LDA(At, 1, 1); PG8_STAGE(PG8_SA(1, 0), a3, voffA);
            PG8_BAR; PG8_WAIT_L(0); PG8_MMA(1, 0, At, B0); PG8_BAR; PG8_SCHED;
            PG8_STAGE(PG8_SB(1, 1), b3 + hstep, voffB);
            PG8_WAIT_V(6); PG8_BAR; PG8_MMA(1, 1, At, B1); PG8_BAR;
            }
        }
        if constexpr (ALIGN_EPI) { if (wr == 0) PG8_BAR; }
        if constexpr (!Epi::AFTER_DRAIN) { E(acc, cur, wr, wc, fr, fq); S.done(cur); }
        if (!has_next) break;
#pragma unroll
        for (int a = 0; a < 2; ++a)
#pragma unroll
            for (int b = 0; b < 2; ++b)
#pragma unroll
                for (int m = 0; m < 4; ++m)
#pragma unroll
                    for (int n = 0; n < 2; ++n) acc[a][b][m][n] = (f32x4){0.f, 0.f, 0.f, 0.f};
        cur = nxt; cA = nA; cB = nB; ++ui;
        if constexpr (ALIGN_EPI) { if (wr == 1) PG8_BAR; }
    }
    PG8_WAIT_V(0);
    if constexpr (!ALIGN_EPI) { if (wr == 0) PG8_BAR; }
    PG8_BAR;
    if constexpr (Epi::AFTER_DRAIN) { E.fused(acc, cur, wr, wc, fr, fq, lds, wid, lane); S.done(cur); }
#undef PG8_SA
#undef PG8_SB
#undef PG8_STAGE
#undef PG8_LDA
#undef PG8_LDB
#undef PG8_MMA
#undef PG8_WAIT_V
#undef PG8_WAIT_L
#undef PG8_BAR
#undef PG8_SCHED
}
}

#ifndef EN_PRO
#define EN_PRO 1
#endif
#ifndef EN_HY14
#define EN_HY14 1
#endif
#ifndef EN_HY12
#define EN_HY12 1
#endif
#ifndef EN_ATT
#define EN_ATT 1
#endif
#ifndef EN_GEMM
#define EN_GEMM 0xffff
#endif
#ifndef EPI_FENCE
#define EPI_FENCE 1
#endif
#ifndef G_ALIGN
#define G_ALIGN true
#endif
#ifndef G_SP2
#define G_SP2 true
#endif
#ifndef REP_ATT
#define REP_ATT 1
#endif
#ifndef REP_HY
#define REP_HY 1
#endif
#ifndef REP_G
#define REP_G 1
#endif
#ifndef REP_SM
#define REP_SM 1
#endif
#ifndef REP_PRO
#define REP_PRO 1
#endif
#ifndef UNR_K
#define UNR_K 8
#endif
#ifndef UNR_Z
#define UNR_Z 8
#endif
#ifndef UNR_Y
#define UNR_Y 8
#endif
#ifndef UNR_F
#define UNR_F 4
#endif
#ifndef MK_MULTI
#define MK_MULTI 0
#endif
#define LAS __attribute__((address_space(3)))
#define XB_TMO      128
#define XB_XCNT(j)  (256  + 64 * (j))
#define XB_XSUB(j)  (1280 + 64 * (j))
#define XB_XGEN(j)  (2304 + 64 * (j))
#define XB_TOP      3328
#define XB_TOPGEN   3392
#define XCD_BAR_WORDS 3456
#define XB_SPIN_CAP (1u << 18)
__device__ __forceinline__ unsigned xb_ld(unsigned* p)              { return __hip_atomic_load(p, __ATOMIC_RELAXED, __HIP_MEMORY_SCOPE_AGENT); }
__device__ __forceinline__ unsigned xb_add(unsigned* p, unsigned v) { return __hip_atomic_fetch_add(p, v, __ATOMIC_RELAXED, __HIP_MEMORY_SCOPE_AGENT); }
__device__ __forceinline__ unsigned xb_xcc_id() { return (unsigned)__builtin_amdgcn_s_getreg((3 << 11) | 20) & 0xFu; }
#define XB_SPIN(cond, bar) do { unsigned _sp = 0; while (cond) { __builtin_amdgcn_s_sleep(1); \
    if ((++_sp & 255u) == 0u) { if (xb_ld(&(bar)[XB_TMO])) break; if (_sp > XB_SPIN_CAP) { atomicAdd(&(bar)[XB_TMO], 1u); break; } } } } while (0)

struct XcdBarrier {
    unsigned* bar; unsigned x;
    volatile LAS unsigned* st;
};

__device__ __forceinline__ XcdBarrier xcd_barrier_post(unsigned* bar, volatile LAS unsigned* st) {
    XcdBarrier b; b.bar = bar; b.x = xb_xcc_id(); b.st = st;
    if (threadIdx.x == 0) (void)xb_add(&bar[XB_XCNT(b.x)], 1u);
    return b;
}
__device__ __forceinline__ void xcd_barrier_complete(unsigned* bar, unsigned x, unsigned& nloc, unsigned& nx) {
    const unsigned G = gridDim.x * gridDim.y * gridDim.z;
    unsigned sum, cnt, mine, sp = 0u;
    for (;;) {
        sum = 0u; cnt = 0u; mine = 0u;
#pragma unroll
        for (unsigned j = 0; j < 16; ++j) { const unsigned c = xb_ld(&bar[XB_XCNT(j)]); sum += c; cnt += (c > 0u) ? 1u : 0u; mine = (j == x) ? c : mine; }
        if (sum == G) break;
        __builtin_amdgcn_s_sleep(1);
        if ((++sp & 255u) == 0u) { if (xb_ld(&bar[XB_TMO])) break; if (sp > XB_SPIN_CAP) { atomicAdd(&bar[XB_TMO], 1u); break; } }
    }
    nloc = mine > 0u ? mine : 1u; nx = cnt > 0u ? cnt : 1u;
}

__device__ __forceinline__ void xcd_barrier(const XcdBarrier& b) {
    asm volatile("s_waitcnt vmcnt(0)" ::: "memory");
    __syncthreads();
    if (threadIdx.x == 0) {
        unsigned* bar = b.bar;
        __builtin_amdgcn_s_waitcnt(0);
        unsigned nloc = b.st[0], nx = b.st[1];
        if (nloc == 0u) { xcd_barrier_complete(bar, b.x, nloc, nx); b.st[0] = nloc; b.st[1] = nx; }
        const unsigned old = xb_add(&bar[XB_XSUB(b.x)], 1u);
        const unsigned gen = old / nloc;
        if (old + 1u == (gen + 1u) * nloc) {
            __builtin_amdgcn_fence(__ATOMIC_RELEASE, "agent");
            asm volatile("s_waitcnt vmcnt(0)" ::: "memory");
            const unsigned og = xb_add(&bar[XB_TOP], 1u);
            const unsigned tg = og / nx;
            if (og + 1u == (tg + 1u) * nx) xb_add(&bar[XB_TOPGEN], 1u);
            else XB_SPIN(xb_ld(&bar[XB_TOPGEN]) == tg, bar);
            __builtin_amdgcn_fence(__ATOMIC_ACQUIRE, "agent");
            xb_add(&bar[XB_XGEN(b.x)], 1u);
            asm volatile("s_waitcnt vmcnt(0)" ::: "memory");
        } else {
            XB_SPIN(xb_ld(&bar[XB_XGEN(b.x)]) == gen, bar);
            __builtin_amdgcn_fence(__ATOMIC_ACQUIRE, "agent");
            asm volatile("s_waitcnt vmcnt(0)" ::: "memory");
        }
    }
    __syncthreads();
}

using pg8::bf16_t; using pg8::f32x4; using pg8::u32x4; using pg8::Unit;
typedef float c2 __attribute__((ext_vector_type(2)));

constexpr int TC = 16384;
constexpr int LDS_FFT = 139264;
constexpr int LDS_BYTES = LDS_FFT + 16;
constexpr float DN_ALPHA = 1.189207115002721f, LN_EPS = 1e-5f, RMS_EPS = 1e-6f;
constexpr size_t MiB = 1u << 20;
constexpr size_t WS_WIN = 0, WS_WUQ = 12 * MiB, WS_WUKV = 14 * MiB, WS_WOMLA = 15 * MiB, WS_WOHY = 17 * MiB, WS_WOUT = 19 * MiB, WS_WUP = 21 * MiB,
                 WS_WDOWN = 32 * MiB, WS_W3B = 38 * MiB, WS_COS = 40 * MiB, WS_SIN = 42 * MiB, WS_H2B = 44 * MiB, WS_SSQ = 50 * MiB, WS_BAR = 51 * MiB, WS_Z = 52 * MiB,
                 WS_UT = 116 * MiB, WS_FT = 308 * MiB, WS_ZT = 436 * MiB,
                 WS_CQ = 116 * MiB, WS_CKV = 128 * MiB, WS_KR = 136 * MiB, WS_G = 138 * MiB, WS_Q = 202 * MiB, WS_KV = 250 * MiB, WS_O = 314 * MiB,
                 WS_MG = 346 * MiB, WS_X1B = 378 * MiB, WS_HM = 410 * MiB, WS_AB = 116 * MiB, WS_END = 512 * MiB;

__device__ __forceinline__ float bflo(unsigned w) { return __uint_as_float(w << 16); }
__device__ __forceinline__ float bfhi(unsigned w) { return __uint_as_float(w & 0xffff0000u); }
__device__ __forceinline__ float bf2f(bf16_t v) { return __uint_as_float(((unsigned)v) << 16); }
__device__ __forceinline__ unsigned pk(float lo, float hi) { return pg8::cvt_pk_bf16(lo, hi); }
__device__ __forceinline__ bf16_t f2bf(float v) { return (bf16_t)(pk(v, 0.f) & 0xffffu); }
__device__ __forceinline__ void st8(bf16_t* p, f32x4 a, f32x4 b) { u32x4 w; w.x = pk(a[0], a[1]); w.y = pk(a[2], a[3]); w.z = pk(b[0], b[1]); w.w = pk(b[2], b[3]); *(u32x4*)p = w; }
__device__ __forceinline__ void ld8(const bf16_t* p, f32x4& a, f32x4& b) { const u32x4 w = *(const u32x4*)p;
    a[0] = bflo(w.x); a[1] = bfhi(w.x); a[2] = bflo(w.y); a[3] = bfhi(w.y); b[0] = bflo(w.z); b[1] = bfhi(w.z); b[2] = bflo(w.w); b[3] = bfhi(w.w); }

template <class F> struct Epi8 {
    static constexpr bool PERM = true, AFTER_DRAIN = false;
    F f;
    __device__ __forceinline__ void operator()(const f32x4 (&acc)[2][2][4][2], const Unit& u, int wr, int wc, int fr, int fq) const {
        const int row0 = u.pm * pg8::BM + wr * 64 + fr, col0 = u.pn * pg8::BM + wc * 32 + 8 * fq;
#pragma unroll
        for (int ai = 0; ai < 2; ++ai)
#pragma unroll
            for (int m = 0; m < 4; ++m)
#pragma unroll
                for (int bj = 0; bj < 2; ++bj) { f(row0 + ai * pg8::HALF + m * 16, col0 + bj * pg8::HALF, acc[ai][bj][m][0], acc[ai][bj][m][1], fq);
                  if (EPI_FENCE) asm volatile("" ::: "memory"); }
    }
};
__device__ __forceinline__ void rope8(f32x4& a, f32x4& b, const float* cosT, const float* sinT, int pos, int i0) {
    const f32x4 c = *(const f32x4*)(cosT + pos * 32 + i0), s = *(const f32x4*)(sinT + pos * 32 + i0);
    f32x4 oa, ob;
    oa[0] = a[0] * c[0] - a[1] * s[0]; oa[1] = a[0] * s[0] + a[1] * c[0]; oa[2] = a[2] * c[1] - a[3] * s[1]; oa[3] = a[2] * s[1] + a[3] * c[1];
    ob[0] = b[0] * c[2] - b[1] * s[2]; ob[1] = b[0] * s[2] + b[1] * c[2]; ob[2] = b[2] * c[3] - b[3] * s[3]; ob[3] = b[2] * s[3] + b[3] * c[3];
    a = oa; b = ob;
}
__device__ __forceinline__ float sigm(float x) { return 1.0f / (1.0f + __expf(-x)); }
struct FTm { bf16_t *CQ, *CKV, *KR, *G; float* ssq; const float *cosT, *sinT; int seqmask;
    __device__ __forceinline__ void operator()(int row, int col, f32x4 a, f32x4 b, int fq) const {
        if (col < 640) {
            float s = (a[0] * a[0] + a[1] * a[1]) + (a[2] * a[2] + a[3] * a[3]) + (b[0] * b[0] + b[1] * b[1]) + (b[2] * b[2] + b[3] * b[3]);
            s += __shfl_xor(s, 16); s += __shfl_xor(s, 32);
            if (col < 384) { st8(CQ + (size_t)row * 384 + col, a, b); if (fq == 0) __hip_atomic_fetch_add(ssq + row * 2, s, __ATOMIC_RELAXED, __HIP_MEMORY_SCOPE_AGENT); }
            else { st8(CKV + (size_t)row * 256 + (col - 384), a, b); if (fq == 0) __hip_atomic_fetch_add(ssq + row * 2 + 1, s, __ATOMIC_RELAXED, __HIP_MEMORY_SCOPE_AGENT); }
        } else if (col < 704) {
            const int j = col - 640; rope8(a, b, cosT, sinT, row & seqmask, j >> 1); st8(KR + (size_t)row * 64 + j, a, b);
        } else if (col < 2752) {
#pragma unroll
            for (int i = 0; i < 4; ++i) { a[i] = sigm(a[i]); b[i] = sigm(b[i]); }
            st8(G + (size_t)row * 2048 + (col - 704), a, b);
        }
    }
};
struct FQ { bf16_t* Q; const float* ssq; const float *cosT, *sinT; int seqmask;
    __device__ __forceinline__ void operator()(int row, int col, f32x4 a, f32x4 b, int) const {
        const float rs = rsqrtf(ssq[row * 2] * (1.0f / 384.0f) + RMS_EPS); a = a * rs; b = b * rs;
        if (col >= 1024) rope8(a, b, cosT, sinT, row & seqmask, ((col - 1024) & 63) >> 1);
        st8(Q + (size_t)row * 1536 + col, a, b);
    }
};
struct FKV { bf16_t* KV; const float* ssq;
    __device__ __forceinline__ void operator()(int row, int col, f32x4 a, f32x4 b, int) const {
        const float rs = rsqrtf(ssq[row * 2 + 1] * (1.0f / 256.0f) + RMS_EPS); st8(KV + (size_t)row * 2048 + col, a * rs, b * rs);
    }
};
struct FBf { bf16_t* O; size_t ld;
    __device__ __forceinline__ void operator()(int row, int col, f32x4 a, f32x4 b, int) const { st8(O + (size_t)row * ld + col, a, b); }
};
struct FFilt { bf16_t* FT; int L;
    __device__ __forceinline__ void operator()(int row, int col, f32x4 a, f32x4 b, int) const {
        const int c = row & 1023; const float MIN_DECAY = -3.0701134573253944f, MAX_DECAY = -15.350567286626973f;
        const float kk = -1.4426950408889634f * fabsf(MIN_DECAY + (MAX_DECAY - MIN_DECAY) * ((float)c * (1.0f / 1023.0f))) / (float)(L - 1); const float fc = (float)col;
#pragma unroll
        for (int i = 0; i < 4; ++i) { a[i] *= __builtin_amdgcn_exp2f((fc + (float)i) * kk) + 0.05f; b[i] *= __builtin_amdgcn_exp2f((fc + (float)(4 + i)) * kk) + 0.05f; }
        st8(FT + (size_t)row * L + col, a, b);
    }
};
struct FM1 { bf16_t* MG; const bf16_t* G;
    __device__ __forceinline__ void operator()(int row, int col, f32x4 a, f32x4 b, int) const {
        f32x4 ga, gb; ld8(G + (size_t)row * 2048 + col, ga, gb); st8(MG + (size_t)row * 1024 + col, a * ga, b * gb);
    }
};
struct FM2 { bf16_t* MG; const bf16_t* G;
    __device__ __forceinline__ void operator()(int row, int col, f32x4 a, f32x4 b, int) const {
        f32x4 ga, gb, pa, pb; ld8(G + (size_t)row * 2048 + 1024 + col, ga, gb); ld8(MG + (size_t)row * 1024 + col, pa, pb);
        st8(MG + (size_t)row * 1024 + col, pa + a * ga, pb + b * gb);
    }
};
struct FOut { float* Y; const float* X;
    __device__ __forceinline__ void operator()(int row, int col, f32x4 a, f32x4 b, int) const {
        const size_t o = (size_t)row * 1024 + col; const f32x4 xa = *(const f32x4*)(X + o), xb = *(const f32x4*)(X + o + 4);
        *(f32x4*)(Y + o) = xa * DN_ALPHA + a; *(f32x4*)(Y + o + 4) = xb * DN_ALPHA + b;
    }
};
struct FDown { float* Y;
    __device__ __forceinline__ void operator()(int row, int col, f32x4 a, f32x4 b, int) const {
        const size_t o = (size_t)row * 1024 + col; const f32x4 xa = *(const f32x4*)(Y + o), xb = *(const f32x4*)(Y + o + 4);
        *(f32x4*)(Y + o) = xa * DN_ALPHA + a; *(f32x4*)(Y + o + 4) = xb * DN_ALPHA + b;
    }
};
template <int ID, class F> __device__ __forceinline__ void run_gemm(PG8_LAS unsigned char* lds, const bf16_t* A, const bf16_t* Bt, int M, int N, int K, const F& f) {
  if constexpr ((EN_GEMM >> ID) & 1) {
    asm volatile("" : "+s"(M), "+s"(N), "+s"(K));
    pg8::Gemm g{A, Bt, M, N, K}; pg8::StaticOrder S; S.init(M, N, (int)gridDim.x, (int)blockIdx.x);
    Epi8<F> E{f};
    pg8::gemm_phase<Epi8<F>, pg8::StaticOrder, G_ALIGN, (ID != 0 && ID != 3)>(lds, g, S, E);
  }
}

namespace att {
typedef short bf16x8 __attribute__((ext_vector_type(8)));
typedef short s16x4 __attribute__((ext_vector_type(4)));
typedef float f32x16 __attribute__((ext_vector_type(16)));
constexpr int NW = 8, QBLK = 32, KVBLK = 64, LDQ = 1536, LDK = 2048, LDKR = 64, LDO = 1024;
constexpr float SCALE = 0.07216878364870323f, THR = 8.f;
constexpr int SHM_V = 16384, SHM_K = 24576;
#define AKSWZ(row, colB) ((row) * 384 + ((colB) ^ (((row) & 7) << 4)))
#define SBAR() __builtin_amdgcn_sched_barrier(0)
__device__ __forceinline__ int crow(int r, int hi) { return (r & 3) + 8 * (r >> 2) + 4 * hi; }
__device__ __forceinline__ void partialSM(f32x16& p0, f32x16& p1, float& m_reg, float& mn, float& alpha) {
  constexpr float C = SCALE * 1.4426950408889634f;
  float pmax = p0[0]; for (int r = 1; r < 16; ++r) pmax = fmaxf(pmax, p0[r]); for (int r = 0; r < 16; ++r) pmax = fmaxf(pmax, p1[r]);
  { auto rr = __builtin_amdgcn_permlane32_swap(__float_as_uint(pmax), __float_as_uint(pmax), false, false);
    pmax = fmaxf(__uint_as_float(rr[0]), __uint_as_float(rr[1])); }
  if (__builtin_expect(__all(pmax - m_reg <= THR / SCALE), 1)) { mn = m_reg; alpha = 1.f; }
  else { mn = fmaxf(m_reg, pmax); alpha = __builtin_amdgcn_exp2f((m_reg - mn) * C); m_reg = mn; }
  float mnC = -mn * C;
  for (int r = 0; r < 16; ++r) p0[r] = fmaf(p0[r], C, mnC); for (int r = 0; r < 16; ++r) p1[r] = fmaf(p1[r], C, mnC);
  for (int r = 0; r < 16; ++r) p0[r] = __builtin_amdgcn_exp2f(p0[r]);
}
__device__ __forceinline__ void finishSM(f32x16& p0, f32x16& p1, float alpha, float& l_reg, bf16x8& pa0, bf16x8& pa1, bf16x8& pa2, bf16x8& pa3) {
  for (int r = 0; r < 16; ++r) p1[r] = __builtin_amdgcn_exp2f(p1[r]);
  float ps = 0; for (int r = 0; r < 16; ++r) ps += p0[r]; for (int r = 0; r < 16; ++r) ps += p1[r];
  { auto rr = __builtin_amdgcn_permlane32_swap(__float_as_uint(ps), __float_as_uint(ps), false, false);
    ps = __uint_as_float(rr[0]) + __uint_as_float(rr[1]); }
  l_reg = l_reg * alpha + ps;
#define PK4(P, BASE, OUT) do { unsigned a0 = pk(P[BASE + 0], P[BASE + 1]), a1 = pk(P[BASE + 2], P[BASE + 3]);   \
    unsigned b0 = pk(P[BASE + 4], P[BASE + 5]), b1 = pk(P[BASE + 6], P[BASE + 7]);                              \
    auto r0 = __builtin_amdgcn_permlane32_swap(a0, b0, false, false); auto r1 = __builtin_amdgcn_permlane32_swap(a1, b1, false, false); \
    u32x4 w = {r0[0], r1[0], r0[1], r1[1]}; OUT = *reinterpret_cast<bf16x8*>(&w); } while (0)
  PK4(p0, 0, pa0); PK4(p0, 8, pa1); PK4(p1, 0, pa2); PK4(p1, 8, pa3);
#undef PK4
}
__device__ __forceinline__ void qkt(f32x16& p0, f32x16& p1, const char* Ks, const bf16x8* qr, const bf16x8* qrl, int r32, int hi) {
  p0 = f32x16{}; p1 = f32x16{};
  int kb[4];
#pragma unroll
  for (int dl = 0; dl < 4; ++dl) kb[dl] = r32 * 384 + ((dl * 32 + hi * 16) ^ ((r32 & 7) << 4));
#pragma unroll
  for (int d0 = 0; d0 < 12; ++d0) {
    bf16x8 b0 = *reinterpret_cast<const bf16x8*>(Ks + kb[d0 & 3] + (d0 >> 2) * 128);
    bf16x8 b1 = *reinterpret_cast<const bf16x8*>(Ks + kb[d0 & 3] + (d0 >> 2) * 128 + 32 * 384);
    const bf16x8 qv = (d0 < 8) ? qr[d0 & 7] : qrl[(d0 - 8) * 64];
    p0 = __builtin_amdgcn_mfma_f32_32x32x16_bf16(b0, qv, p0, 0, 0, 0);
    p1 = __builtin_amdgcn_mfma_f32_32x32x16_bf16(b1, qv, p1, 0, 0, 0); }
}
__device__ __forceinline__ int v_st(int k, int c) { const int kk = (k & ~0xC) | ((k & 4) << 1) | ((k & 8) >> 1); return ((kk >> 3) * 4 + (c >> 5)) * 512 + ((kk & 7) * 32 + (c & 31)) * 2; }
__device__ __forceinline__ int v_rd_base(int lane) { return ((lane & 3) << 3) | (((lane >> 2) & 3) << 6) | (((lane >> 4) & 1) << 5) | (((lane >> 5) & 1) << 8); }
constexpr int v_rd_off(int d0, int ks, int half) { return d0 * 512 + ks * 4096 + half * 2048; }
template <int OFF> __device__ __forceinline__ s16x4 tr_read(int vb) {
  s16x4 r; asm volatile("ds_read_b64_tr_b16 %0, %1 offset:%2" : "=&v"(r) : "v"(vb), "i"(OFF) : "memory"); return r;
}
template <int D0> __device__ __forceinline__ void pv_one(f32x16& od, int vb, bf16x8 pa0, bf16x8 pa1, bf16x8 pa2, bf16x8 pa3) {
  const s16x4 l0 = tr_read<v_rd_off(D0, 0, 0)>(vb), h0 = tr_read<v_rd_off(D0, 0, 1)>(vb), l1 = tr_read<v_rd_off(D0, 1, 0)>(vb), h1 = tr_read<v_rd_off(D0, 1, 1)>(vb);
  const s16x4 l2 = tr_read<v_rd_off(D0, 2, 0)>(vb), h2 = tr_read<v_rd_off(D0, 2, 1)>(vb), l3 = tr_read<v_rd_off(D0, 3, 0)>(vb), h3 = tr_read<v_rd_off(D0, 3, 1)>(vb);
  asm volatile("s_waitcnt lgkmcnt(0)" ::: "memory"); SBAR();
#define PKV(L, H) (bf16x8){L[0], L[1], L[2], L[3], H[0], H[1], H[2], H[3]}
  od = __builtin_amdgcn_mfma_f32_32x32x16_bf16(pa0, PKV(l0, h0), od, 0, 0, 0);
  od = __builtin_amdgcn_mfma_f32_32x32x16_bf16(pa1, PKV(l1, h1), od, 0, 0, 0);
  od = __builtin_amdgcn_mfma_f32_32x32x16_bf16(pa2, PKV(l2, h2), od, 0, 0, 0);
  od = __builtin_amdgcn_mfma_f32_32x32x16_bf16(pa3, PKV(l3, h3), od, 0, 0, 0);
#undef PKV
}
__device__ __forceinline__ void pv_d0(f32x16* o, int vb, bf16x8 pa0, bf16x8 pa1, bf16x8 pa2, bf16x8 pa3) {
  pv_one<0>(o[0], vb, pa0, pa1, pa2, pa3); pv_one<1>(o[1], vb, pa0, pa1, pa2, pa3); pv_one<2>(o[2], vb, pa0, pa1, pa2, pa3); pv_one<3>(o[3], vb, pa0, pa1, pa2, pa3);
}
__device__ __forceinline__ void attn_unit(const bf16_t* __restrict__ Qb, const bf16_t* __restrict__ Kh, const bf16_t* __restrict__ Vh, const bf16_t* __restrict__ KRb,
                                          bf16_t* __restrict__ Ob, int seq, char* lds, int h) {
  int tid = threadIdx.x; asm volatile("" : "+v"(tid));
  const int wid = tid >> 6, lane = tid & 63, r32 = lane & 31, hi = lane >> 5;
  char* V_lds = lds; char* K_lds = lds + 2 * SHM_V;
  float* ws = (float*)(lds + 2 * SHM_V + 2 * SHM_K) + wid * 64; float* li_l = ws; float* al_l = ws + 32;
  float m_reg = -1e30f, l_reg = 0; f32x16 o[4] = {}; bf16x8 qr[8];
  bf16x8* qrl = (bf16x8*)(lds + 2 * SHM_V + 2 * SHM_K + 2048) + wid * 256 + lane;
  const bf16_t* Qw = Qb + (long)(wid * QBLK + r32) * LDQ + hi * 8 + h * 128;
  const bf16_t* Qwr = Qb + (long)(wid * QBLK + r32) * LDQ + hi * 8 + 1024 + h * 64;
#pragma unroll
  for (int d0 = 0; d0 < 8; ++d0) qr[d0] = *reinterpret_cast<const bf16x8*>(Qw + d0 * 16);
#pragma unroll
  for (int d0 = 8; d0 < 12; ++d0) qrl[(d0 - 8) * 64] = *reinterpret_cast<const bf16x8*>(Qwr + (d0 - 8) * 16);
  const int sr = tid >> 4, sc = (tid & 15) * 8, vst0 = v_st(sr, sc), vst1 = v_st(32 + sr, sc);
  const int rr = tid >> 3, rc = (tid & 7) * 8;
  const int vb0 = (int)(uintptr_t)V_lds + v_rd_base(lane);
  bf16x8 vs0, vs1, ks0, ks1, kr0;
#define SLOAD(k0) do { vs0 = *reinterpret_cast<const bf16x8*>(&Vh[(long)((k0) + sr) * LDK + sc]); vs1 = *reinterpret_cast<const bf16x8*>(&Vh[(long)((k0) + 32 + sr) * LDK + sc]); \
    ks0 = *reinterpret_cast<const bf16x8*>(&Kh[(long)((k0) + sr) * LDK + sc]); ks1 = *reinterpret_cast<const bf16x8*>(&Kh[(long)((k0) + 32 + sr) * LDK + sc]); \
    kr0 = *reinterpret_cast<const bf16x8*>(&KRb[(long)((k0) + rr) * LDKR + rc]); } while (0)
#define SWRITE(b) do { *(bf16x8*)(V_lds + (b) * SHM_V + vst0) = vs0; *(bf16x8*)(V_lds + (b) * SHM_V + vst1) = vs1; int kc = sc * 2; \
    *(bf16x8*)(K_lds + (b) * SHM_K + AKSWZ(sr, kc)) = ks0; *(bf16x8*)(K_lds + (b) * SHM_K + AKSWZ(32 + sr, kc)) = ks1; \
    *(bf16x8*)(K_lds + (b) * SHM_K + AKSWZ(rr, 256 + rc * 2)) = kr0; } while (0)
#define SWAIT() asm volatile("s_waitcnt vmcnt(0)" ::: "memory")
#define RESC(a) do { if (__any((a) < 1.f)) { if (hi == 0) al_l[r32] = (a); asm volatile("s_waitcnt lgkmcnt(0)" ::: "memory"); \
    for (int d = 0; d < 4; ++d) for (int r = 0; r < 16; ++r) o[d][r] *= al_l[crow(r, hi)]; } } while (0)
  f32x16 pA0, pA1, pB0, pB1; float mnA, mnB, alA, alB; bf16x8 pa0, pa1, pa2, pa3; const int NT = seq / KVBLK;
  SLOAD(0); SWAIT(); SWRITE(0); __syncthreads();
  qkt(pA0, pA1, K_lds, qr, qrl, r32, hi); partialSM(pA0, pA1, m_reg, mnA, alA);
  SLOAD(KVBLK);
  SWAIT(); SWRITE(1); __syncthreads();
  for (int j = 1; j + 1 < NT; j += 2) {
    SBAR(); qkt(pB0, pB1, K_lds + SHM_K, qr, qrl, r32, hi);
    finishSM(pA0, pA1, alA, l_reg, pa0, pa1, pa2, pa3); SBAR();
    SLOAD((j + 1) * KVBLK); SBAR();
    pv_d0(o, vb0, pa0, pa1, pa2, pa3); partialSM(pB0, pB1, m_reg, mnB, alB);
    __syncthreads(); SWAIT(); SWRITE(0);
    RESC(alB); __syncthreads();
    SBAR(); qkt(pA0, pA1, K_lds, qr, qrl, r32, hi);
    finishSM(pB0, pB1, alB, l_reg, pa0, pa1, pa2, pa3); SBAR();
    SLOAD((j + 2) * KVBLK); SBAR();
    pv_d0(o, vb0 + SHM_V, pa0, pa1, pa2, pa3); partialSM(pA0, pA1, m_reg, mnA, alA);
    __syncthreads(); SWAIT(); SWRITE(1);
    RESC(alA); __syncthreads();
  }
  SBAR(); qkt(pB0, pB1, K_lds + SHM_K, qr, qrl, r32, hi);
  finishSM(pA0, pA1, alA, l_reg, pa0, pa1, pa2, pa3); SBAR();
  pv_d0(o, vb0, pa0, pa1, pa2, pa3); partialSM(pB0, pB1, m_reg, mnB, alB);
  __syncthreads(); RESC(alB);
  finishSM(pB0, pB1, alB, l_reg, pa0, pa1, pa2, pa3); SBAR();
  pv_d0(o, vb0 + SHM_V, pa0, pa1, pa2, pa3);
  if (hi == 0) li_l[r32] = l_reg; asm volatile("s_waitcnt lgkmcnt(0)" ::: "memory");
  float rli[16];
#pragma unroll
  for (int r = 0; r < 16; ++r) rli[r] = __builtin_amdgcn_rcpf(li_l[crow(r, hi)]);
  bf16_t* Ow = Ob + (long)(wid * QBLK) * LDO;
#pragma unroll
  for (int r = 0; r < 16; ++r) { int orow = crow(r, hi);
#pragma unroll
    for (int d0 = 0; d0 < 4; ++d0) Ow[(long)orow * LDO + d0 * 32 + r32] = f2bf(o[d0][r] * rli[r]); }
  __syncthreads();
#undef SLOAD
#undef SWRITE
#undef SWAIT
#undef RESC
}
}

namespace hy {
__device__ __forceinline__ c2 cmul(c2 a, c2 b) { return (c2){a.x * b.x - a.y * b.y, a.x * b.y + a.y * b.x}; }
__device__ __forceinline__ c2 cmulc(c2 a, c2 b) { return (c2){a.x * b.x + a.y * b.y, a.y * b.x - a.x * b.y}; }
__device__ __forceinline__ c2 twid(float fr) { return (c2){__builtin_amdgcn_cosf(fr), -__builtin_amdgcn_sinf(fr)}; }
struct T2 { c2 w, wr; };
__device__ __forceinline__ T2 mk(c2 w) { T2 t; t.w = w; t.wr = (c2){-w.y, w.x}; return t; }
__device__ __forceinline__ c2 mulT(c2 x, const T2& t) { return x.xx * t.w + x.yy * t.wr; }
template <bool INV> __device__ __forceinline__ void r4(c2& x0, c2& x1, c2& x2, c2& x3) {
    const c2 t0 = x0 + x2, t1 = x0 - x2, t2 = x1 + x3, t3 = x1 - x3;
    const c2 r = INV ? (c2){-t3.y, t3.x} : (c2){t3.y, -t3.x};
    x0 = t0 + t2; x1 = t1 + r; x2 = t0 - t2; x3 = t1 - r;
}
template <bool INV> __device__ __forceinline__ c2 mulw(c2 x, int k) {
    const float C1 = 0.9238795325112867f, S1 = 0.3826834323650898f, R = 0.7071067811865476f;
    const float sg = INV ? -1.f : 1.f; c2 w;
    switch (k) { case 0: return x; case 1: w = (c2){C1, -S1 * sg}; break; case 2: w = (c2){R, -R * sg}; break; case 3: w = (c2){S1, -C1 * sg}; break;
                 case 4: return INV ? (c2){-x.y, x.x} : (c2){x.y, -x.x}; case 6: w = (c2){-R, -R * sg}; break; default: w = (c2){-C1, S1 * sg}; break;   }
    return x.xx * w + x.yy * (c2){-w.y, w.x};
}
template <bool INV> __device__ __forceinline__ void dft16(c2 (&e)[16]) {
#pragma unroll
    for (int a0 = 0; a0 < 4; ++a0) { r4<INV>(e[a0], e[a0 + 4], e[a0 + 8], e[a0 + 12]);
#pragma unroll
        for (int b0 = 1; b0 < 4; ++b0) e[a0 + 4 * b0] = mulw<INV>(e[a0 + 4 * b0], a0 * b0); }
#pragma unroll
    for (int b0 = 0; b0 < 4; ++b0) r4<INV>(e[4 * b0], e[4 * b0 + 1], e[4 * b0 + 2], e[4 * b0 + 3]);
#pragma unroll
    for (int b0 = 0; b0 < 4; ++b0)
#pragma unroll
        for (int b1 = b0 + 1; b1 < 4; ++b1) { const c2 t = e[b1 + 4 * b0]; e[b1 + 4 * b0] = e[b0 + 4 * b1]; e[b0 + 4 * b1] = t; }
}
template <int R, bool INV, bool TW> __device__ __forceinline__ void bfly(c2 (&e)[R], c2 th) {
    T2 t1, t2, t3, T1, T2_, T3;
    if (TW) { t1 = mk(th); t2 = mk(mulT(th, t1)); t3 = mk(mulT(t2.w, t1));
        if (R == 16) { T1 = mk(mulT(t2.w, t2)); T2_ = mk(mulT(T1.w, T1)); T3 = mk(mulT(T2_.w, T1)); } }
#define HY_APPLY_TW() do { if (R == 16) { _Pragma("unroll") for (int b1 = 0; b1 < 4; ++b1) { e[4 * b1 + 1] = mulT(e[4 * b1 + 1], t1); e[4 * b1 + 2] = mulT(e[4 * b1 + 2], t2); e[4 * b1 + 3] = mulT(e[4 * b1 + 3], t3); } \
        _Pragma("unroll") for (int b0 = 0; b0 < 4; ++b0) { e[4 + b0] = mulT(e[4 + b0], T1); e[8 + b0] = mulT(e[8 + b0], T2_); e[12 + b0] = mulT(e[12 + b0], T3); } } \
      else { e[1] = mulT(e[1], t1); e[2] = mulT(e[2], t2); e[3] = mulT(e[3], t3); } } while (0)
    if (INV && TW) HY_APPLY_TW();
    if constexpr (R == 16) dft16<INV>(e); else r4<INV>(e[0], e[1], e[2], e[3]);
    if (!INV && TW) HY_APPLY_TW();
#undef HY_APPLY_TW
}
struct NoF { static constexpr bool ON = false; };
template <int R, bool INV, int S, int LS, int NSL, class LD, class ST> __device__ __forceinline__ void fft_pass(LAS c2* X, int seqstride, int nseq, int tid, const LD& ld, const ST& st) {
    const int total = nseq << NSL;
    for (int g = tid; g < total; g += 512) {
        const int q = g >> NSL, sg = g & ((1 << NSL) - 1);
        const int j0 = sg & (S - 1), blk = sg >> LS, base = blk * R * S + j0;
        LAS c2* p = X + q * seqstride + base + (base >> 4);
        constexpr int sp = (S >= 16) ? S + (S >> 4) : S;
        c2 e[R];
#pragma unroll
        for (int a = 0; a < R; ++a) { if constexpr (LD::ON) { e[a] = ld(q, base + a * S); if ((a & 3) == 3) asm volatile("" ::: "memory"); } else e[a] = p[a * sp]; }
        c2 th0 = twid((float)j0 * (1.0f / (float)(R * S))); if (INV) th0.y = -th0.y;
        bfly<R, INV, (S > 1)>(e, th0);
#pragma unroll
        for (int a = 0; a < R; ++a) { if constexpr (ST::ON) { st(q, base + a * S, e[a]); if ((a & 1) == 1) asm volatile("" ::: "memory"); } else p[a * sp] = e[a]; }
    }
    __syncthreads();
}
template <int LOGN> __device__ __forceinline__ void fft_mid(LAS c2* X, int nseq, const c2* KS, int tid) {
    constexpr int N = 1 << LOGN, SS = N + N / 16, NSL = LOGN - 4;
    const int total = nseq << NSL;
    for (int g = tid; g < total; g += 512) {
        const int q = g >> NSL, sg = g & ((1 << NSL) - 1);
        LAS c2* p = X + q * SS + sg * 17;
        c2 e[16];
#pragma unroll
        for (int a = 0; a < 16; ++a) e[a] = p[a];
        dft16<false>(e);
        const c2* kp = KS + sg;
#pragma unroll
        for (int a0 = 0; a0 < 16; a0 += 4) { c2 k[4];
#pragma unroll
            for (int a = 0; a < 4; ++a) k[a] = kp[(a0 + a) * (N / 16)];
#pragma unroll
            for (int a = 0; a < 4; ++a) e[a0 + a] = mulT(e[a0 + a], mk(k[a]));
            asm volatile("" ::: "memory"); }
        dft16<true>(e);
#pragma unroll
        for (int a = 0; a < 16; ++a) p[a] = e[a];
    }
    __syncthreads();
}
template <int LOGN, class LD> __device__ __forceinline__ void fft_fwd_head(LAS c2* X, int nseq, int tid, const LD& ld) {
    constexpr int N = 1 << LOGN, SS = N + N / 16; const NoF nf;
    if constexpr (LOGN == 14) { fft_pass<4, false, 4096, 12, LOGN - 2>(X, SS, nseq, tid, ld, nf); fft_pass<16, false, 256, 8, LOGN - 4>(X, SS, nseq, tid, nf, nf); }
    else fft_pass<16, false, 256, 8, LOGN - 4>(X, SS, nseq, tid, ld, nf);
    fft_pass<16, false, 16, 4, LOGN - 4>(X, SS, nseq, tid, nf, nf);
}
template <int LOGN, class ST> __device__ __forceinline__ void fft_inv_tail(LAS c2* X, int nseq, int tid, const ST& st) {
    constexpr int N = 1 << LOGN, SS = N + N / 16; const NoF nf;
    fft_pass<16, true, 16, 4, LOGN - 4>(X, SS, nseq, tid, nf, nf);
    if constexpr (LOGN == 14) { fft_pass<16, true, 256, 8, LOGN - 4>(X, SS, nseq, tid, nf, nf); fft_pass<4, true, 4096, 12, LOGN - 2>(X, SS, nseq, tid, nf, st); }
    else fft_pass<16, true, 256, 8, LOGN - 4>(X, SS, nseq, tid, nf, st);
}
template <int L> __device__ __forceinline__ float dw3(const bf16_t* u, int m, float w0, float w1, float w2, float b) {
    float x = bf2f(u[m]) * w1 + b; if (m > 0) x += bf2f(u[m - 1]) * w0; if (m < L - 1) x += bf2f(u[m + 1]) * w2; return x;
}
template <int L> struct HyCtx {
    const bf16_t *hf, *hb, *uv, *ug; bf16_t* zt; c2 *KS, *YC; float v0, v1, v2, vb, g0, g1, g2, gb, skip; int n;
    __device__ __forceinline__ c2 loadz(int q, int m) const { const int oA = 2 * q * L, oB = oA + L; c2 z;
        if (n == 0) { z.x = dw3<L>(uv + oA, m, v0, v1, v2, vb); z.y = dw3<L>(uv + oB, m, v0, v1, v2, vb); } else { z.x = bf2f(zt[oA + m]); z.y = bf2f(zt[oB + m]); }
        return z; }
};
template <int L, bool NEG> struct LdK { static constexpr bool ON = true; const HyCtx<L>* c;
    __device__ __forceinline__ c2 operator()(int, int m) const { const float f = bf2f(c->hf[m]); const float b = m ? bf2f(c->hb[L - m]) : 0.f;
        if (!NEG) return (c2){f + b, 0.f}; return twid((float)m * (0.5f / (float)L)) * (f - b); } };
template <int L, bool NEG> struct LdZ { static constexpr bool ON = true; const HyCtx<L>* c;
    __device__ __forceinline__ c2 operator()(int q, int m) const { c2 z = c->loadz(q, m); if (NEG) z = mulT(z, mk(twid((float)m * (0.5f / (float)L)))); return z; } };
template <int L> struct StKS { static constexpr bool ON = true; const HyCtx<L>* c;
    __device__ __forceinline__ void operator()(int, int pos, c2 v) const { c->KS[(pos & 15) * (L / 16) + (pos >> 4)] = v; } };
template <int L> struct StYC { static constexpr bool ON = true; const HyCtx<L>* c;
    __device__ __forceinline__ void operator()(int q, int m, c2 v) const { c->YC[q * L + m] = v; } };
template <int L> struct StFin { static constexpr bool ON = true; const HyCtx<L>* c;
    __device__ __forceinline__ void operator()(int q, int m, c2 v) const { const int oA = 2 * q * L, oB = oA + L;
        const c2 z = c->loadz(q, m); c2 tw = twid((float)m * (0.5f / (float)L)); tw.y = -tw.y;
        const c2 y = (c->YC[q * L + m] + mulT(v, mk(tw))) * (0.5f / (float)L) + z * c->skip;
        const float gA = dw3<L>(c->ug + oA, m, c->g0, c->g1, c->g2, c->gb), gB = dw3<L>(c->ug + oB, m, c->g0, c->g1, c->g2, c->gb);
        c->zt[oA + m] = f2bf(y.x * gA); c->zt[oB + m] = f2bf(y.y * gB); } };
__device__ __forceinline__ unsigned ldw(const void* base, unsigned boff) { return *(const unsigned*)((const char*)base + boff); }
struct W3 { unsigned p, c, n; };
template <int L> __device__ __forceinline__ W3 dw3ld(const bf16_t* u, unsigned j) {
    const unsigned o = j * 4u; W3 w; w.c = ldw(u, o); w.p = ldw(u, j > 0u ? o - 4u : o); w.n = ldw(u, j < (unsigned)(L / 2 - 1) ? o + 4u : o); return w; }
template <int L> __device__ __forceinline__ c2 dw3c(W3 w, unsigned j, float w0, float w1, float w2, float b) {
    const unsigned prv = j > 0u ? w.p : 0u, nxt = j < (unsigned)(L / 2 - 1) ? w.n : 0u;
    const float xm = bfhi(prv), x0 = bflo(w.c), x1 = bfhi(w.c), x2 = bflo(nxt);
    return (c2){xm * w0 + x0 * w1 + x1 * w2 + b, x0 * w0 + x1 * w1 + x2 * w2 + b};
}
template <int L, bool NEG> __device__ __forceinline__ void ew_loadk(LAS c2* X, const HyCtx<L>& c, int tid) {
    constexpr int NI = L / 1024, U = (L == 4096) ? 2 : 8;
#pragma unroll 1
    for (int i0 = 0; i0 < NI; i0 += U) {
        unsigned wf[U], wA[U], wB[U];
#pragma unroll
        for (int u = 0; u < U; ++u) { const unsigned j = (unsigned)tid + 512u * (i0 + u);
            wf[u] = ldw(c.hf, j * 4u); wA[u] = ldw(c.hb, (unsigned)(2 * L - 4) - j * 4u); wB[u] = ldw(c.hb, j ? (unsigned)(2 * L) - j * 4u : 0u); }
#pragma unroll
        for (int u = 0; u < U; ++u) { const unsigned j = (unsigned)tid + 512u * (i0 + u);
            const float f0 = bflo(wf[u]), f1 = bfhi(wf[u]), b0 = j ? bflo(wB[u]) : 0.f, b1 = bfhi(wA[u]); LAS c2* p = X + 2 * j + (j >> 3);
            if (!NEG) { p[0] = (c2){f0 + b0, 0.f}; p[1] = (c2){f1 + b1, 0.f}; }
            else { p[0] = twid((float)(2 * j) * (0.5f / (float)L)) * (f0 - b0); p[1] = twid((float)(2 * j + 1) * (0.5f / (float)L)) * (f1 - b1); } }
    }
    __syncthreads();
}
template <int L, bool NEG, bool N0> __device__ __forceinline__ void ew_loadz(LAS c2* X, const HyCtx<L>& c, int nseq, int tid) {
    constexpr int SS = L + L / 16, NI = L / 1024, U = (L == 4096) ? 2 : 8;
#pragma unroll 1
    for (int q = 0; q < nseq; ++q) { const int oA = 2 * q * L, oB = oA + L;
#pragma unroll 1
        for (int i0 = 0; i0 < NI; i0 += U) {
            W3 a[U], b[U];
#pragma unroll
            for (int u = 0; u < U; ++u) { const unsigned j = (unsigned)tid + 512u * (i0 + u);
                if (N0) { a[u] = dw3ld<L>(c.uv + oA, j); b[u] = dw3ld<L>(c.uv + oB, j); } else { a[u].c = ldw(c.zt + oA, j * 4u); b[u].c = ldw(c.zt + oB, j * 4u); } }
#pragma unroll
            for (int u = 0; u < U; ++u) { const unsigned j = (unsigned)tid + 512u * (i0 + u); c2 zA, zB;
                if (N0) { zA = dw3c<L>(a[u], j, c.v0, c.v1, c.v2, c.vb); zB = dw3c<L>(b[u], j, c.v0, c.v1, c.v2, c.vb); } else { zA = (c2){bflo(a[u].c), bfhi(a[u].c)}; zB = (c2){bflo(b[u].c), bfhi(b[u].c)}; }
                LAS c2* p = X + q * SS + 2 * j + (j >> 3); c2 e0 = (c2){zA.x, zB.x}, e1 = (c2){zA.y, zB.y};
                if (NEG) { e0 = mulT(e0, mk(twid((float)(2 * j) * (0.5f / (float)L)))); e1 = mulT(e1, mk(twid((float)(2 * j + 1) * (0.5f / (float)L)))); }
                p[0] = e0; p[1] = e1; }
        } }
    __syncthreads();
}
template <int L> __device__ __forceinline__ void ew_storeyc(LAS c2* X, const HyCtx<L>& c, int nseq, int tid) {
    constexpr int SS = L + L / 16; typedef float f4 __attribute__((ext_vector_type(4)));
#pragma unroll 1
    for (int q = 0; q < nseq; ++q)
#pragma unroll (L == 4096 ? 2 : 8)
        for (int i = 0; i < L / 1024; ++i) { const unsigned j = (unsigned)tid + 512u * i; LAS c2* p = X + q * SS + 2 * j + (j >> 3); const c2 a = p[0], b = p[1];
            *(f4*)((char*)(c.YC + q * L) + j * 16u) = (f4){a.x, a.y, b.x, b.y}; }
    __syncthreads();
}
template <int L, bool N0> __device__ __forceinline__ void ew_final(LAS c2* X, const HyCtx<L>& c, int nseq, int tid) {
    constexpr int SS = L + L / 16, NI = L / 1024, U = (L == 4096) ? 2 : 4; typedef float f4 __attribute__((ext_vector_type(4)));
#pragma unroll 1
    for (int q = 0; q < nseq; ++q) { const int oA = 2 * q * L, oB = oA + L;
#pragma unroll 1
        for (int i0 = 0; i0 < NI; i0 += U) {
            W3 a[U], b[U], ga[U], gb[U]; f4 yc[U];
#pragma unroll
            for (int u = 0; u < U; ++u) { const unsigned j = (unsigned)tid + 512u * (i0 + u);
                if (N0) { a[u] = dw3ld<L>(c.uv + oA, j); b[u] = dw3ld<L>(c.uv + oB, j); } else { a[u].c = ldw(c.zt + oA, j * 4u); b[u].c = ldw(c.zt + oB, j * 4u); }
                ga[u] = dw3ld<L>(c.ug + oA, j); gb[u] = dw3ld<L>(c.ug + oB, j); yc[u] = *(const f4*)((const char*)(c.YC + q * L) + j * 16u); }
#pragma unroll
            for (int u = 0; u < U; ++u) { const unsigned j = (unsigned)tid + 512u * (i0 + u); c2 zA, zB;
                if (N0) { zA = dw3c<L>(a[u], j, c.v0, c.v1, c.v2, c.vb); zB = dw3c<L>(b[u], j, c.v0, c.v1, c.v2, c.vb); } else { zA = (c2){bflo(a[u].c), bfhi(a[u].c)}; zB = (c2){bflo(b[u].c), bfhi(b[u].c)}; }
                LAS c2* p = X + q * SS + 2 * j + (j >> 3); const c2 yn0 = p[0], yn1 = p[1];
                c2 t0 = twid((float)(2 * j) * (0.5f / (float)L)), t1 = twid((float)(2 * j + 1) * (0.5f / (float)L)); t0.y = -t0.y; t1.y = -t1.y;
                const c2 y0 = ((c2){yc[u][0], yc[u][1]} + mulT(yn0, mk(t0))) * (0.5f / (float)L) + (c2){zA.x, zB.x} * c.skip;
                const c2 y1 = ((c2){yc[u][2], yc[u][3]} + mulT(yn1, mk(t1))) * (0.5f / (float)L) + (c2){zA.y, zB.y} * c.skip;
                const c2 gA = dw3c<L>(ga[u], j, c.g0, c.g1, c.g2, c.gb), gB = dw3c<L>(gb[u], j, c.g0, c.g1, c.g2, c.gb);
                *(unsigned*)((char*)(c.zt + oA) + j * 4u) = pk(y0.x * gA.x, y1.x * gA.y); *(unsigned*)((char*)(c.zt + oB) + j * 4u) = pk(y0.y * gB.x, y1.y * gB.y); }
        } }
    __syncthreads();
}
template <int LOGN> __device__ __forceinline__ void hyena_item(LAS c2* X, const bf16_t* UT, int Tg, const bf16_t* FT, bf16_t* ZT, int c,
                                                               const float* short_w, const float* short_b, const float* hy_skip, c2* KS, c2* YC, int tid) {
    constexpr int L = 1 << LOGN, NSEQ = (LOGN == 12) ? 2 : 1, SS = L + L / 16; constexpr bool FUSE = false;
    HyCtx<L> cx; cx.uv = UT + (size_t)(2048 + c) * Tg; cx.zt = ZT + (size_t)c * Tg; cx.KS = KS; cx.YC = YC;
    cx.v0 = short_w[2048 + c]; cx.v1 = short_w[3072 + 2048 + c]; cx.v2 = short_w[6144 + 2048 + c]; cx.vb = short_b[2048 + c];
    const NoF nf;
    for (int n = 0; n < 2; ++n) {
        cx.n = n; cx.hf = FT + (size_t)(n * 1024 + c) * L; cx.hb = FT + (size_t)((2 + n) * 1024 + c) * L; cx.skip = hy_skip[n * 1024 + c];
        const int gr = n ? 1024 + c : c; cx.ug = UT + (size_t)gr * Tg;
        cx.g0 = short_w[gr]; cx.g1 = short_w[3072 + gr]; cx.g2 = short_w[6144 + gr]; cx.gb = short_b[gr];
        if constexpr (FUSE) fft_fwd_head<LOGN>(X, 1, tid, LdK<L, false>{&cx}); else { ew_loadk<L, false>(X, cx, tid); fft_fwd_head<LOGN>(X, 1, tid, nf); }
        fft_pass<16, false, 1, 0, LOGN - 4>(X, SS, 1, tid, nf, StKS<L>{&cx});
        if constexpr (FUSE) fft_fwd_head<LOGN>(X, NSEQ, tid, LdZ<L, false>{&cx}); else { if (n == 0) ew_loadz<L, false, true>(X, cx, NSEQ, tid); else ew_loadz<L, false, false>(X, cx, NSEQ, tid); fft_fwd_head<LOGN>(X, NSEQ, tid, nf); }
        fft_mid<LOGN>(X, NSEQ, KS, tid);
        if constexpr (FUSE) fft_inv_tail<LOGN>(X, NSEQ, tid, StYC<L>{&cx}); else { fft_inv_tail<LOGN>(X, NSEQ, tid, nf); ew_storeyc<L>(X, cx, NSEQ, tid); }
        if constexpr (FUSE) fft_fwd_head<LOGN>(X, 1, tid, LdK<L, true>{&cx}); else { ew_loadk<L, true>(X, cx, tid); fft_fwd_head<LOGN>(X, 1, tid, nf); }
        fft_pass<16, false, 1, 0, LOGN - 4>(X, SS, 1, tid, nf, StKS<L>{&cx});
        if constexpr (FUSE) fft_fwd_head<LOGN>(X, NSEQ, tid, LdZ<L, true>{&cx}); else { if (n == 0) ew_loadz<L, true, true>(X, cx, NSEQ, tid); else ew_loadz<L, true, false>(X, cx, NSEQ, tid); fft_fwd_head<LOGN>(X, NSEQ, tid, nf); }
        fft_mid<LOGN>(X, NSEQ, KS, tid);
        if constexpr (FUSE) fft_inv_tail<LOGN>(X, NSEQ, tid, StFin<L>{&cx}); else { fft_inv_tail<LOGN>(X, NSEQ, tid, nf); if (n == 0) ew_final<L, true>(X, cx, NSEQ, tid); else ew_final<L, false>(X, cx, NSEQ, tid); }
    }
}
}

__device__ __forceinline__ int colmap(int mode, int n) {
    if (mode == 0) return n;
    if (mode == 1) {
        if (n >= 2816) return 704 + (n - 2816);
        if (n < 640) return n;
        if (n < 704) { const int j = n - 640; return 640 + (j >> 1) + 32 * (j & 1); }
        if (n < 2752) return 3776 + (n - 704);
        return -1;
    }
    if (n < 1024) return (n >> 7) * 192 + (n & 127);
    { const int h = (n - 1024) >> 6, j = (n - 1024) & 63; return h * 192 + 128 + (j >> 1) + 32 * (j & 1); }
}
__device__ __forceinline__ void wtrans(float* tile  , const float* src, int ld, int K, int dstN, bf16_t* dst, int mode, const float* scale, int tid) {
    const int tk = K / 64, ntiles = (dstN / 64) * tk;
    for (int t = blockIdx.x; t < ntiles; t += gridDim.x) {
        const int n0 = (t / tk) * 64, k0 = (t % tk) * 64;
        { const int nn = tid & 63, col = colmap(mode, n0 + nn);
#pragma unroll
          for (int i = 0; i < 8; ++i) { const int kk = (tid >> 6) + 8 * i; float v = 0.f; if (col >= 0) { v = src[(size_t)(k0 + kk) * ld + col]; if (scale) v *= scale[k0 + kk]; } tile[kk * 65 + nn] = v; } }
        __syncthreads();
        { const int kk = tid & 63;
#pragma unroll
          for (int i = 0; i < 8; ++i) { const int nn = (tid >> 6) + 8 * i; dst[(size_t)(n0 + nn) * K + k0 + kk] = f2bf(tile[kk * 65 + nn]); } }
        __syncthreads();
    }
}
__device__ __forceinline__ void cvt_rows(const float* src, bf16_t* dst, size_t n8, int gtid, int gthreads) {
    for (size_t i = gtid; i < n8; i += gthreads) { const f32x4 a = *(const f32x4*)(src + i * 8), b = *(const f32x4*)(src + i * 8 + 4); st8(dst + i * 8, a, b); }
}
__device__ __forceinline__ float wsum(float v) { v += __shfl_xor(v, 1); v += __shfl_xor(v, 2); v += __shfl_xor(v, 4); v += __shfl_xor(v, 8); v += __shfl_xor(v, 16); v += __shfl_xor(v, 32); return v; }
__device__ __forceinline__ void ln_rows(float* Y, const float* g, const float* b, bf16_t* Xb, int nrows, int tid) {
    const int wid = tid >> 6, lane = tid & 63;
    f32x4 gv[4], bv[4];
#pragma unroll
    for (int k = 0; k < 4; ++k) { gv[k] = *(const f32x4*)(g + k * 256 + lane * 4); bv[k] = *(const f32x4*)(b + k * 256 + lane * 4); }
    for (int row = (blockIdx.x * 8 + wid) * 2; row < nrows; row += gridDim.x * 16) {
        f32x4 v[2][4];
#pragma unroll
        for (int u = 0; u < 2; ++u)
#pragma unroll
            for (int k = 0; k < 4; ++k) v[u][k] = *(const f32x4*)(Y + (size_t)(row + u) * 1024 + k * 256 + lane * 4);
#pragma unroll
        for (int u = 0; u < 2; ++u) {
            float* y = Y + (size_t)(row + u) * 1024; float s = 0.f;
#pragma unroll
            for (int k = 0; k < 4; ++k) s += (v[u][k][0] + v[u][k][1]) + (v[u][k][2] + v[u][k][3]);
            const float mean = wsum(s) * (1.0f / 1024.0f); float q = 0.f;
#pragma unroll
            for (int k = 0; k < 4; ++k) { v[u][k] = v[u][k] - mean; q += (v[u][k][0] * v[u][k][0] + v[u][k][1] * v[u][k][1]) + (v[u][k][2] * v[u][k][2] + v[u][k][3] * v[u][k][3]); }
            const float rstd = rsqrtf(wsum(q) * (1.0f / 1024.0f) + LN_EPS);
#pragma unroll
            for (int k = 0; k < 4; ++k) { const f32x4 o = v[u][k] * rstd * gv[k] + bv[k]; *(f32x4*)(y + k * 256 + lane * 4) = o;
                if (Xb) { unsigned w0 = pk(o[0], o[1]), w1 = pk(o[2], o[3]); *(uint2*)(Xb + (size_t)(row + u) * 1024 + k * 256 + lane * 4) = make_uint2(w0, w1); } }
        }
    }
}
__device__ __forceinline__ void ffn_mid(const bf16_t* AB, bf16_t* HM, const float* dw_w, const float* dw_b, int seqmask, int tid) {
    typedef float f32x2 __attribute__((ext_vector_type(2)));
    if (tid >= 352) return;
    const int col = tid * 8;
    const f32x4 w0a = *(const f32x4*)(dw_w + col), w0b = *(const f32x4*)(dw_w + col + 4), w1a = *(const f32x4*)(dw_w + 2816 + col), w1b = *(const f32x4*)(dw_w + 2816 + col + 4),
                w2a = *(const f32x4*)(dw_w + 5632 + col), w2b = *(const f32x4*)(dw_w + 5632 + col + 4), ba = *(const f32x4*)(dw_b + col), bb = *(const f32x4*)(dw_b + col + 4);
    const f32x4 zero = {0.f, 0.f, 0.f, 0.f};
    for (int rb = blockIdx.x; rb < TC / 64; rb += gridDim.x) {
        const int r0 = rb * 64; const bf16_t* p = AB + (size_t)r0 * 5632 + col; bf16_t* o = HM + (size_t)r0 * 2816 + col;
        f32x4 pa = zero, pb = zero, ca, cb, na, nb;
        if ((r0 & seqmask) > 0) ld8(p - 5632, pa, pb);
        ld8(p, ca, cb);
#pragma unroll 4
        for (int r = 0; r < 64; ++r) {
            const int pos = (r0 + r) & seqmask;
            if (pos < seqmask) ld8(p + (size_t)(r + 1) * 5632, na, nb); else { na = zero; nb = zero; }
            f32x4 ga, gb; ld8(p + (size_t)r * 5632 + 2816, ga, gb);
            if (pos == 0) { pa = zero; pb = zero; }
            f32x4 ta = pa * w0a + ca * w1a + na * w2a + ba, tb = pb * w0b + cb * w1b + nb * w2b + bb;
            const f32x2 q0 = pg8::gelu_pk((f32x2){ta[0], ta[1]}), q1 = pg8::gelu_pk((f32x2){ta[2], ta[3]}), q2 = pg8::gelu_pk((f32x2){tb[0], tb[1]}), q3 = pg8::gelu_pk((f32x2){tb[2], tb[3]});
            ta = (f32x4){q0.x, q0.y, q1.x, q1.y} * ga; tb = (f32x4){q2.x, q2.y, q3.x, q3.y} * gb;
            st8(o + (size_t)r * 2816, ta, tb);
            pa = ca; pb = cb; ca = na; cb = nb;
        }
    }
}
__device__ __forceinline__ void transpose_z(LAS bf16_t* tile  , const bf16_t* ZT, bf16_t* Z, int Tg, int tid) {
    const int tt = Tg / 64, ngroups = 16 * tt / 4;
    for (int gI = blockIdx.x; gI < ngroups; gI += gridDim.x) {
        const int c0 = (gI / (tt / 4)) * 64, tb = (gI % (tt / 4)) * 256;
        const int cc = tid >> 3, t8 = (tid & 7) * 8;
        u32x4 w[4];
#pragma unroll
        for (int k = 0; k < 4; ++k) w[k] = *(const u32x4*)(ZT + (size_t)(c0 + cc) * Tg + tb + k * 64 + t8);
#pragma unroll
        for (int k = 0; k < 4; ++k) { LAS bf16_t* T = tile + k * 64 * 72;
          T[(t8 + 0) * 72 + cc] = (bf16_t)(w[k].x & 0xffff); T[(t8 + 1) * 72 + cc] = (bf16_t)(w[k].x >> 16); T[(t8 + 2) * 72 + cc] = (bf16_t)(w[k].y & 0xffff); T[(t8 + 3) * 72 + cc] = (bf16_t)(w[k].y >> 16);
          T[(t8 + 4) * 72 + cc] = (bf16_t)(w[k].z & 0xffff); T[(t8 + 5) * 72 + cc] = (bf16_t)(w[k].z >> 16); T[(t8 + 6) * 72 + cc] = (bf16_t)(w[k].w & 0xffff); T[(t8 + 7) * 72 + cc] = (bf16_t)(w[k].w >> 16); }
        __syncthreads();
        { const int r = tid >> 3, c8 = (tid & 7) * 8;
#pragma unroll
          for (int k = 0; k < 4; ++k) { const u32x4 o = *(const LAS u32x4*)(tile + k * 64 * 72 + r * 72 + c8); *(u32x4*)(Z + (size_t)(tb + k * 64 + r) * 1024 + c0 + c8) = o; } }
        __syncthreads();
    }
}

struct Params { const float* in[27]; float* out; unsigned char* ws; int lo, hi; };

__device__ __forceinline__ void prologue(const Params& P, unsigned char* smem, int tid) {
    unsigned char* ws = P.ws; float* tile = (float*)smem;
    const int gtid = blockIdx.x * 512 + tid, gthreads = gridDim.x * 512;
    wtrans(tile, P.in[2], 5824, 1024, 5888, (bf16_t*)(ws + WS_WIN), 1, nullptr, tid);
    wtrans(tile, P.in[6], 1536, 384, 1536, (bf16_t*)(ws + WS_WUQ), 2, P.in[5], tid);
    wtrans(tile, P.in[8], 2048, 256, 2048, (bf16_t*)(ws + WS_WUKV), 0, P.in[7], tid);
    wtrans(tile, P.in[9], 1024, 1024, 1024, (bf16_t*)(ws + WS_WOMLA), 0, nullptr, tid);
    wtrans(tile, P.in[17], 1024, 1024, 1024, (bf16_t*)(ws + WS_WOHY), 0, nullptr, tid);
    wtrans(tile, P.in[18], 1024, 1024, 1024, (bf16_t*)(ws + WS_WOUT), 0, nullptr, tid);
    wtrans(tile, P.in[21], 5632, 1024, 5632, (bf16_t*)(ws + WS_WUP), 0, nullptr, tid);
    wtrans(tile, P.in[24], 1024, 2816, 1024, (bf16_t*)(ws + WS_WDOWN), 0, nullptr, tid);
    { bf16_t* W3B = (bf16_t*)(ws + WS_W3B); const float* w3 = P.in[15];
      for (int i = gtid; i < 4096 * 128; i += gthreads) { const int k = i >> 12, o = i & 4095; W3B[o * 128 + k] = f2bf(w3[(k & 63) * 4096 + o]); } }
    cvt_rows(P.in[0], (bf16_t*)(P.out + (size_t)1 * TC * 1024), (size_t)TC * 1024 / 8, gtid, gthreads);
    cvt_rows(P.in[1], (bf16_t*)(P.out + (size_t)2 * TC * 1024), (size_t)2 * TC * 1024 / 8, gtid, gthreads);
    { float* cosT = (float*)(ws + WS_COS); float* sinT = (float*)(ws + WS_SIN);
      for (int i = gtid; i < 16384 * 32; i += gthreads) { const int pos = i >> 5, k = i & 31; const float inv = powf(10000.0f, -(float)(2 * k) / 64.0f); const float ang = (float)pos * inv;
          cosT[i] = cosf(ang); sinT[i] = sinf(ang); } }
    { float* ssq = (float*)(ws + WS_SSQ); for (int i = gtid; i < 3 * TC * 2; i += gthreads) ssq[i] = 0.f; }
    { bf16_t* H2B = (bf16_t*)(ws + WS_H2B); const float *w1 = P.in[10], *b1 = P.in[11], *fq = P.in[12], *w2 = P.in[13], *b2 = P.in[14];
      const int wid = tid >> 6, lane = tid & 63; const float fr = fq[lane];
      for (int row = blockIdx.x * 8 + wid; row < 20480; row += gridDim.x * 8) {
          const int L = row < 4096 ? 4096 : 16384, m = row < 4096 ? row : row - 4096;
          const float t = (float)m / (float)(L - 1); const int kb = lane & 15;
          const float band = 1e-4f + (float)kb * ((15.0f - 1e-4f) / 15.0f); const float a0 = (6.283185307179586f * (float)m) / (float)L; const float ang = a0 * band;
          const float cv = cosf(ang), sv = -sinf(ang);
          float acc = b1[lane] + t * w1[lane];
#pragma unroll
          for (int k = 0; k < 16; ++k) { acc += __shfl(cv, k) * w1[(1 + k) * 64 + lane]; acc += __shfl(sv, k) * w1[(17 + k) * 64 + lane]; }
          const float h1 = sinf(fr * acc);
          float acc2 = b2[lane];
#pragma unroll 8
          for (int k = 0; k < 64; ++k) acc2 += __shfl(h1, k) * w2[k * 64 + lane];
          const float h2 = sinf(fr * acc2);
          const bf16_t hi = f2bf(h2); H2B[(size_t)row * 128 + lane] = hi; H2B[(size_t)row * 128 + 64 + lane] = f2bf(h2 - bf2f(hi));
      } }
}

__global__ void __launch_bounds__(512, 2) mega(Params P) {
    extern __shared__ __attribute__((aligned(16))) unsigned char smem[];
    cg::grid_group grid = cg::this_grid();
    PG8_LAS unsigned char* lds = (PG8_LAS unsigned char*)smem;
    unsigned char* ws = P.ws; const int lo = P.lo, hi = P.hi;
    const int gthreads = gridDim.x * 512;
    volatile LAS unsigned* xst = (volatile LAS unsigned*)(lds + LDS_FFT);
    if (threadIdx.x == 0) { xst[0] = 0u; xst[1] = 0u; }
    __syncthreads();
    XcdBarrier gbar = xcd_barrier_post((unsigned*)(ws + WS_BAR), xst);
    int ph = 0;
#if MK_MULTI
#define PH_BEGIN if (ph >= lo && ph < hi) { int tid = threadIdx.x; asm volatile("" : "+v"(tid)); const int gtid = blockIdx.x * 512 + tid;
#else
#define PH_BEGIN { int tid = threadIdx.x; asm volatile("" : "+v"(tid)); const int gtid = blockIdx.x * 512 + tid;
#endif
#if MK_MULTI
#define PH_END } ++ph; if (ph > lo && ph < hi) { if (ph == 1) grid.sync(); else xcd_barrier(gbar); }
#define PH_END_FIRST PH_END
#define PH_END_NOSYNC } ++ph;
#else
#define PH_END } xcd_barrier(gbar);
#define PH_END_FIRST } grid.sync();
#define PH_END_NOSYNC }
#endif
    const float* cosT = (const float*)(ws + WS_COS); const float* sinT = (const float*)(ws + WS_SIN);
    bf16_t* WIN = (bf16_t*)(ws + WS_WIN);
    PH_BEGIN
#if EN_PRO
 for (int rep = 0; rep < REP_PRO; ++rep) prologue(P, smem, tid);
#endif
 PH_END_FIRST
    for (int g = 0; g < 2; ++g) {
        const int L = g ? 16384 : 4096, Tg = g ? 2 * TC : TC, seqmask = L - 1;
        const bf16_t* xb = (const bf16_t*)(P.out + (size_t)(g ? 2 : 1) * TC * 1024);
        const bf16_t* H2 = (const bf16_t*)(ws + WS_H2B) + (g ? (size_t)4096 * 128 : 0);
        bf16_t* UT = (bf16_t*)(ws + WS_UT); bf16_t* FT = (bf16_t*)(ws + WS_FT); bf16_t* ZT = (bf16_t*)(ws + WS_ZT); bf16_t* Z = (bf16_t*)(ws + WS_Z);
        PH_BEGIN
            for (int rep = 0; rep < REP_G; ++rep) run_gemm<0>(lds, (const bf16_t*)(ws + WS_W3B), H2, 4096, L, 128, FFilt{FT, L});
            for (int rep = 0; rep < REP_G; ++rep) run_gemm<1>(lds, WIN + (size_t)2816 * 1024, xb, 3072, Tg, 1024, FBf{UT, (size_t)Tg});
        PH_END
        PH_BEGIN
            for (int rep = 0; rep < REP_HY; ++rep)
            for (int c = blockIdx.x; c < 1024; c += gridDim.x) {
                c2* KS = (c2*)(P.out + (size_t)(g ? 1 : 0) * TC * 1024) + (size_t)blockIdx.x * 32768; c2* YC = KS + 16384;
#if EN_HY14
                if (g) hy::hyena_item<14>((LAS c2*)smem, UT, Tg, FT, ZT, c, P.in[3], P.in[4], P.in[16], KS, YC, tid);
#endif
#if EN_HY12
                if (!g) hy::hyena_item<12>((LAS c2*)smem, UT, Tg, FT, ZT, c, P.in[3], P.in[4], P.in[16], KS, YC, tid);
#endif
            }
        PH_END
        for (int ck = 0; ck < (g ? 2 : 1); ++ck) {
            const int chunk = g ? 1 + ck : 0;
            const bf16_t* xbc = xb + (size_t)ck * TC * 1024;
            const float* xin = g ? P.in[1] + (size_t)ck * TC * 1024 : P.in[0];
            float* Y = P.out + (size_t)chunk * TC * 1024;
            float* ssq = (float*)(ws + WS_SSQ) + (size_t)chunk * TC * 2;
            bf16_t *CQ = (bf16_t*)(ws + WS_CQ), *CKV = (bf16_t*)(ws + WS_CKV), *KR = (bf16_t*)(ws + WS_KR), *G = (bf16_t*)(ws + WS_G), *Q = (bf16_t*)(ws + WS_Q), *KV = (bf16_t*)(ws + WS_KV),
                   *O = (bf16_t*)(ws + WS_O), *MG = (bf16_t*)(ws + WS_MG), *X1B = (bf16_t*)(ws + WS_X1B), *HM = (bf16_t*)(ws + WS_HM), *AB = (bf16_t*)(ws + WS_AB);
            PH_BEGIN
                if (ck == 0) transpose_z((LAS bf16_t*)smem, ZT, Z, Tg, tid);
                run_gemm<2>(lds, xbc, WIN, TC, 2816, 1024, FTm{CQ, CKV, KR, G, ssq, cosT, sinT, seqmask});
            PH_END
            PH_BEGIN
                for (int rep = 0; rep < REP_G; ++rep) run_gemm<3>(lds, CQ, (const bf16_t*)(ws + WS_WUQ), TC, 1536, 384, FQ{Q, ssq, cosT, sinT, seqmask});
                for (int rep = 0; rep < REP_G; ++rep) run_gemm<4>(lds, CKV, (const bf16_t*)(ws + WS_WUKV), TC, 2048, 256, FKV{KV, ssq});
            PH_END
            PH_BEGIN
                const int nqb = L / 256;
                for (int rep = 0; rep < REP_ATT; ++rep)
                for (int i = blockIdx.x; i < 512; i += gridDim.x) {
                    const int h = i & 7, combo = i >> 3, b = combo / nqb, qb = combo % nqb;
                    const size_t r0 = (size_t)b * L;
#if EN_ATT
                    att::attn_unit(Q + (r0 + (size_t)qb * 256) * 1536, KV + r0 * 2048 + h * 256, KV + r0 * 2048 + h * 256 + 128, KR + r0 * 64,
                                   O + (r0 + (size_t)qb * 256) * 1024 + h * 128, L, (char*)smem, h);
#endif
                }
            PH_END
            PH_BEGIN
                run_gemm<5>(lds, Z + (size_t)ck * TC * 1024, (const bf16_t*)(ws + WS_WOHY), TC, 1024, 1024, FM1{MG, G});
                run_gemm<6>(lds, O, (const bf16_t*)(ws + WS_WOMLA), TC, 1024, 1024, FM2{MG, G});
            PH_END
            PH_BEGIN
                for (int rep = 0; rep < REP_G; ++rep) run_gemm<7>(lds, MG, (const bf16_t*)(ws + WS_WOUT), TC, 1024, 1024, FOut{Y, xin});
            PH_END
            PH_BEGIN ln_rows(Y, P.in[19], P.in[20], X1B, TC, tid); PH_END
            PH_BEGIN
                for (int rep = 0; rep < REP_G; ++rep) run_gemm<8>(lds, X1B, (const bf16_t*)(ws + WS_WUP), TC, 5632, 1024, FBf{AB, (size_t)5632});
            PH_END
            PH_BEGIN for (int rep = 0; rep < REP_SM; ++rep) ffn_mid(AB, HM, P.in[22], P.in[23], seqmask, tid); PH_END
            PH_BEGIN
                run_gemm<9>(lds, HM, (const bf16_t*)(ws + WS_WDOWN), TC, 1024, 2816, FDown{Y});
            PH_END
            PH_BEGIN ln_rows(Y, P.in[25], P.in[26], nullptr, TC, tid); PH_END_NOSYNC
        }
    }
}
constexpr int N_PHASES = 1 + 2 * 2 + 3 * 10;

extern "C" void kernel_launch(void* const* d_in, const int* in_sizes, int n_in, void* d_out, int out_size, void* d_ws, size_t ws_size, hipStream_t stream) {
    static int grid = 0;
    if (grid == 0) {
        if (n_in != 27 || out_size != 3 * TC * 1024 || ws_size < WS_END) { fprintf(stderr, "kernel_launch: unexpected shapes: n_in %d out %d ws %zu\n", n_in, out_size, ws_size); grid = -1; return; }
        int dev = 0, cus = 0, per_cu = 0;
        hipGetDevice(&dev); hipDeviceGetAttribute(&cus, hipDeviceAttributeMultiprocessorCount, dev);
        if (hipFuncSetAttribute((const void*)mega, hipFuncAttributeMaxDynamicSharedMemorySize, LDS_BYTES) != hipSuccess) { fprintf(stderr, "kernel_launch: hipFuncSetAttribute failed\n"); grid = -1; return; }
        if (hipOccupancyMaxActiveBlocksPerMultiprocessor(&per_cu, (const void*)mega, 512, LDS_BYTES) != hipSuccess || per_cu < 1) { fprintf(stderr, "kernel_launch: occupancy query says %d\n", per_cu); per_cu = 1; }
        (void)hipGetLastError();
        grid = cus * per_cu;
    }
    if (grid < 0) return;
    if (hipMemsetAsync((char*)d_ws + WS_BAR, 0, XCD_BAR_WORDS * 4, stream) != hipSuccess) { fprintf(stderr, "kernel_launch: memset of barrier words failed\n"); return; }
    Params p{};
    for (int i = 0; i < 27; ++i) p.in[i] = (const float*)d_in[i];
    p.out = (float*)d_out; p.ws = (unsigned char*)d_ws;
#if MK_MULTI
    for (int i = 0; i < N_PHASES; ++i) { p.lo = i; p.hi = i + 1; hipLaunchKernelGGL(mega, dim3(grid), dim3(512), LDS_BYTES, stream, p); }
#else
    p.lo = 0; p.hi = N_PHASES;
    void* args[] = {&p};
    hipError_t e = hipLaunchCooperativeKernel((void*)mega, dim3(grid), dim3(512), args, LDS_BYTES, stream);
    if (e != hipSuccess) fprintf(stderr, "cooperative launch failed: %s (grid %d)\n", hipGetErrorString(e), grid);
#endif
}
```

```cpp
#include <hip/hip_runtime.h>
#include <hip/hip_cooperative_groups.h>
#include <cstdio>
#include <cstdint>
namespace cg = cooperative_groups;
namespace pg8 {
#define PG8_LAS __attribute__((address_space(3)))
typedef unsigned short bf16_t;
typedef short bf16x8 __attribute__((ext_vector_type(8)));
typedef float f32x4 __attribute__((ext_vector_type(4)));
typedef unsigned u32x4 __attribute__((ext_vector_type(4)));
constexpr int BM = 256, BK = 64, HALF = 128, HTB = HALF * BK * 2  , STAGE_BYTES = 8 * HTB, NXCD = 8, WGM = 8;

__host__ __device__ __forceinline__ int lds_byte(int r, int c) { const int st = (r >> 4) * 2 + (c >> 5), rr = r & 15, cc = c & 31, ob = rr * 64 + cc * 2; return st * 1024 + (ob ^ (((ob >> 9) & 1) << 5)); }
__host__ __device__ __forceinline__ void stage_rc(int b, int& R, int& C) { const int st = b / 1024, sb = b % 1024, swz = sb ^ (((sb >> 9) & 1) << 5); R = (st >> 1) * 16 + swz / 64; C = (st & 1) * 32 + (swz % 64) / 2; }
__host__ __device__ __forceinline__ int perm32(int rho) { const int n = rho >> 4, i = rho & 15; return 8 * (i >> 2) + 4 * n + (i & 3); }

struct Unit { int pm, pn; };
struct Gemm { const bf16_t* A; const bf16_t* Bt; int M, N, K; };

struct StaticOrder {
    int nM, nN, nwg, G, c;
    __host__ __device__ void init(int M, int N, int G_, int c_) { nM = M / BM; nN = N / BM; nwg = nM * nN; G = G_; c = c_; }
    __host__ __device__ bool next(int i, Unit& u) const {
        const long L = (long)i * G + c; if (L >= nwg) return false;
        int wgid = (int)L; { const int q = nwg / NXCD, r = nwg % NXCD, xcd = wgid % NXCD, off = wgid / NXCD; wgid = (xcd < r ? xcd * (q + 1) : r * (q + 1) + (xcd - r) * q) + off; }
        const int nig = WGM * nN, gid = wgid / nig, fm = gid * WGM, gsz = (nM - fm) < WGM ? (nM - fm) : WGM;
        u.pm = fm + ((wgid % nig) % gsz); u.pn = (wgid % nig) / gsz; return true;
    }
    __device__ __forceinline__ void a_ready(const Unit&) const {}
    __device__ __forceinline__ void done(const Unit&) const {}
};

__device__ __forceinline__ unsigned cvt_pk_bf16(float lo, float hi) { unsigned r; asm volatile("v_cvt_pk_bf16_f32 %0, %1, %2" : "=v"(r) : "v"(lo), "v"(hi)); return r; }
typedef float f32x2 __attribute__((ext_vector_type(2)));
__device__ __forceinline__ f32x2 gelu_pk(f32x2 v) {
    const f32x2 av = __builtin_elementwise_abs(v), d = av * 0.2316418882f + 1.0f;
    f32x2 t; t.x = __builtin_amdgcn_rcpf(d.x); t.y = __builtin_amdgcn_rcpf(d.y);
    f32x2 q = t * 0.5307027145f + (-0.7265760135f); q = q * t + 0.7107068705f; q = q * t + (-0.142248368f); q = q * t + 0.127414796f; q = q * t;
    const f32x2 s = (v * v) * (-0.72134752044f);
    f32x2 e; e.x = __builtin_amdgcn_exp2f(s.x); e.y = __builtin_amdgcn_exp2f(s.y);
    const f32x2 m = v * (q * e), r = v - m;
    f32x2 o; o.x = v.x < 0.f ? m.x : r.x; o.y = v.y < 0.f ? m.y : r.y; return o;
}
template <class Epi, class Sched, bool ALIGN_EPI = false, bool SP2 = false>
__device__ __forceinline__ void gemm_phase(PG8_LAS unsigned char* lds, const Gemm g, const Sched& S, const Epi& E) {
    int tid = threadIdx.x; asm volatile("" : "+v"(tid));
    const int wid = __builtin_amdgcn_readfirstlane(tid >> 6), lane = tid & 63, wr = wid >> 2, wc = wid & 3, fr = lane & 15, fq = lane >> 4;
    const int K = g.K, nt = K / BK;
    unsigned voffA[2], voffB[2];
#pragma unroll
    for (int i = 0; i < 2; ++i) { int R, C; stage_rc(tid * 16 + i * 8192, R, C); const int Rb = Epi::PERM ? ((R & ~31) + perm32(R & 31)) : R;
        voffA[i] = (unsigned)(R * K + C) * 2u; voffB[i] = (unsigned)(Rb * K + C) * 2u; }
    const size_t kstep = (size_t)(BK * 2);
    const size_t hstep = (size_t)HALF * K * 2;
    const size_t tstep = 2 * hstep;
    const unsigned ldsw = (unsigned)wid * 1024u;
    const int aoff = lds_byte(wr * 64 + fr, fq * 8), boff = lds_byte(wc * 32 + fr, fq * 8);
#define PG8_SA(b, h) (((b) * 2 + (h)) * HTB)
#define PG8_SB(b, h) ((4 + (b) * 2 + (h)) * HTB)
#define PG8_STAGE(bufoff, gbase, voff) do { _Pragma("unroll") for (int _i = 0; _i < 2; ++_i) \
        __builtin_amdgcn_global_load_lds((const unsigned*)((const char*)(gbase) + (voff)[_i]), (PG8_LAS unsigned*)(lds + (bufoff) + ldsw + _i * 8192), 16, 0, 0); } while (0)
#define PG8_LDA(dst, b, h) do { _Pragma("unroll") for (int m = 0; m < 4; ++m) _Pragma("unroll") for (int k = 0; k < 2; ++k) dst[m][k] = *(const PG8_LAS bf16x8*)(lds + PG8_SA(b, h) + aoff + m * 2048 + k * 1024); } while (0)
#define PG8_LDB(dst, b, h) do { _Pragma("unroll") for (int n = 0; n < 2; ++n) _Pragma("unroll") for (int k = 0; k < 2; ++k) dst[n][k] = *(const PG8_LAS bf16x8*)(lds + PG8_SB(b, h) + boff + n * 2048 + k * 1024); } while (0)
#define PG8_MMA(ai, bj, At, Bt) do { __builtin_amdgcn_s_setprio(1); _Pragma("unroll") for (int m = 0; m < 4; ++m) _Pragma("unroll") for (int n = 0; n < 2; ++n) _Pragma("unroll") for (int k = 0; k < 2; ++k) \
        acc[ai][bj][m][n] = __builtin_amdgcn_mfma_f32_16x16x32_bf16(Bt[n][k], At[m][k], acc[ai][bj][m][n], 0, 0, 0); __builtin_amdgcn_s_setprio(0); } while (0)
#define PG8_WAIT_V(n) asm volatile("s_waitcnt vmcnt(" #n ")" ::: "memory")
#define PG8_WAIT_L(n) asm volatile("s_waitcnt lgkmcnt(" #n ")" ::: "memory")
#define PG8_BAR __builtin_amdgcn_s_barrier()
#define PG8_SCHED __builtin_amdgcn_sched_barrier(0)
    Unit cur, nxt; int ui = 0;
    if (!S.next(0, cur)) return;
    f32x4 acc[2][2][4][2];
#pragma unroll
    for (int a = 0; a < 2; ++a)
#pragma unroll
        for (int b = 0; b < 2; ++b)
#pragma unroll
            for (int m = 0; m < 4; ++m)
#pragma unroll
                for (int n = 0; n < 2; ++n) acc[a][b][m][n] = (f32x4){0.f, 0.f, 0.f, 0.f};
    bf16x8 At[4][2], B0[2][2], B1[2][2];
    const char* cA = (const char*)g.A + (size_t)cur.pm * tstep; const char* cB = (const char*)g.Bt + (size_t)cur.pn * tstep;
    S.a_ready(cur);
    if constexpr (SP2) {
        PG8_STAGE(PG8_SB(0, 0), cB, voffB); PG8_STAGE(PG8_SB(0, 1), cB + hstep, voffB); PG8_STAGE(PG8_SA(0, 0), cA, voffA); PG8_STAGE(PG8_SA(0, 1), cA + hstep, voffA);
        if (wr == 1) PG8_BAR;
        PG8_WAIT_V(2); PG8_BAR;
        PG8_STAGE(PG8_SB(1, 0), cB + kstep, voffB); PG8_STAGE(PG8_SA(1, 0), cA + kstep, voffA); PG8_STAGE(PG8_SB(1, 1), cB + hstep + kstep, voffB);
        PG8_WAIT_V(6); PG8_BAR;
    } else {
        PG8_STAGE(PG8_SB(0, 0), cB, voffB); PG8_STAGE(PG8_SA(0, 0), cA, voffA); PG8_STAGE(PG8_SB(0, 1), cB + hstep, voffB); PG8_STAGE(PG8_SA(0, 1), cA + hstep, voffA);
        if (wr == 1) PG8_BAR;
        PG8_WAIT_V(4); PG8_BAR;
        PG8_STAGE(PG8_SB(1, 0), cB + kstep, voffB); PG8_STAGE(PG8_SA(1, 0), cA + kstep, voffA); PG8_STAGE(PG8_SB(1, 1), cB + hstep + kstep, voffB);
        PG8_WAIT_V(6); PG8_BAR;
    }
    for (;;) {
        const bool has_next = S.next(ui + 1, nxt);
        const char* nA = has_next ? (const char*)g.A + (size_t)nxt.pm * tstep : cA; const char* nB = has_next ? (const char*)g.Bt + (size_t)nxt.pn * tstep : cB;
        for (int t = 0; t < nt; t += 2) {
            const bool last = (t == nt - 2);
            const char* a1 = cA + (size_t)(t + 1) * kstep;
            const char* a2 = last ? nA : cA + (size_t)(t + 2) * kstep; const char* b2 = last ? nB : cB + (size_t)(t + 2) * kstep;
            const char* a3 = a2 + kstep; const char* b3 = b2 + kstep;
            if (last && has_next) S.a_ready(nxt);
            if constexpr (SP2) {
            PG8_LDB(B0, 0, 0); PG8_LDB(B1, 0, 1); PG8_SCHED; PG8_LDA(At, 0, 0); PG8_STAGE(PG8_SA(1, 1), a1 + hstep, voffA);
            PG8_WAIT_V(8); PG8_WAIT_L(0); PG8_BAR; PG8_MMA(0, 0, At, B0); PG8_MMA(0, 1, At, B1); PG8_BAR; PG8_SCHED;
            PG8_LDA(At, 0, 1); PG8_STAGE(PG8_SB(0, 0), b2, voffB); PG8_STAGE(PG8_SB(0, 1), b2 + hstep, voffB); PG8_STAGE(PG8_SA(0, 0), a2, voffA);
            PG8_WAIT_V(8); PG8_WAIT_L(0); PG8_BAR; PG8_MMA(1, 0, At, B0); PG8_MMA(1, 1, At, B1); PG8_BAR; PG8_SCHED;
            PG8_LDB(B0, 1, 0); PG8_LDB(B1, 1, 1); PG8_SCHED; PG8_LDA(At, 1, 0); PG8_STAGE(PG8_SA(0, 1), a2 + hstep, voffA);
            PG8_WAIT_V(8); PG8_WAIT_L(0); PG8_BAR; PG8_MMA(0, 0, At, B0); PG8_MMA(0, 1, At, B1); PG8_BAR; PG8_SCHED;
            PG8_LDA(At, 1, 1); PG8_STAGE(PG8_SB(1, 0), b3, voffB); PG8_STAGE(PG8_SB(1, 1), b3 + hstep, voffB); PG8_STAGE(PG8_SA(1, 0), a3, voffA);
            PG8_WAIT_V(8); PG8_WAIT_L(0); PG8_BAR; PG8_MMA(1, 0, At, B0); PG8_MMA(1, 1, At, B1); PG8_BAR; PG8_SCHED;
            } else {
            PG8_LDB(B0, 0, 0); PG8_SCHED; PG8_LDA(At, 0, 0); PG8_STAGE(PG8_SA(1, 1), a1 + hstep, voffA);
            PG8_WAIT_L(8); PG8_BAR; PG8_WAIT_L(0); PG8_MMA(0, 0, At, B0); PG8_BAR; PG8_SCHED;
            PG8_LDB(B1, 0, 1); PG8_STAGE(PG8_SB(0, 0), b2, voffB);
            PG8_BAR; PG8_WAIT_L(0); PG8_MMA(0, 1, At, B1); PG8_BAR;
            PG8_LDA(At, 0, 1); PG8_STAGE(PG8_SA(0, 0), a2, voffA);
            PG8_BAR; PG8_WAIT_L(0); PG8_MMA(1, 0, At, B0); PG8_BAR; PG8_SCHED;
            PG8_STAGE(PG8_SB(0, 1), b2 + hstep, voffB);
            PG8_WAIT_V(6); PG8_BAR; PG8_MMA(1, 1, At, B1); PG8_BAR;
            PG8_LDB(B0, 1, 0); PG8_SCHED; PG8_LDA(At, 1, 0); PG8_STAGE(PG8_SA(0, 1), a2 + hstep, voffA);
            PG8_WAIT_L(8); PG8_BAR; PG8_WAIT_L(0); PG8_MMA(0, 0, At, B0); PG8_BAR; PG8_SCHED;
            PG8_LDB(B1, 1, 1); PG8_STAGE(PG8_SB(1, 0), b3, voffB);
            PG8_BAR; PG8_WAIT_L(0); PG8_MMA(0, 1, At, B1); PG8_BAR;
            PG8_LDA(At, 1, 1); PG8_STAGE(PG8_SA(1, 0), a3, voffA);
            PG8_BAR; PG8_WAIT_L(0); PG8_MMA(1, 0, At, B0); PG8_BAR; PG8_SCHED;
            PG8_STAGE(PG8_SB(1, 1), b3 + hstep, voffB);
            PG8_WAIT_V(6); PG8_BAR; PG8_MMA(1, 1, At, B1); PG8_BAR;
            }
        }
        if constexpr (ALIGN_EPI) { if (wr == 0) PG8_BAR; }
        if constexpr (!Epi::AFTER_DRAIN) { E(acc, cur, wr, wc, fr, fq); S.done(cur); }
        if (!has_next) break;
#pragma unroll
        for (int a = 0; a < 2; ++a)
#pragma unroll
            for (int b = 0; b < 2; ++b)
#pragma unroll
                for (int m = 0; m < 4; ++m)
#pragma unroll
                    for (int n = 0; n < 2; ++n) acc[a][b][m][n] = (f32x4){0.f, 0.f, 0.f, 0.f};
        cur = nxt; cA = nA; cB = nB; ++ui;
        if constexpr (ALIGN_EPI) { if (wr == 1) PG8_BAR; }
    }
    PG8_WAIT_V(0);
    if constexpr (!ALIGN_EPI) { if (wr == 0) PG8_BAR; }
    PG8_BAR;
    if constexpr (Epi::AFTER_DRAIN) { E.fused(acc, cur, wr, wc, fr, fq, lds, wid, lane); S.done(cur); }
#undef PG8_SA
#undef PG8_SB
#undef PG8_STAGE
#undef PG8_LDA
#undef PG8_LDB
#undef PG8_MMA
#undef PG8_WAIT_V
#undef PG8_WAIT_L
#undef PG8_BAR
#undef PG8_SCHED
}
}

#ifndef EN_PRO
#define EN_PRO 1
#endif
#ifndef EN_HY14
#define EN_HY14 1
#endif
#ifndef EN_HY12
#define EN_HY12 1
#endif
#ifndef EN_ATT
#define EN_ATT 1
#endif
#ifndef EN_GEMM
#define EN_GEMM 0xffff
#endif
#ifndef EPI_FENCE
#define EPI_FENCE 1
#endif
#ifndef G_ALIGN
#define G_ALIGN true
#endif
#ifndef G_SP2
#define G_SP2 true
#endif
#ifndef REP_ATT
#define REP_ATT 1
#endif
#ifndef REP_HY
#define REP_HY 1
#endif
#ifndef REP_G
#define REP_G 1
#endif
#ifndef REP_SM
#define REP_SM 1
#endif
#ifndef REP_PRO
#define REP_PRO 1
#endif
#ifndef UNR_K
#define UNR_K 8
#endif
#ifndef UNR_Z
#define UNR_Z 8
#endif
#ifndef UNR_Y
#define UNR_Y 8
#endif
#ifndef UNR_F
#define UNR_F 4
#endif
#ifndef MK_MULTI
#define MK_MULTI 0
#endif
#define LAS __attribute__((address_space(3)))
#define XB_TMO      128
#define XB_XCNT(j)  (256  + 64 * (j))
#define XB_XSUB(j)  (1280 + 64 * (j))
#define XB_XGEN(j)  (2304 + 64 * (j))
#define XB_TOP      3328
#define XB_TOPGEN   3392
#define XCD_BAR_WORDS 3456
#define XB_SPIN_CAP (1u << 18)
__device__ __forceinline__ unsigned xb_ld(unsigned* p)              { return __hip_atomic_load(p, __ATOMIC_RELAXED, __HIP_MEMORY_SCOPE_AGENT); }
__device__ __forceinline__ unsigned xb_add(unsigned* p, unsigned v) { return __hip_atomic_fetch_add(p, v, __ATOMIC_RELAXED, __HIP_MEMORY_SCOPE_AGENT); }
__device__ __forceinline__ unsigned xb_xcc_id() { return (unsigned)__builtin_amdgcn_s_getreg((3 << 11) | 20) & 0xFu; }
#define XB_SPIN(cond, bar) do { unsigned _sp = 0; while (cond) { __builtin_amdgcn_s_sleep(1); \
    if ((++_sp & 255u) == 0u) { if (xb_ld(&(bar)[XB_TMO])) break; if (_sp > XB_SPIN_CAP) { atomicAdd(&(bar)[XB_TMO], 1u); break; } } } } while (0)

struct XcdBarrier {
    unsigned* bar; unsigned x;
    volatile LAS unsigned* st;
};

__device__ __forceinline__ XcdBarrier xcd_barrier_post(unsigned* bar, volatile LAS unsigned* st) {
    XcdBarrier b; b.bar = bar; b.x = xb_xcc_id(); b.st = st;
    if (threadIdx.x == 0) (void)xb_add(&bar[XB_XCNT(b.x)], 1u);
    return b;
}
__device__ __forceinline__ void xcd_barrier_complete(unsigned* bar, unsigned x, unsigned& nloc, unsigned& nx) {
    const unsigned G = gridDim.x * gridDim.y * gridDim.z;
    unsigned sum, cnt, mine, sp = 0u;
    for (;;) {
        sum = 0u; cnt = 0u; mine = 0u;
#pragma unroll
        for (unsigned j = 0; j < 16; ++j) { const unsigned c = xb_ld(&bar[XB_XCNT(j)]); sum += c; cnt += (c > 0u) ? 1u : 0u; mine = (j == x) ? c : mine; }
        if (sum == G) break;
        __builtin_amdgcn_s_sleep(1);
        if ((++sp & 255u) == 0u) { if (xb_ld(&bar[XB_TMO])) break; if (sp > XB_SPIN_CAP) { atomicAdd(&bar[XB_TMO], 1u); break; } }
    }
    nloc = mine > 0u ? mine : 1u; nx = cnt > 0u ? cnt : 1u;
}

__device__ __forceinline__ void xcd_barrier(const XcdBarrier& b) {
    asm volatile("s_waitcnt vmcnt(0)" ::: "memory");
    __syncthreads();
    if (threadIdx.x == 0) {
        unsigned* bar = b.bar;
        __builtin_amdgcn_s_waitcnt(0);
        unsigned nloc = b.st[0], nx = b.st[1];
        if (nloc == 0u) { xcd_barrier_complete(bar, b.x, nloc, nx); b.st[0] = nloc; b.st[1] = nx; }
        const unsigned old = xb_add(&bar[XB_XSUB(b.x)], 1u);
        const unsigned gen = old / nloc;
        if (old + 1u == (gen + 1u) * nloc) {
            __builtin_amdgcn_fence(__ATOMIC_RELEASE, "agent");
            asm volatile("s_waitcnt vmcnt(0)" ::: "memory");
            const unsigned og = xb_add(&bar[XB_TOP], 1u);
            const unsigned tg = og / nx;
            if (og + 1u == (tg + 1u) * nx) xb_add(&bar[XB_TOPGEN], 1u);
            else XB_SPIN(xb_ld(&bar[XB_TOPGEN]) == tg, bar);
            __builtin_amdgcn_fence(__ATOMIC_ACQUIRE, "agent");
            xb_add(&bar[XB_XGEN(b.x)], 1u);
            asm volatile("s_waitcnt vmcnt(0)" ::: "memory");
        } else {
            XB_SPIN(xb_ld(&bar[XB_XGEN(b.x)]) == gen, bar);
            __builtin_amdgcn_fence(__ATOMIC_ACQUIRE, "agent");
            asm volatile("s_waitcnt vmcnt(0)" ::: "memory");
        }
    }
    __syncthreads();
}

using pg8::bf16_t; using pg8::f32x4; using pg8::u32x4; using pg8::Unit;
typedef float c2 __attribute__((ext_vector_type(2)));

constexpr int TC = 16384;
constexpr int LDS_FFT = 139264;
constexpr int LDS_BYTES = LDS_FFT + 16;
constexpr float DN_ALPHA = 1.189207115002721f, LN_EPS = 1e-5f, RMS_EPS = 1e-6f;
constexpr size_t MiB = 1u << 20;
constexpr size_t WS_WIN = 0, WS_WUQ = 12 * MiB, WS_WUKV = 14 * MiB, WS_WOMLA = 15 * MiB, WS_WOHY = 17 * MiB, WS_WOUT = 19 * MiB, WS_WUP = 21 * MiB,
                 WS_WDOWN = 32 * MiB, WS_W3B = 38 * MiB, WS_COS = 40 * MiB, WS_SIN = 42 * MiB, WS_H2B = 44 * MiB, WS_SSQ = 50 * MiB, WS_BAR = 51 * MiB, WS_Z = 52 * MiB,
                 WS_UT = 116 * MiB, WS_FT = 308 * MiB, WS_ZT = 436 * MiB,
                 WS_CQ = 116 * MiB, WS_CKV = 128 * MiB, WS_KR = 136 * MiB, WS_G = 138 * MiB, WS_Q = 202 * MiB, WS_KV = 250 * MiB, WS_O = 314 * MiB,
                 WS_MG = 346 * MiB, WS_X1B = 378 * MiB, WS_HM = 410 * MiB, WS_AB = 116 * MiB, WS_END = 512 * MiB;

__device__ __forceinline__ float bflo(unsigned w) { return __uint_as_float(w << 16); }
__device__ __forceinline__ float bfhi(unsigned w) { return __uint_as_float(w & 0xffff0000u); }
__device__ __forceinline__ float bf2f(bf16_t v) { return __uint_as_float(((unsigned)v) << 16); }
__device__ __forceinline__ unsigned pk(float lo, float hi) { return pg8::cvt_pk_bf16(lo, hi); }
__device__ __forceinline__ bf16_t f2bf(float v) { return (bf16_t)(pk(v, 0.f) & 0xffffu); }
__device__ __forceinline__ void st8(bf16_t* p, f32x4 a, f32x4 b) { u32x4 w; w.x = pk(a[0], a[1]); w.y = pk(a[2], a[3]); w.z = pk(b[0], b[1]); w.w = pk(b[2], b[3]); *(u32x4*)p = w; }
__device__ __forceinline__ void ld8(const bf16_t* p, f32x4& a, f32x4& b) { const u32x4 w = *(const u32x4*)p;
    a[0] = bflo(w.x); a[1] = bfhi(w.x); a[2] = bflo(w.y); a[3] = bfhi(w.y); b[0] = bflo(w.z); b[1] = bfhi(w.z); b[2] = bflo(w.w); b[3] = bfhi(w.w); }

__device__ __forceinline__ void unp8(u32x4 w, f32x4& a, f32x4& b) { a[0] = bflo(w.x); a[1] = bfhi(w.x); a[2] = bflo(w.y); a[3] = bfhi(w.y); b[0] = bflo(w.z); b[1] = bfhi(w.z); b[2] = bflo(w.w); b[3] = bfhi(w.w); }
template <class F> struct Epi8 {
    static constexpr bool PERM = true, AFTER_DRAIN = false;
    F f;
    __device__ __forceinline__ void operator()(const f32x4 (&acc)[2][2][4][2], const Unit& u, int wr, int wc, int fr, int fq) const {
        const int row0 = u.pm * pg8::BM + wr * 64 + fr, col0 = u.pn * pg8::BM + wc * 32 + 8 * fq;
        if constexpr (F::HAS_LD) {
#pragma unroll
            for (int ai = 0; ai < 2; ++ai)
#pragma unroll
                for (int mh = 0; mh < 2; ++mh) {
                    typename F::LD l[2][2];
#pragma unroll
                    for (int mm = 0; mm < 2; ++mm)
#pragma unroll
                        for (int bj = 0; bj < 2; ++bj) l[mm][bj] = f.ld(row0 + ai * pg8::HALF + (2 * mh + mm) * 16, col0 + bj * pg8::HALF);
#pragma unroll
                    for (int mm = 0; mm < 2; ++mm)
#pragma unroll
                        for (int bj = 0; bj < 2; ++bj) f.st(row0 + ai * pg8::HALF + (2 * mh + mm) * 16, col0 + bj * pg8::HALF, acc[ai][bj][2 * mh + mm][0], acc[ai][bj][2 * mh + mm][1], l[mm][bj]);
                    asm volatile("" ::: "memory");
                }
        } else {
#pragma unroll
            for (int ai = 0; ai < 2; ++ai)
#pragma unroll
                for (int m = 0; m < 4; ++m)
#pragma unroll
                    for (int bj = 0; bj < 2; ++bj) { f(row0 + ai * pg8::HALF + m * 16, col0 + bj * pg8::HALF, acc[ai][bj][m][0], acc[ai][bj][m][1], fq);
                      if (EPI_FENCE) asm volatile("" ::: "memory"); }
        }
    }
};
__device__ __forceinline__ void rope8(f32x4& a, f32x4& b, const float* cosT, const float* sinT, int pos, int i0) {
    const f32x4 c = *(const f32x4*)(cosT + pos * 32 + i0), s = *(const f32x4*)(sinT + pos * 32 + i0);
    f32x4 oa, ob;
    oa[0] = a[0] * c[0] - a[1] * s[0]; oa[1] = a[0] * s[0] + a[1] * c[0]; oa[2] = a[2] * c[1] - a[3] * s[1]; oa[3] = a[2] * s[1] + a[3] * c[1];
    ob[0] = b[0] * c[2] - b[1] * s[2]; ob[1] = b[0] * s[2] + b[1] * c[2]; ob[2] = b[2] * c[3] - b[3] * s[3]; ob[3] = b[2] * s[3] + b[3] * c[3];
    a = oa; b = ob;
}
__device__ __forceinline__ float sigm(float x) { return 1.0f / (1.0f + __expf(-x)); }
struct FTm { static constexpr bool HAS_LD = false; bf16_t *CQ, *CKV, *KR, *G; float* ssq; const float *cosT, *sinT; int seqmask;
    __device__ __forceinline__ void operator()(int row, int col, f32x4 a, f32x4 b, int fq) const {
        if (col < 640) {
            float s = (a[0] * a[0] + a[1] * a[1]) + (a[2] * a[2] + a[3] * a[3]) + (b[0] * b[0] + b[1] * b[1]) + (b[2] * b[2] + b[3] * b[3]);
            s += __shfl_xor(s, 16); s += __shfl_xor(s, 32);
            if (col < 384) { st8(CQ + (size_t)row * 384 + col, a, b); if (fq == 0) __hip_atomic_fetch_add(ssq + row * 2, s, __ATOMIC_RELAXED, __HIP_MEMORY_SCOPE_AGENT); }
            else { st8(CKV + (size_t)row * 256 + (col - 384), a, b); if (fq == 0) __hip_atomic_fetch_add(ssq + row * 2 + 1, s, __ATOMIC_RELAXED, __HIP_MEMORY_SCOPE_AGENT); }
        } else if (col < 704) {
            const int j = col - 640; rope8(a, b, cosT, sinT, row & seqmask, j >> 1); st8(KR + (size_t)row * 64 + j, a, b);
        } else if (col < 2752) {
#pragma unroll
            for (int i = 0; i < 4; ++i) { a[i] = sigm(a[i]); b[i] = sigm(b[i]); }
            st8(G + (size_t)row * 2048 + (col - 704), a, b);
        }
    }
};
struct FQ { static constexpr bool HAS_LD = true; typedef float LD; bf16_t* Q; const float* ssq; const float *cosT, *sinT; int seqmask;
    __device__ __forceinline__ LD ld(int row, int) const { return ssq[row * 2]; }
    __device__ __forceinline__ void st(int row, int col, f32x4 a, f32x4 b, LD sq) const {
        const float rs = rsqrtf(sq * (1.0f / 384.0f) + RMS_EPS); a = a * rs; b = b * rs;
        if (col >= 1024) rope8(a, b, cosT, sinT, row & seqmask, ((col - 1024) & 63) >> 1);
        st8(Q + (size_t)row * 1536 + col, a, b);
    }
};
struct FKV { static constexpr bool HAS_LD = true; typedef float LD; bf16_t* KV; const float* ssq;
    __device__ __forceinline__ LD ld(int row, int) const { return ssq[row * 2 + 1]; }
    __device__ __forceinline__ void st(int row, int col, f32x4 a, f32x4 b, LD sq) const {
        const float rs = rsqrtf(sq * (1.0f / 256.0f) + RMS_EPS); st8(KV + (size_t)row * 2048 + col, a * rs, b * rs);
    }
};
struct FBf { static constexpr bool HAS_LD = false; bf16_t* O; size_t ld;
    __device__ __forceinline__ void operator()(int row, int col, f32x4 a, f32x4 b, int) const { st8(O + (size_t)row * ld + col, a, b); }
};
struct FFilt { static constexpr bool HAS_LD = false; bf16_t* FT; int L;
    __device__ __forceinline__ void operator()(int row, int col, f32x4 a, f32x4 b, int) const {
        const int c = row & 1023; const float MIN_DECAY = -3.0701134573253944f, MAX_DECAY = -15.350567286626973f;
        const float kk = -1.4426950408889634f * fabsf(MIN_DECAY + (MAX_DECAY - MIN_DECAY) * ((float)c * (1.0f / 1023.0f))) / (float)(L - 1); const float fc = (float)col;
#pragma unroll
        for (int i = 0; i < 4; ++i) { a[i] *= __builtin_amdgcn_exp2f((fc + (float)i) * kk) + 0.05f; b[i] *= __builtin_amdgcn_exp2f((fc + (float)(4 + i)) * kk) + 0.05f; }
        st8(FT + (size_t)row * L + col, a, b);
    }
};
struct FM1 { static constexpr bool HAS_LD = true; typedef u32x4 LD; bf16_t* MG; const bf16_t* G;
    __device__ __forceinline__ LD ld(int row, int col) const { return *(const u32x4*)(G + (size_t)row * 2048 + col); }
    __device__ __forceinline__ void st(int row, int col, f32x4 a, f32x4 b, LD g) const { f32x4 ga, gb; unp8(g, ga, gb); st8(MG + (size_t)row * 1024 + col, a * ga, b * gb); }
};
struct LD2 { u32x4 g, p; };
struct FM2 { static constexpr bool HAS_LD = true; typedef LD2 LD; bf16_t* MG; const bf16_t* G;
    __device__ __forceinline__ LD ld(int row, int col) const { LD2 l; l.g = *(const u32x4*)(G + (size_t)row * 2048 + 1024 + col); l.p = *(const u32x4*)(MG + (size_t)row * 1024 + col); return l; }
    __device__ __forceinline__ void st(int row, int col, f32x4 a, f32x4 b, LD l) const { f32x4 ga, gb, pa, pb; unp8(l.g, ga, gb); unp8(l.p, pa, pb); st8(MG + (size_t)row * 1024 + col, pa + a * ga, pb + b * gb); }
};
struct LDF { f32x4 a, b; };
struct FOut { static constexpr bool HAS_LD = true; typedef LDF LD; float* Y; const float* X;
    __device__ __forceinline__ LD ld(int row, int col) const { const size_t o = (size_t)row * 1024 + col; LDF l; l.a = *(const f32x4*)(X + o); l.b = *(const f32x4*)(X + o + 4); return l; }
    __device__ __forceinline__ void st(int row, int col, f32x4 a, f32x4 b, LD l) const { const size_t o = (size_t)row * 1024 + col; *(f32x4*)(Y + o) = l.a * DN_ALPHA + a; *(f32x4*)(Y + o + 4) = l.b * DN_ALPHA + b; }
};
struct FDown { static constexpr bool HAS_LD = true; typedef LDF LD; float* Y;
    __device__ __forceinline__ LD ld(int row, int col) const { const size_t o = (size_t)row * 1024 + col; LDF l; l.a = *(const f32x4*)(Y + o); l.b = *(const f32x4*)(Y + o + 4); return l; }
    __device__ __forceinline__ void st(int row, int col, f32x4 a, f32x4 b, LD l) const { const size_t o = (size_t)row * 1024 + col; *(f32x4*)(Y + o) = l.a * DN_ALPHA + a; *(f32x4*)(Y + o + 4) = l.b * DN_ALPHA + b; }
};
template <int ID, class F> __device__ __forceinline__ void run_gemm(PG8_LAS unsigned char* lds, const bf16_t* A, const bf16_t* Bt, int M, int N, int K, const F& f) {
  if constexpr ((EN_GEMM >> ID) & 1) {
    asm volatile("" : "+s"(M), "+s"(N), "+s"(K));
    pg8::Gemm g{A, Bt, M, N, K}; pg8::StaticOrder S; S.init(M, N, (int)gridDim.x, (int)blockIdx.x);
    Epi8<F> E{f};
    pg8::gemm_phase<Epi8<F>, pg8::StaticOrder, G_ALIGN, (ID != 0 && ID != 3)>(lds, g, S, E);
  }
}

namespace att {
typedef short bf16x8 __attribute__((ext_vector_type(8)));
typedef short s16x4 __attribute__((ext_vector_type(4)));
typedef float f32x16 __attribute__((ext_vector_type(16)));
constexpr int NW = 8, QBLK = 32, KVBLK = 64, LDQ = 1536, LDK = 2048, LDKR = 64, LDO = 1024;
constexpr float SCALE = 0.07216878364870323f, THR = 8.f;
constexpr int SHM_V = 16384, SHM_K = 24576;
#define AKSWZ(row, colB) ((row) * 384 + ((colB) ^ (((row) & 7) << 4)))
#define SBAR() __builtin_amdgcn_sched_barrier(0)
__device__ __forceinline__ int crow(int r, int hi) { return (r & 3) + 8 * (r >> 2) + 4 * hi; }
__device__ __forceinline__ void partialSM(f32x16& p0, f32x16& p1, float& m_reg, float& mn, float& alpha) {
  constexpr float C = SCALE * 1.4426950408889634f;
  float pmax = p0[0]; for (int r = 1; r < 16; ++r) pmax = fmaxf(pmax, p0[r]); for (int r = 0; r < 16; ++r) pmax = fmaxf(pmax, p1[r]);
  { auto rr = __builtin_amdgcn_permlane32_swap(__float_as_uint(pmax), __float_as_uint(pmax), false, false);
    pmax = fmaxf(__uint_as_float(rr[0]), __uint_as_float(rr[1])); }
  if (__builtin_expect(__all(pmax - m_reg <= THR / SCALE), 1)) { mn = m_reg; alpha = 1.f; }
  else { mn = fmaxf(m_reg, pmax); alpha = __builtin_amdgcn_exp2f((m_reg - mn) * C); m_reg = mn; }
  float mnC = -mn * C;
  for (int r = 0; r < 16; ++r) p0[r] = fmaf(p0[r], C, mnC); for (int r = 0; r < 16; ++r) p1[r] = fmaf(p1[r], C, mnC);
  for (int r = 0; r < 16; ++r) p0[r] = __builtin_amdgcn_exp2f(p0[r]);
}
__device__ __forceinline__ void finishSM(f32x16& p0, f32x16& p1, float alpha, float& l_reg, bf16x8& pa0, bf16x8& pa1, bf16x8& pa2, bf16x8& pa3) {
  for (int r = 0; r < 16; ++r) p1[r] = __builtin_amdgcn_exp2f(p1[r]);
  float ps = 0; for (int r = 0; r < 16; ++r) ps += p0[r]; for (int r = 0; r < 16; ++r) ps += p1[r];
  { auto rr = __builtin_amdgcn_permlane32_swap(__float_as_uint(ps), __float_as_uint(ps), false, false);
    ps = __uint_as_float(rr[0]) + __uint_as_float(rr[1]); }
  l_reg = l_reg * alpha + ps;
#define PK4(P, BASE, OUT) do { unsigned a0 = pk(P[BASE + 0], P[BASE + 1]), a1 = pk(P[BASE + 2], P[BASE + 3]);   \
    unsigned b0 = pk(P[BASE + 4], P[BASE + 5]), b1 = pk(P[BASE + 6], P[BASE + 7]);                              \
    auto r0 = __builtin_amdgcn_permlane32_swap(a0, b0, false, false); auto r1 = __builtin_amdgcn_permlane32_swap(a1, b1, false, false); \
    u32x4 w = {r0[0], r1[0], r0[1], r1[1]}; OUT = *reinterpret_cast<bf16x8*>(&w); } while (0)
  PK4(p0, 0, pa0); PK4(p0, 8, pa1); PK4(p1, 0, pa2); PK4(p1, 8, pa3);
#undef PK4
}
__device__ __forceinline__ void qkt(f32x16& p0, f32x16& p1, const char* Ks, const bf16x8* qr, const bf16x8* qrl, int r32, int hi) {
  p0 = f32x16{}; p1 = f32x16{};
  int kb[4];
#pragma unroll
  for (int dl = 0; dl < 4; ++dl) kb[dl] = r32 * 384 + ((dl * 32 + hi * 16) ^ ((r32 & 7) << 4));
#pragma unroll
  for (int d0 = 0; d0 < 12; ++d0) {
    bf16x8 b0 = *reinterpret_cast<const bf16x8*>(Ks + kb[d0 & 3] + (d0 >> 2) * 128);
    bf16x8 b1 = *reinterpret_cast<const bf16x8*>(Ks + kb[d0 & 3] + (d0 >> 2) * 128 + 32 * 384);
    const bf16x8 qv = (d0 < 8) ? qr[d0 & 7] : qrl[(d0 - 8) * 64];
    p0 = __builtin_amdgcn_mfma_f32_32x32x16_bf16(b0, qv, p0, 0, 0, 0);
    p1 = __builtin_amdgcn_mfma_f32_32x32x16_bf16(b1, qv, p1, 0, 0, 0); }
}
__device__ __forceinline__ int v_st(int k, int c) { const int kk = (k & ~0xC) | ((k & 4) << 1) | ((k & 8) >> 1); return ((kk >> 3) * 4 + (c >> 5)) * 512 + ((kk & 7) * 32 + (c & 31)) * 2; }
__device__ __forceinline__ int v_rd_base(int lane) { return ((lane & 3) << 3) | (((lane >> 2) & 3) << 6) | (((lane >> 4) & 1) << 5) | (((lane >> 5) & 1) << 8); }
constexpr int v_rd_off(int d0, int ks, int half) { return d0 * 512 + ks * 4096 + half * 2048; }
template <int OFF> __device__ __forceinline__ s16x4 tr_read(int vb) {
  s16x4 r; asm volatile("ds_read_b64_tr_b16 %0, %1 offset:%2" : "=&v"(r) : "v"(vb), "i"(OFF) : "memory"); return r;
}
template <int D0> __device__ __forceinline__ void pv_one(f32x16& od, int vb, bf16x8 pa0, bf16x8 pa1, bf16x8 pa2, bf16x8 pa3) {
  const s16x4 l0 = tr_read<v_rd_off(D0, 0, 0)>(vb), h0 = tr_read<v_rd_off(D0, 0, 1)>(vb), l1 = tr_read<v_rd_off(D0, 1, 0)>(vb), h1 = tr_read<v_rd_off(D0, 1, 1)>(vb);
  const s16x4 l2 = tr_read<v_rd_off(D0, 2, 0)>(vb), h2 = tr_read<v_rd_off(D0, 2, 1)>(vb), l3 = tr_read<v_rd_off(D0, 3, 0)>(vb), h3 = tr_read<v_rd_off(D0, 3, 1)>(vb);
  asm volatile("s_waitcnt lgkmcnt(0)" ::: "memory"); SBAR();
#define PKV(L, H) (bf16x8){L[0], L[1], L[2], L[3], H[0], H[1], H[2], H[3]}
  od = __builtin_amdgcn_mfma_f32_32x32x16_bf16(pa0, PKV(l0, h0), od, 0, 0, 0);
  od = __builtin_amdgcn_mfma_f32_32x32x16_bf16(pa1, PKV(l1, h1), od, 0, 0, 0);
  od = __builtin_amdgcn_mfma_f32_32x32x16_bf16(pa2, PKV(l2, h2), od, 0, 0, 0);
  od = __builtin_amdgcn_mfma_f32_32x32x16_bf16(pa3, PKV(l3, h3), od, 0, 0, 0);
#undef PKV
}
__device__ __forceinline__ void pv_d0(f32x16* o, int vb, bf16x8 pa0, bf16x8 pa1, bf16x8 pa2, bf16x8 pa3) {
  pv_one<0>(o[0], vb, pa0, pa1, pa2, pa3); pv_one<1>(o[1], vb, pa0, pa1, pa2, pa3); pv_one<2>(o[2], vb, pa0, pa1, pa2, pa3); pv_one<3>(o[3], vb, pa0, pa1, pa2, pa3);
}
__device__ __forceinline__ void attn_unit(const bf16_t* __restrict__ Qb, const bf16_t* __restrict__ Kh, const bf16_t* __restrict__ Vh, const bf16_t* __restrict__ KRb,
                                          bf16_t* __restrict__ Ob, int seq, char* lds, int h) {
  int tid = threadIdx.x; asm volatile("" : "+v"(tid));
  const int wid = tid >> 6, lane = tid & 63, r32 = lane & 31, hi = lane >> 5;
  char* V_lds = lds; char* K_lds = lds + 2 * SHM_V;
  float* ws = (float*)(lds + 2 * SHM_V + 2 * SHM_K) + wid * 64; float* li_l = ws; float* al_l = ws + 32;
  float m_reg = -1e30f, l_reg = 0; f32x16 o[4] = {}; bf16x8 qr[8];
  bf16x8* qrl = (bf16x8*)(lds + 2 * SHM_V + 2 * SHM_K + 2048) + wid * 256 + lane;
  const bf16_t* Qw = Qb + (long)(wid * QBLK + r32) * LDQ + hi * 8 + h * 128;
  const bf16_t* Qwr = Qb + (long)(wid * QBLK + r32) * LDQ + hi * 8 + 1024 + h * 64;
#pragma unroll
  for (int d0 = 0; d0 < 8; ++d0) qr[d0] = *reinterpret_cast<const bf16x8*>(Qw + d0 * 16);
#pragma unroll
  for (int d0 = 8; d0 < 12; ++d0) qrl[(d0 - 8) * 64] = *reinterpret_cast<const bf16x8*>(Qwr + (d0 - 8) * 16);
  const int sr = tid >> 4, sc = (tid & 15) * 8, vst0 = v_st(sr, sc), vst1 = v_st(32 + sr, sc);
  const int rr = tid >> 3, rc = (tid & 7) * 8;
  const int vb0 = (int)(uintptr_t)V_lds + v_rd_base(lane);
  bf16x8 vs0, vs1, ks0, ks1, kr0;
#define SLOAD(k0) do { vs0 = *reinterpret_cast<const bf16x8*>(&Vh[(long)((k0) + sr) * LDK + sc]); vs1 = *reinterpret_cast<const bf16x8*>(&Vh[(long)((k0) + 32 + sr) * LDK + sc]); \
    ks0 = *reinterpret_cast<const bf16x8*>(&Kh[(long)((k0) + sr) * LDK + sc]); ks1 = *reinterpret_cast<const bf16x8*>(&Kh[(long)((k0) + 32 + sr) * LDK + sc]); \
    kr0 = *reinterpret_cast<const bf16x8*>(&KRb[(long)((k0) + rr) * LDKR + rc]); } while (0)
#define SWRITE(b) do { *(bf16x8*)(V_lds + (b) * SHM_V + vst0) = vs0; *(bf16x8*)(V_lds + (b) * SHM_V + vst1) = vs1; int kc = sc * 2; \
    *(bf16x8*)(K_lds + (b) * SHM_K + AKSWZ(sr, kc)) = ks0; *(bf16x8*)(K_lds + (b) * SHM_K + AKSWZ(32 + sr, kc)) = ks1; \
    *(bf16x8*)(K_lds + (b) * SHM_K + AKSWZ(rr, 256 + rc * 2)) = kr0; } while (0)
#define SWAIT() asm volatile("s_waitcnt vmcnt(0)" ::: "memory")
#define RESC(a) do { if (__any((a) < 1.f)) { if (hi == 0) al_l[r32] = (a); asm volatile("s_waitcnt lgkmcnt(0)" ::: "memory"); \
    for (int d = 0; d < 4; ++d) for (int r = 0; r < 16; ++r) o[d][r] *= al_l[crow(r, hi)]; } } while (0)
  f32x16 pA0, pA1, pB0, pB1; float mnA, mnB, alA, alB; bf16x8 pa0, pa1, pa2, pa3; const int NT = seq / KVBLK;
  SLOAD(0); SWAIT(); SWRITE(0); __syncthreads();
  qkt(pA0, pA1, K_lds, qr, qrl, r32, hi); partialSM(pA0, pA1, m_reg, mnA, alA);
  SLOAD(KVBLK);
  SWAIT(); SWRITE(1); __syncthreads();
  for (int j = 1; j + 1 < NT; j += 2) {
    SBAR(); qkt(pB0, pB1, K_lds + SHM_K, qr, qrl, r32, hi);
    finishSM(pA0, pA1, alA, l_reg, pa0, pa1, pa2, pa3); SBAR();
    SLOAD((j + 1) * KVBLK); SBAR();
    pv_d0(o, vb0, pa0, pa1, pa2, pa3); partialSM(pB0, pB1, m_reg, mnB, alB);
    __syncthreads(); SWAIT(); SWRITE(0);
    RESC(alB); __syncthreads();
    SBAR(); qkt(pA0, pA1, K_lds, qr, qrl, r32, hi);
    finishSM(pB0, pB1, alB, l_reg, pa0, pa1, pa2, pa3); SBAR();
    SLOAD((j + 2) * KVBLK); SBAR();
    pv_d0(o, vb0 + SHM_V, pa0, pa1, pa2, pa3); partialSM(pA0, pA1, m_reg, mnA, alA);
    __syncthreads(); SWAIT(); SWRITE(1);
    RESC(alA); __syncthreads();
  }
  SBAR(); qkt(pB0, pB1, K_lds + SHM_K, qr, qrl, r32, hi);
  finishSM(pA0, pA1, alA, l_reg, pa0, pa1, pa2, pa3); SBAR();
  pv_d0(o, vb0, pa0, pa1, pa2, pa3); partialSM(pB0, pB1, m_reg, mnB, alB);
  __syncthreads(); RESC(alB);
  finishSM(pB0, pB1, alB, l_reg, pa0, pa1, pa2, pa3); SBAR();
  pv_d0(o, vb0 + SHM_V, pa0, pa1, pa2, pa3);
  if (hi == 0) li_l[r32] = l_reg; asm volatile("s_waitcnt lgkmcnt(0)" ::: "memory");
  float rli[16];
#pragma unroll
  for (int r = 0; r < 16; ++r) rli[r] = __builtin_amdgcn_rcpf(li_l[crow(r, hi)]);
  bf16_t* Ow = Ob + (long)(wid * QBLK) * LDO;
#pragma unroll
  for (int r = 0; r < 16; ++r) { int orow = crow(r, hi);
#pragma unroll
    for (int d0 = 0; d0 < 4; ++d0) Ow[(long)orow * LDO + d0 * 32 + r32] = f2bf(o[d0][r] * rli[r]); }
  __syncthreads();
#undef SLOAD
#undef SWRITE
#undef SWAIT
#undef RESC
}
}

namespace hy {
__device__ __forceinline__ c2 cmul(c2 a, c2 b) { return (c2){a.x * b.x - a.y * b.y, a.x * b.y + a.y * b.x}; }
__device__ __forceinline__ c2 cmulc(c2 a, c2 b) { return (c2){a.x * b.x + a.y * b.y, a.y * b.x - a.x * b.y}; }
__device__ __forceinline__ c2 twid(float fr) { return (c2){__builtin_amdgcn_cosf(fr), -__builtin_amdgcn_sinf(fr)}; }
struct T2 { c2 w, wr; };
__device__ __forceinline__ T2 mk(c2 w) { T2 t; t.w = w; t.wr = (c2){-w.y, w.x}; return t; }
__device__ __forceinline__ c2 mulT(c2 x, const T2& t) { return x.xx * t.w + x.yy * t.wr; }
template <bool INV> __device__ __forceinline__ void r4(c2& x0, c2& x1, c2& x2, c2& x3) {
    const c2 t0 = x0 + x2, t1 = x0 - x2, t2 = x1 + x3, t3 = x1 - x3;
    const c2 r = INV ? (c2){-t3.y, t3.x} : (c2){t3.y, -t3.x};
    x0 = t0 + t2; x1 = t1 + r; x2 = t0 - t2; x3 = t1 - r;
}
template <bool INV> __device__ __forceinline__ c2 mulw(c2 x, int k) {
    const float C1 = 0.9238795325112867f, S1 = 0.3826834323650898f, R = 0.7071067811865476f;
    const float sg = INV ? -1.f : 1.f; c2 w;
    switch (k) { case 0: return x; case 1: w = (c2){C1, -S1 * sg}; break; case 2: w = (c2){R, -R * sg}; break; case 3: w = (c2){S1, -C1 * sg}; break;
                 case 4: return INV ? (c2){-x.y, x.x} : (c2){x.y, -x.x}; case 6: w = (c2){-R, -R * sg}; break; default: w = (c2){-C1, S1 * sg}; break;   }
    return x.xx * w + x.yy * (c2){-w.y, w.x};
}
template <bool INV> __device__ __forceinline__ void dft16(c2 (&e)[16]) {
#pragma unroll
    for (int a0 = 0; a0 < 4; ++a0) { r4<INV>(e[a0], e[a0 + 4], e[a0 + 8], e[a0 + 12]);
#pragma unroll
        for (int b0 = 1; b0 < 4; ++b0) e[a0 + 4 * b0] = mulw<INV>(e[a0 + 4 * b0], a0 * b0); }
#pragma unroll
    for (int b0 = 0; b0 < 4; ++b0) r4<INV>(e[4 * b0], e[4 * b0 + 1], e[4 * b0 + 2], e[4 * b0 + 3]);
#pragma unroll
    for (int b0 = 0; b0 < 4; ++b0)
#pragma unroll
        for (int b1 = b0 + 1; b1 < 4; ++b1) { const c2 t = e[b1 + 4 * b0]; e[b1 + 4 * b0] = e[b0 + 4 * b1]; e[b0 + 4 * b1] = t; }
}
template <int R, bool INV, bool TW> __device__ __forceinline__ void bfly(c2 (&e)[R], c2 th) {
    T2 t1, t2, t3, T1, T2_, T3;
    if (TW) { t1 = mk(th); t2 = mk(mulT(th, t1)); t3 = mk(mulT(t2.w, t1));
        if (R == 16) { T1 = mk(mulT(t2.w, t2)); T2_ = mk(mulT(T1.w, T1)); T3 = mk(mulT(T2_.w, T1)); } }
#define HY_APPLY_TW() do { if (R == 16) { _Pragma("unroll") for (int b1 = 0; b1 < 4; ++b1) { e[4 * b1 + 1] = mulT(e[4 * b1 + 1], t1); e[4 * b1 + 2] = mulT(e[4 * b1 + 2], t2); e[4 * b1 + 3] = mulT(e[4 * b1 + 3], t3); } \
        _Pragma("unroll") for (int b0 = 0; b0 < 4; ++b0) { e[4 + b0] = mulT(e[4 + b0], T1); e[8 + b0] = mulT(e[8 + b0], T2_); e[12 + b0] = mulT(e[12 + b0], T3); } } \
      else { e[1] = mulT(e[1], t1); e[2] = mulT(e[2], t2); e[3] = mulT(e[3], t3); } } while (0)
    if (INV && TW) HY_APPLY_TW();
    if constexpr (R == 16) dft16<INV>(e); else r4<INV>(e[0], e[1], e[2], e[3]);
    if (!INV && TW) HY_APPLY_TW();
#undef HY_APPLY_TW
}
struct NoF { static constexpr bool ON = false; };
template <int R, bool INV, int S, int LS, int NSL, class LD, class ST> __device__ __forceinline__ void fft_pass(LAS c2* X, int seqstride, int nseq, int tid, const LD& ld, const ST& st) {
    const int total = nseq << NSL;
    for (int g = tid; g < total; g += 512) {
        const int q = g >> NSL, sg = g & ((1 << NSL) - 1);
        const int j0 = sg & (S - 1), blk = sg >> LS, base = blk * R * S + j0;
        LAS c2* p = X + q * seqstride + base + (base >> 4);
        constexpr int sp = (S >= 16) ? S + (S >> 4) : S;
        c2 e[R];
#pragma unroll
        for (int a = 0; a < R; ++a) { if constexpr (LD::ON) { e[a] = ld(q, base + a * S); if ((a & 3) == 3) asm volatile("" ::: "memory"); } else e[a] = p[a * sp]; }
        c2 th0 = twid((float)j0 * (1.0f / (float)(R * S))); if (INV) th0.y = -th0.y;
        bfly<R, INV, (S > 1)>(e, th0);
#pragma unroll
        for (int a = 0; a < R; ++a) { if constexpr (ST::ON) { st(q, base + a * S, e[a]); if ((a & 1) == 1) asm volatile("" ::: "memory"); } else p[a * sp] = e[a]; }
    }
    __syncthreads();
}
template <int LOGN> __device__ __forceinline__ void fft_mid(LAS c2* X, int nseq, const c2* KS, int tid) {
    constexpr int N = 1 << LOGN, SS = N + N / 16, NSL = LOGN - 4;
    const int total = nseq << NSL;
    for (int g = tid; g < total; g += 512) {
        const int q = g >> NSL, sg = g & ((1 << NSL) - 1);
        LAS c2* p = X + q * SS + sg * 17;
        c2 e[16];
#pragma unroll
        for (int a = 0; a < 16; ++a) e[a] = p[a];
        dft16<false>(e);
        const c2* kp = KS + sg;
#pragma unroll
        for (int a0 = 0; a0 < 16; a0 += 4) { c2 k[4];
#pragma unroll
            for (int a = 0; a < 4; ++a) k[a] = kp[(a0 + a) * (N / 16)];
#pragma unroll
            for (int a = 0; a < 4; ++a) e[a0 + a] = mulT(e[a0 + a], mk(k[a]));
            asm volatile("" ::: "memory"); }
        dft16<true>(e);
#pragma unroll
        for (int a = 0; a < 16; ++a) p[a] = e[a];
    }
    __syncthreads();
}
template <int LOGN, class LD> __device__ __forceinline__ void fft_fwd_head(LAS c2* X, int nseq, int tid, const LD& ld) {
    constexpr int N = 1 << LOGN, SS = N + N / 16; const NoF nf;
    if constexpr (LOGN == 14) { fft_pass<4, false, 4096, 12, LOGN - 2>(X, SS, nseq, tid, ld, nf); fft_pass<16, false, 256, 8, LOGN - 4>(X, SS, nseq, tid, nf, nf); }
    else fft_pass<16, false, 256, 8, LOGN - 4>(X, SS, nseq, tid, ld, nf);
    fft_pass<16, false, 16, 4, LOGN - 4>(X, SS, nseq, tid, nf, nf);
}
template <int LOGN, class ST> __device__ __forceinline__ void fft_inv_tail(LAS c2* X, int nseq, int tid, const ST& st) {
    constexpr int N = 1 << LOGN, SS = N + N / 16; const NoF nf;
    fft_pass<16, true, 16, 4, LOGN - 4>(X, SS, nseq, tid, nf, nf);
    if constexpr (LOGN == 14) { fft_pass<16, true, 256, 8, LOGN - 4>(X, SS, nseq, tid, nf, nf); fft_pass<4, true, 4096, 12, LOGN - 2>(X, SS, nseq, tid, nf, st); }
    else fft_pass<16, true, 256, 8, LOGN - 4>(X, SS, nseq, tid, nf, st);
}
template <int L> __device__ __forceinline__ float dw3(const bf16_t* u, int m, float w0, float w1, float w2, float b) {
    float x = bf2f(u[m]) * w1 + b; if (m > 0) x += bf2f(u[m - 1]) * w0; if (m < L - 1) x += bf2f(u[m + 1]) * w2; return x;
}
template <int L> struct HyCtx {
    const bf16_t *hf, *hb, *uv, *ug; bf16_t* zt; c2 *KS, *YC; float v0, v1, v2, vb, g0, g1, g2, gb, skip; int n;
    __device__ __forceinline__ c2 loadz(int q, int m) const { const int oA = 2 * q * L, oB = oA + L; c2 z;
        if (n == 0) { z.x = dw3<L>(uv + oA, m, v0, v1, v2, vb); z.y = dw3<L>(uv + oB, m, v0, v1, v2, vb); } else { z.x = bf2f(zt[oA + m]); z.y = bf2f(zt[oB + m]); }
        return z; }
};
template <int L, bool NEG> struct LdK { static constexpr bool ON = true; const HyCtx<L>* c;
    __device__ __forceinline__ c2 operator()(int, int m) const { const float f = bf2f(c->hf[m]); const float b = m ? bf2f(c->hb[L - m]) : 0.f;
        if (!NEG) return (c2){f + b, 0.f}; return twid((float)m * (0.5f / (float)L)) * (f - b); } };
template <int L, bool NEG> struct LdZ { static constexpr bool ON = true; const HyCtx<L>* c;
    __device__ __forceinline__ c2 operator()(int q, int m) const { c2 z = c->loadz(q, m); if (NEG) z = mulT(z, mk(twid((float)m * (0.5f / (float)L)))); return z; } };
template <int L> struct StKS { static constexpr bool ON = true; const HyCtx<L>* c;
    __device__ __forceinline__ void operator()(int, int pos, c2 v) const { c->KS[(pos & 15) * (L / 16) + (pos >> 4)] = v; } };
template <int L> struct StYC { static constexpr bool ON = true; const HyCtx<L>* c;
    __device__ __forceinline__ void operator()(int q, int m, c2 v) const { c->YC[q * L + m] = v; } };
template <int L> struct StFin { static constexpr bool ON = true; const HyCtx<L>* c;
    __device__ __forceinline__ void operator()(int q, int m, c2 v) const { const int oA = 2 * q * L, oB = oA + L;
        const c2 z = c->loadz(q, m); c2 tw = twid((float)m * (0.5f / (float)L)); tw.y = -tw.y;
        const c2 y = (c->YC[q * L + m] + mulT(v, mk(tw))) * (0.5f / (float)L) + z * c->skip;
        const float gA = dw3<L>(c->ug + oA, m, c->g0, c->g1, c->g2, c->gb), gB = dw3<L>(c->ug + oB, m, c->g0, c->g1, c->g2, c->gb);
        c->zt[oA + m] = f2bf(y.x * gA); c->zt[oB + m] = f2bf(y.y * gB); } };
__device__ __forceinline__ unsigned ldw(const void* base, unsigned boff) { return *(const unsigned*)((const char*)base + boff); }
struct W3 { unsigned p, c, n; };
template <int L> __device__ __forceinline__ W3 dw3ld(const bf16_t* u, unsigned j) {
    const unsigned o = j * 4u; W3 w; w.c = ldw(u, o); w.p = ldw(u, j > 0u ? o - 4u : o); w.n = ldw(u, j < (unsigned)(L / 2 - 1) ? o + 4u : o); return w; }
template <int L> __device__ __forceinline__ c2 dw3c(W3 w, unsigned j, float w0, float w1, float w2, float b) {
    const unsigned prv = j > 0u ? w.p : 0u, nxt = j < (unsigned)(L / 2 - 1) ? w.n : 0u;
    const float xm = bfhi(prv), x0 = bflo(w.c), x1 = bfhi(w.c), x2 = bflo(nxt);
    return (c2){xm * w0 + x0 * w1 + x1 * w2 + b, x0 * w0 + x1 * w1 + x2 * w2 + b};
}
template <int L, bool NEG> __device__ __forceinline__ void ew_loadk(LAS c2* X, const HyCtx<L>& c, int tid) {
    constexpr int NI = L / 1024, U = (L == 4096) ? 2 : 8;
#pragma unroll 1
    for (int i0 = 0; i0 < NI; i0 += U) {
        unsigned wf[U], wA[U], wB[U];
#pragma unroll
        for (int u = 0; u < U; ++u) { const unsigned j = (unsigned)tid + 512u * (i0 + u);
            wf[u] = ldw(c.hf, j * 4u); wA[u] = ldw(c.hb, (unsigned)(2 * L - 4) - j * 4u); wB[u] = ldw(c.hb, j ? (unsigned)(2 * L) - j * 4u : 0u); }
#pragma unroll
        for (int u = 0; u < U; ++u) { const unsigned j = (unsigned)tid + 512u * (i0 + u);
            const float f0 = bflo(wf[u]), f1 = bfhi(wf[u]), b0 = j ? bflo(wB[u]) : 0.f, b1 = bfhi(wA[u]); LAS c2* p = X + 2 * j + (j >> 3);
            if (!NEG) { p[0] = (c2){f0 + b0, 0.f}; p[1] = (c2){f1 + b1, 0.f}; }
            else { p[0] = twid((float)(2 * j) * (0.5f / (float)L)) * (f0 - b0); p[1] = twid((float)(2 * j + 1) * (0.5f / (float)L)) * (f1 - b1); } }
    }
    __syncthreads();
}
template <int L, bool NEG, bool N0> __device__ __forceinline__ void ew_loadz(LAS c2* X, const HyCtx<L>& c, int nseq, int tid) {
    constexpr int SS = L + L / 16, NI = L / 1024, U = (L == 4096) ? 2 : 8;
#pragma unroll 1
    for (int q = 0; q < nseq; ++q) { const int oA = 2 * q * L, oB = oA + L;
#pragma unroll 1
        for (int i0 = 0; i0 < NI; i0 += U) {
            W3 a[U], b[U];
#pragma unroll
            for (int u = 0; u < U; ++u) { const unsigned j = (unsigned)tid + 512u * (i0 + u);
                if (N0) { a[u] = dw3ld<L>(c.uv + oA, j); b[u] = dw3ld<L>(c.uv + oB, j); } else { a[u].c = ldw(c.zt + oA, j * 4u); b[u].c = ldw(c.zt + oB, j * 4u); } }
#pragma unroll
            for (int u = 0; u < U; ++u) { const unsigned j = (unsigned)tid + 512u * (i0 + u); c2 zA, zB;
                if (N0) { zA = dw3c<L>(a[u], j, c.v0, c.v1, c.v2, c.vb); zB = dw3c<L>(b[u], j, c.v0, c.v1, c.v2, c.vb); } else { zA = (c2){bflo(a[u].c), bfhi(a[u].c)}; zB = (c2){bflo(b[u].c), bfhi(b[u].c)}; }
                LAS c2* p = X + q * SS + 2 * j + (j >> 3); c2 e0 = (c2){zA.x, zB.x}, e1 = (c2){zA.y, zB.y};
                if (NEG) { e0 = mulT(e0, mk(twid((float)(2 * j) * (0.5f / (float)L)))); e1 = mulT(e1, mk(twid((float)(2 * j + 1) * (0.5f / (float)L)))); }
                p[0] = e0; p[1] = e1; }
        } }
    __syncthreads();
}
template <int L> __device__ __forceinline__ void ew_storeyc(LAS c2* X, const HyCtx<L>& c, int nseq, int tid) {
    constexpr int SS = L + L / 16; typedef float f4 __attribute__((ext_vector_type(4)));
#pragma unroll 1
    for (int q = 0; q < nseq; ++q)
#pragma unroll (L == 4096 ? 2 : 8)
        for (int i = 0; i < L / 1024; ++i) { const unsigned j = (unsigned)tid + 512u * i; LAS c2* p = X + q * SS + 2 * j + (j >> 3); const c2 a = p[0], b = p[1];
            *(f4*)((char*)(c.YC + q * L) + j * 16u) = (f4){a.x, a.y, b.x, b.y}; }
    __syncthreads();
}
template <int L, bool N0> __device__ __forceinline__ void ew_final(LAS c2* X, const HyCtx<L>& c, int nseq, int tid) {
    constexpr int SS = L + L / 16, NI = L / 1024, U = (L == 4096) ? 2 : 4; typedef float f4 __attribute__((ext_vector_type(4)));
#pragma unroll 1
    for (int q = 0; q < nseq; ++q) { const int oA = 2 * q * L, oB = oA + L;
#pragma unroll 1
        for (int i0 = 0; i0 < NI; i0 += U) {
            W3 a[U], b[U], ga[U], gb[U]; f4 yc[U];
#pragma unroll
            for (int u = 0; u < U; ++u) { const unsigned j = (unsigned)tid + 512u * (i0 + u);
                if (N0) { a[u] = dw3ld<L>(c.uv + oA, j); b[u] = dw3ld<L>(c.uv + oB, j); } else { a[u].c = ldw(c.zt + oA, j * 4u); b[u].c = ldw(c.zt + oB, j * 4u); }
                ga[u] = dw3ld<L>(c.ug + oA, j); gb[u] = dw3ld<L>(c.ug + oB, j); yc[u] = *(const f4*)((const char*)(c.YC + q * L) + j * 16u); }
#pragma unroll
            for (int u = 0; u < U; ++u) { const unsigned j = (unsigned)tid + 512u * (i0 + u); c2 zA, zB;
                if (N0) { zA = dw3c<L>(a[u], j, c.v0, c.v1, c.v2, c.vb); zB = dw3c<L>(b[u], j, c.v0, c.v1, c.v2, c.vb); } else { zA = (c2){bflo(a[u].c), bfhi(a[u].c)}; zB = (c2){bflo(b[u].c), bfhi(b[u].c)}; }
                LAS c2* p = X + q * SS + 2 * j + (j >> 3); const c2 yn0 = p[0], yn1 = p[1];
                c2 t0 = twid((float)(2 * j) * (0.5f / (float)L)), t1 = twid((float)(2 * j + 1) * (0.5f / (float)L)); t0.y = -t0.y; t1.y = -t1.y;
                const c2 y0 = ((c2){yc[u][0], yc[u][1]} + mulT(yn0, mk(t0))) * (0.5f / (float)L) + (c2){zA.x, zB.x} * c.skip;
                const c2 y1 = ((c2){yc[u][2], yc[u][3]} + mulT(yn1, mk(t1))) * (0.5f / (float)L) + (c2){zA.y, zB.y} * c.skip;
                const c2 gA = dw3c<L>(ga[u], j, c.g0, c.g1, c.g2, c.gb), gB = dw3c<L>(gb[u], j, c.g0, c.g1, c.g2, c.gb);
                *(unsigned*)((char*)(c.zt + oA) + j * 4u) = pk(y0.x * gA.x, y1.x * gA.y); *(unsigned*)((char*)(c.zt + oB) + j * 4u) = pk(y0.y * gB.x, y1.y * gB.y); }
        } }
    __syncthreads();
}
template <int LOGN> __device__ __forceinline__ void hyena_item(LAS c2* X, const bf16_t* UT, int Tg, const bf16_t* FT, bf16_t* ZT, int c,
                                                               const float* short_w, const float* short_b, const float* hy_skip, c2* KS, c2* YC, int tid) {
    constexpr int L = 1 << LOGN, NSEQ = (LOGN == 12) ? 2 : 1, SS = L + L / 16; constexpr bool FUSE = false;
    HyCtx<L> cx; cx.uv = UT + (size_t)(2048 + c) * Tg; cx.zt = ZT + (size_t)c * Tg; cx.KS = KS; cx.YC = YC;
    cx.v0 = short_w[2048 + c]; cx.v1 = short_w[3072 + 2048 + c]; cx.v2 = short_w[6144 + 2048 + c]; cx.vb = short_b[2048 + c];
    const NoF nf;
    for (int n = 0; n < 2; ++n) {
        cx.n = n; cx.hf = FT + (size_t)(n * 1024 + c) * L; cx.hb = FT + (size_t)((2 + n) * 1024 + c) * L; cx.skip = hy_skip[n * 1024 + c];
        const int gr = n ? 1024 + c : c; cx.ug = UT + (size_t)gr * Tg;
        cx.g0 = short_w[gr]; cx.g1 = short_w[3072 + gr]; cx.g2 = short_w[6144 + gr]; cx.gb = short_b[gr];
        if constexpr (FUSE) fft_fwd_head<LOGN>(X, 1, tid, LdK<L, false>{&cx}); else { ew_loadk<L, false>(X, cx, tid); fft_fwd_head<LOGN>(X, 1, tid, nf); }
        fft_pass<16, false, 1, 0, LOGN - 4>(X, SS, 1, tid, nf, StKS<L>{&cx});
        if constexpr (FUSE) fft_fwd_head<LOGN>(X, NSEQ, tid, LdZ<L, false>{&cx}); else { if (n == 0) ew_loadz<L, false, true>(X, cx, NSEQ, tid); else ew_loadz<L, false, false>(X, cx, NSEQ, tid); fft_fwd_head<LOGN>(X, NSEQ, tid, nf); }
        fft_mid<LOGN>(X, NSEQ, KS, tid);
        if constexpr (FUSE) fft_inv_tail<LOGN>(X, NSEQ, tid, StYC<L>{&cx}); else { fft_inv_tail<LOGN>(X, NSEQ, tid, nf); ew_storeyc<L>(X, cx, NSEQ, tid); }
        if constexpr (FUSE) fft_fwd_head<LOGN>(X, 1, tid, LdK<L, true>{&cx}); else { ew_loadk<L, true>(X, cx, tid); fft_fwd_head<LOGN>(X, 1, tid, nf); }
        fft_pass<16, false, 1, 0, LOGN - 4>(X, SS, 1, tid, nf, StKS<L>{&cx});
        if constexpr (FUSE) fft_fwd_head<LOGN>(X, NSEQ, tid, LdZ<L, true>{&cx}); else { if (n == 0) ew_loadz<L, true, true>(X, cx, NSEQ, tid); else ew_loadz<L, true, false>(X, cx, NSEQ, tid); fft_fwd_head<LOGN>(X, NSEQ, tid, nf); }
        fft_mid<LOGN>(X, NSEQ, KS, tid);
        if constexpr (FUSE) fft_inv_tail<LOGN>(X, NSEQ, tid, StFin<L>{&cx}); else { fft_inv_tail<LOGN>(X, NSEQ, tid, nf); if (n == 0) ew_final<L, true>(X, cx, NSEQ, tid); else ew_final<L, false>(X, cx, NSEQ, tid); }
    }
}
}

__device__ __forceinline__ int colmap(int mode, int n) {
    if (mode == 0) return n;
    if (mode == 1) {
        if (n >= 2816) return 704 + (n - 2816);
        if (n < 640) return n;
        if (n < 704) { const int j = n - 640; return 640 + (j >> 1) + 32 * (j & 1); }
        if (n < 2752) return 3776 + (n - 704);
        return -1;
    }
    if (n < 1024) return (n >> 7) * 192 + (n & 127);
    { const int h = (n - 1024) >> 6, j = (n - 1024) & 63; return h * 192 + 128 + (j >> 1) + 32 * (j & 1); }
}
__device__ __forceinline__ void wtrans(float* tile  , const float* src, int ld, int K, int dstN, bf16_t* dst, int mode, const float* scale, int tid) {
    const int tk = K / 64, ntiles = (dstN / 64) * tk;
    for (int t = blockIdx.x; t < ntiles; t += gridDim.x) {
        const int n0 = (t / tk) * 64, k0 = (t % tk) * 64;
        { const int nn = tid & 63, col = colmap(mode, n0 + nn);
          float vv[8];
#pragma unroll
          for (int i = 0; i < 8; ++i) { const int kk = (tid >> 6) + 8 * i; vv[i] = src[(size_t)(k0 + kk) * ld + (col >= 0 ? col : 0)]; if (scale) vv[i] *= scale[k0 + kk]; }
#pragma unroll
          for (int i = 0; i < 8; ++i) { const int kk = (tid >> 6) + 8 * i; tile[kk * 65 + nn] = col >= 0 ? vv[i] : 0.f; } }
        __syncthreads();
        { const int kk = tid & 63;
#pragma unroll
          for (int i = 0; i < 8; ++i) { const int nn = (tid >> 6) + 8 * i; dst[(size_t)(n0 + nn) * K + k0 + kk] = f2bf(tile[kk * 65 + nn]); } }
        __syncthreads();
    }
}
__device__ __forceinline__ void cvt_rows(const float* src, bf16_t* dst, size_t n8, int gtid, int gthreads) {
    for (size_t i = gtid; i < n8; i += (size_t)gthreads * 4) {
        f32x4 a[4], b[4];
#pragma unroll
        for (int u = 0; u < 4; ++u) { const size_t k = i + (size_t)u * gthreads; a[u] = *(const f32x4*)(src + k * 8); b[u] = *(const f32x4*)(src + k * 8 + 4); }
#pragma unroll
        for (int u = 0; u < 4; ++u) { const size_t k = i + (size_t)u * gthreads; st8(dst + k * 8, a[u], b[u]); } }
}
__device__ __forceinline__ float wsum(float v) { v += __shfl_xor(v, 1); v += __shfl_xor(v, 2); v += __shfl_xor(v, 4); v += __shfl_xor(v, 8); v += __shfl_xor(v, 16); v += __shfl_xor(v, 32); return v; }
__device__ __forceinline__ void ln_rows(float* Y, const float* g, const float* b, bf16_t* Xb, int nrows, int tid) {
    const int wid = tid >> 6, lane = tid & 63;
    f32x4 gv[4], bv[4];
#pragma unroll
    for (int k = 0; k < 4; ++k) { gv[k] = *(const f32x4*)(g + k * 256 + lane * 4); bv[k] = *(const f32x4*)(b + k * 256 + lane * 4); }
    for (int row = (blockIdx.x * 8 + wid) * 2; row < nrows; row += gridDim.x * 16) {
        f32x4 v[2][4];
#pragma unroll
        for (int u = 0; u < 2; ++u)
#pragma unroll
            for (int k = 0; k < 4; ++k) v[u][k] = *(const f32x4*)(Y + (size_t)(row + u) * 1024 + k * 256 + lane * 4);
#pragma unroll
        for (int u = 0; u < 2; ++u) {
            float* y = Y + (size_t)(row + u) * 1024; float s = 0.f;
#pragma unroll
            for (int k = 0; k < 4; ++k) s += (v[u][k][0] + v[u][k][1]) + (v[u][k][2] + v[u][k][3]);
            const float mean = wsum(s) * (1.0f / 1024.0f); float q = 0.f;
#pragma unroll
            for (int k = 0; k < 4; ++k) { v[u][k] = v[u][k] - mean; q += (v[u][k][0] * v[u][k][0] + v[u][k][1] * v[u][k][1]) + (v[u][k][2] * v[u][k][2] + v[u][k][3] * v[u][k][3]); }
            const float rstd = rsqrtf(wsum(q) * (1.0f / 1024.0f) + LN_EPS);
#pragma unroll
            for (int k = 0; k < 4; ++k) { const f32x4 o = v[u][k] * rstd * gv[k] + bv[k]; *(f32x4*)(y + k * 256 + lane * 4) = o;
                if (Xb) { unsigned w0 = pk(o[0], o[1]), w1 = pk(o[2], o[3]); *(uint2*)(Xb + (size_t)(row + u) * 1024 + k * 256 + lane * 4) = make_uint2(w0, w1); } }
        }
    }
}
__device__ __forceinline__ void ffn_mid(const bf16_t* AB, bf16_t* HM, const float* dw_w, const float* dw_b, int seqmask, int tid) {
    typedef float f32x2 __attribute__((ext_vector_type(2)));
    if (tid >= 352) return;
    const int col = tid * 8;
    const f32x4 w0a = *(const f32x4*)(dw_w + col), w0b = *(const f32x4*)(dw_w + col + 4), w1a = *(const f32x4*)(dw_w + 2816 + col), w1b = *(const f32x4*)(dw_w + 2816 + col + 4),
                w2a = *(const f32x4*)(dw_w + 5632 + col), w2b = *(const f32x4*)(dw_w + 5632 + col + 4), ba = *(const f32x4*)(dw_b + col), bb = *(const f32x4*)(dw_b + col + 4);
    const f32x4 zero = {0.f, 0.f, 0.f, 0.f};
    for (int rb = blockIdx.x; rb < TC / 64; rb += gridDim.x) {
        const int r0 = rb * 64; const bf16_t* p = AB + (size_t)r0 * 5632 + col; bf16_t* o = HM + (size_t)r0 * 2816 + col;
        u32x4 wp = {0u, 0u, 0u, 0u}, wc;
        if ((r0 & seqmask) > 0) wp = *(const u32x4*)(p - 5632);
        wc = *(const u32x4*)p;
#pragma unroll 1
        for (int r = 0; r < 64; r += 4) {
            u32x4 wn[4], wg[4];
#pragma unroll
            for (int u = 0; u < 4; ++u) { const int pos = (r0 + r + u) & seqmask;
                wn[u] = *(const u32x4*)(p + (size_t)(r + u + (pos < seqmask ? 1 : 0)) * 5632); wg[u] = *(const u32x4*)(p + (size_t)(r + u) * 5632 + 2816); }
#pragma unroll
            for (int u = 0; u < 4; ++u) { const int pos = (r0 + r + u) & seqmask;
                f32x4 pa, pb, ca, cb, na, nb, ga, gb;
                if (pos == 0) wp = (u32x4){0u, 0u, 0u, 0u};
                if (pos == seqmask) wn[u] = (u32x4){0u, 0u, 0u, 0u};
                unp8(wp, pa, pb); unp8(wc, ca, cb); unp8(wn[u], na, nb); unp8(wg[u], ga, gb);
                f32x4 ta = pa * w0a + ca * w1a + na * w2a + ba, tb = pb * w0b + cb * w1b + nb * w2b + bb;
                const f32x2 q0 = pg8::gelu_pk((f32x2){ta[0], ta[1]}), q1 = pg8::gelu_pk((f32x2){ta[2], ta[3]}), q2 = pg8::gelu_pk((f32x2){tb[0], tb[1]}), q3 = pg8::gelu_pk((f32x2){tb[2], tb[3]});
                ta = (f32x4){q0.x, q0.y, q1.x, q1.y} * ga; tb = (f32x4){q2.x, q2.y, q3.x, q3.y} * gb;
                st8(o + (size_t)(r + u) * 2816, ta, tb);
                wp = wc; wc = wn[u]; }
        }
    }
}
__device__ __forceinline__ void transpose_z(LAS bf16_t* tile  , const bf16_t* ZT, bf16_t* Z, int Tg, int tid) {
    const int tt = Tg / 64, ngroups = 16 * tt / 4;
    for (int gI = blockIdx.x; gI < ngroups; gI += gridDim.x) {
        const int c0 = (gI / (tt / 4)) * 64, tb = (gI % (tt / 4)) * 256;
        const int cc = tid >> 3, t8 = (tid & 7) * 8;
        u32x4 w[4];
#pragma unroll
        for (int k = 0; k < 4; ++k) w[k] = *(const u32x4*)(ZT + (size_t)(c0 + cc) * Tg + tb + k * 64 + t8);
#pragma unroll
        for (int k = 0; k < 4; ++k) { LAS bf16_t* T = tile + k * 64 * 72;
          T[(t8 + 0) * 72 + cc] = (bf16_t)(w[k].x & 0xffff); T[(t8 + 1) * 72 + cc] = (bf16_t)(w[k].x >> 16); T[(t8 + 2) * 72 + cc] = (bf16_t)(w[k].y & 0xffff); T[(t8 + 3) * 72 + cc] = (bf16_t)(w[k].y >> 16);
          T[(t8 + 4) * 72 + cc] = (bf16_t)(w[k].z & 0xffff); T[(t8 + 5) * 72 + cc] = (bf16_t)(w[k].z >> 16); T[(t8 + 6) * 72 + cc] = (bf16_t)(w[k].w & 0xffff); T[(t8 + 7) * 72 + cc] = (bf16_t)(w[k].w >> 16); }
        __syncthreads();
        { const int r = tid >> 3, c8 = (tid & 7) * 8;
#pragma unroll
          for (int k = 0; k < 4; ++k) { const u32x4 o = *(const LAS u32x4*)(tile + k * 64 * 72 + r * 72 + c8); *(u32x4*)(Z + (size_t)(tb + k * 64 + r) * 1024 + c0 + c8) = o; } }
        __syncthreads();
    }
}

struct Params { const float* in[27]; float* out; unsigned char* ws; int lo, hi; };

__device__ __forceinline__ void prologue(const Params& P, unsigned char* smem, int tid) {
    unsigned char* ws = P.ws; float* tile = (float*)smem;
    const int gtid = blockIdx.x * 512 + tid, gthreads = gridDim.x * 512;
    wtrans(tile, P.in[2], 5824, 1024, 5888, (bf16_t*)(ws + WS_WIN), 1, nullptr, tid);
    wtrans(tile, P.in[6], 1536, 384, 1536, (bf16_t*)(ws + WS_WUQ), 2, P.in[5], tid);
    wtrans(tile, P.in[8], 2048, 256, 2048, (bf16_t*)(ws + WS_WUKV), 0, P.in[7], tid);
    wtrans(tile, P.in[9], 1024, 1024, 1024, (bf16_t*)(ws + WS_WOMLA), 0, nullptr, tid);
    wtrans(tile, P.in[17], 1024, 1024, 1024, (bf16_t*)(ws + WS_WOHY), 0, nullptr, tid);
    wtrans(tile, P.in[18], 1024, 1024, 1024, (bf16_t*)(ws + WS_WOUT), 0, nullptr, tid);
    wtrans(tile, P.in[21], 5632, 1024, 5632, (bf16_t*)(ws + WS_WUP), 0, nullptr, tid);
    wtrans(tile, P.in[24], 1024, 2816, 1024, (bf16_t*)(ws + WS_WDOWN), 0, nullptr, tid);
    { bf16_t* W3B = (bf16_t*)(ws + WS_W3B); const float* w3 = P.in[15];
      for (int i = gtid; i < 4096 * 128; i += gthreads) { const int k = i >> 12, o = i & 4095; W3B[o * 128 + k] = f2bf(w3[(k & 63) * 4096 + o]); } }
    cvt_rows(P.in[0], (bf16_t*)(P.out + (size_t)1 * TC * 1024), (size_t)TC * 1024 / 8, gtid, gthreads);
    cvt_rows(P.in[1], (bf16_t*)(P.out + (size_t)2 * TC * 1024), (size_t)2 * TC * 1024 / 8, gtid, gthreads);
    { float* cosT = (float*)(ws + WS_COS); float* sinT = (float*)(ws + WS_SIN);
      for (int i = gtid; i < 16384 * 32; i += gthreads) { const int pos = i >> 5, k = i & 31; const float inv = powf(10000.0f, -(float)(2 * k) / 64.0f); const float ang = (float)pos * inv;
          cosT[i] = cosf(ang); sinT[i] = sinf(ang); } }
    { float* ssq = (float*)(ws + WS_SSQ); for (int i = gtid; i < 3 * TC * 2; i += gthreads) ssq[i] = 0.f; }
    { bf16_t* H2B = (bf16_t*)(ws + WS_H2B); const float *w1 = P.in[10], *b1 = P.in[11], *fq = P.in[12], *w2 = P.in[13], *b2 = P.in[14];
      const int wid = tid >> 6, lane = tid & 63; const float fr = fq[lane];
      for (int row = blockIdx.x * 8 + wid; row < 20480; row += gridDim.x * 8) {
          const int L = row < 4096 ? 4096 : 16384, m = row < 4096 ? row : row - 4096;
          const float t = (float)m / (float)(L - 1); const int kb = lane & 15;
          const float band = 1e-4f + (float)kb * ((15.0f - 1e-4f) / 15.0f); const float a0 = (6.283185307179586f * (float)m) / (float)L; const float ang = a0 * band;
          const float cv = cosf(ang), sv = -sinf(ang);
          float acc = b1[lane] + t * w1[lane];
#pragma unroll
          for (int k = 0; k < 16; ++k) { acc += __shfl(cv, k) * w1[(1 + k) * 64 + lane]; acc += __shfl(sv, k) * w1[(17 + k) * 64 + lane]; }
          const float h1 = sinf(fr * acc);
          float acc2 = b2[lane];
#pragma unroll 8
          for (int k = 0; k < 64; ++k) acc2 += __shfl(h1, k) * w2[k * 64 + lane];
          const float h2 = sinf(fr * acc2);
          const bf16_t hi = f2bf(h2); H2B[(size_t)row * 128 + lane] = hi; H2B[(size_t)row * 128 + 64 + lane] = f2bf(h2 - bf2f(hi));
      } }
}

__global__ void __launch_bounds__(512, 2) mega(Params P) {
    extern __shared__ __attribute__((aligned(16))) unsigned char smem[];
    cg::grid_group grid = cg::this_grid();
    PG8_LAS unsigned char* lds = (PG8_LAS unsigned char*)smem;
    unsigned char* ws = P.ws; const int lo = P.lo, hi = P.hi;
    const int gthreads = gridDim.x * 512;
    volatile LAS unsigned* xst = (volatile LAS unsigned*)(lds + LDS_FFT);
    if (threadIdx.x == 0) { xst[0] = 0u; xst[1] = 0u; }
    __syncthreads();
    XcdBarrier gbar = xcd_barrier_post((unsigned*)(ws + WS_BAR), xst);
    int ph = 0;
#if MK_MULTI
#define PH_BEGIN if (ph >= lo && ph < hi) { int tid = threadIdx.x; asm volatile("" : "+v"(tid)); const int gtid = blockIdx.x * 512 + tid;
#else
#define PH_BEGIN { int tid = threadIdx.x; asm volatile("" : "+v"(tid)); const int gtid = blockIdx.x * 512 + tid;
#endif
#if MK_MULTI
#define PH_END } ++ph; if (ph > lo && ph < hi) { if (ph == 1) grid.sync(); else xcd_barrier(gbar); }
#define PH_END_FIRST PH_END
#define PH_END_NOSYNC } ++ph;
#else
#define PH_END } xcd_barrier(gbar);
#define PH_END_FIRST } grid.sync();
#define PH_END_NOSYNC }
#endif
    const float* cosT = (const float*)(ws + WS_COS); const float* sinT = (const float*)(ws + WS_SIN);
    bf16_t* WIN = (bf16_t*)(ws + WS_WIN);
    PH_BEGIN
#if EN_PRO
 for (int rep = 0; rep < REP_PRO; ++rep) prologue(P, smem, tid);
#endif
 PH_END_FIRST
    for (int g = 0; g < 2; ++g) {
        const int L = g ? 16384 : 4096, Tg = g ? 2 * TC : TC, seqmask = L - 1;
        const bf16_t* xb = (const bf16_t*)(P.out + (size_t)(g ? 2 : 1) * TC * 1024);
        const bf16_t* H2 = (const bf16_t*)(ws + WS_H2B) + (g ? (size_t)4096 * 128 : 0);
        bf16_t* UT = (bf16_t*)(ws + WS_UT); bf16_t* FT = (bf16_t*)(ws + WS_FT); bf16_t* ZT = (bf16_t*)(ws + WS_ZT); bf16_t* Z = (bf16_t*)(ws + WS_Z);
        PH_BEGIN
            for (int rep = 0; rep < REP_G; ++rep) run_gemm<0>(lds, (const bf16_t*)(ws + WS_W3B), H2, 4096, L, 128, FFilt{FT, L});
            for (int rep = 0; rep < REP_G; ++rep) run_gemm<1>(lds, WIN + (size_t)2816 * 1024, xb, 3072, Tg, 1024, FBf{UT, (size_t)Tg});
        PH_END
        PH_BEGIN
            for (int rep = 0; rep < REP_HY; ++rep)
            for (int c = blockIdx.x; c < 1024; c += gridDim.x) {
                c2* KS = (c2*)(P.out + (size_t)(g ? 1 : 0) * TC * 1024) + (size_t)blockIdx.x * 32768; c2* YC = KS + 16384;
#if EN_HY14
                if (g) hy::hyena_item<14>((LAS c2*)smem, UT, Tg, FT, ZT, c, P.in[3], P.in[4], P.in[16], KS, YC, tid);
#endif
#if EN_HY12
                if (!g) hy::hyena_item<12>((LAS c2*)smem, UT, Tg, FT, ZT, c, P.in[3], P.in[4], P.in[16], KS, YC, tid);
#endif
            }
        PH_END
        for (int ck = 0; ck < (g ? 2 : 1); ++ck) {
            const int chunk = g ? 1 + ck : 0;
            const bf16_t* xbc = xb + (size_t)ck * TC * 1024;
            const float* xin = g ? P.in[1] + (size_t)ck * TC * 1024 : P.in[0];
            float* Y = P.out + (size_t)chunk * TC * 1024;
            float* ssq = (float*)(ws + WS_SSQ) + (size_t)chunk * TC * 2;
            bf16_t *CQ = (bf16_t*)(ws + WS_CQ), *CKV = (bf16_t*)(ws + WS_CKV), *KR = (bf16_t*)(ws + WS_KR), *G = (bf16_t*)(ws + WS_G), *Q = (bf16_t*)(ws + WS_Q), *KV = (bf16_t*)(ws + WS_KV),
                   *O = (bf16_t*)(ws + WS_O), *MG = (bf16_t*)(ws + WS_MG), *X1B = (bf16_t*)(ws + WS_X1B), *HM = (bf16_t*)(ws + WS_HM), *AB = (bf16_t*)(ws + WS_AB);
            PH_BEGIN
                if (ck == 0) transpose_z((LAS bf16_t*)smem, ZT, Z, Tg, tid);
                run_gemm<2>(lds, xbc, WIN, TC, 2816, 1024, FTm{CQ, CKV, KR, G, ssq, cosT, sinT, seqmask});
            PH_END
            PH_BEGIN
                for (int rep = 0; rep < REP_G; ++rep) run_gemm<3>(lds, CQ, (const bf16_t*)(ws + WS_WUQ), TC, 1536, 384, FQ{Q, ssq, cosT, sinT, seqmask});
                for (int rep = 0; rep < REP_G; ++rep) run_gemm<4>(lds, CKV, (const bf16_t*)(ws + WS_WUKV), TC, 2048, 256, FKV{KV, ssq});
            PH_END
            PH_BEGIN
                const int nqb = L / 256;
                for (int rep = 0; rep < REP_ATT; ++rep)
                for (int i = blockIdx.x; i < 512; i += gridDim.x) {
                    const int h = i & 7, combo = i >> 3, b = combo / nqb, qb = combo % nqb;
                    const size_t r0 = (size_t)b * L;
#if EN_ATT
                    att::attn_unit(Q + (r0 + (size_t)qb * 256) * 1536, KV + r0 * 2048 + h * 256, KV + r0 * 2048 + h * 256 + 128, KR + r0 * 64,
                                   O + (r0 + (size_t)qb * 256) * 1024 + h * 128, L, (char*)smem, h);
#endif
                }
            PH_END
            PH_BEGIN
                run_gemm<5>(lds, Z + (size_t)ck * TC * 1024, (const bf16_t*)(ws + WS_WOHY), TC, 1024, 1024, FM1{MG, G});
                run_gemm<6>(lds, O, (const bf16_t*)(ws + WS_WOMLA), TC, 1024, 1024, FM2{MG, G});
            PH_END
            PH_BEGIN
                for (int rep = 0; rep < REP_G; ++rep) run_gemm<7>(lds, MG, (const bf16_t*)(ws + WS_WOUT), TC, 1024, 1024, FOut{Y, xin});
            PH_END
            PH_BEGIN ln_rows(Y, P.in[19], P.in[20], X1B, TC, tid); PH_END
            PH_BEGIN
                for (int rep = 0; rep < REP_G; ++rep) run_gemm<8>(lds, X1B, (const bf16_t*)(ws + WS_WUP), TC, 5632, 1024, FBf{AB, (size_t)5632});
            PH_END
            PH_BEGIN for (int rep = 0; rep < REP_SM; ++rep) ffn_mid(AB, HM, P.in[22], P.in[23], seqmask, tid); PH_END
            PH_BEGIN
                run_gemm<9>(lds, HM, (const bf16_t*)(ws + WS_WDOWN), TC, 1024, 2816, FDown{Y});
            PH_END
            PH_BEGIN ln_rows(Y, P.in[25], P.in[26], nullptr, TC, tid); PH_END_NOSYNC
        }
    }
}
constexpr int N_PHASES = 1 + 2 * 2 + 3 * 10;

extern "C" void kernel_launch(void* const* d_in, const int* in_sizes, int n_in, void* d_out, int out_size, void* d_ws, size_t ws_size, hipStream_t stream) {
    static int grid = 0;
    if (grid == 0) {
        if (n_in != 27 || out_size != 3 * TC * 1024 || ws_size < WS_END) { fprintf(stderr, "kernel_launch: unexpected shapes: n_in %d out %d ws %zu\n", n_in, out_size, ws_size); grid = -1; return; }
        int dev = 0, cus = 0, per_cu = 0;
        hipGetDevice(&dev); hipDeviceGetAttribute(&cus, hipDeviceAttributeMultiprocessorCount, dev);
        if (hipFuncSetAttribute((const void*)mega, hipFuncAttributeMaxDynamicSharedMemorySize, LDS_BYTES) != hipSuccess) { fprintf(stderr, "kernel_launch: hipFuncSetAttribute failed\n"); grid = -1; return; }
        if (hipOccupancyMaxActiveBlocksPerMultiprocessor(&per_cu, (const void*)mega, 512, LDS_BYTES) != hipSuccess || per_cu < 1) { fprintf(stderr, "kernel_launch: occupancy query says %d\n", per_cu); per_cu = 1; }
        (void)hipGetLastError();
        grid = cus * per_cu;
    }
    if (grid < 0) return;
    if (hipMemsetAsync((char*)d_ws + WS_BAR, 0, XCD_BAR_WORDS * 4, stream) != hipSuccess) { fprintf(stderr, "kernel_launch: memset of barrier words failed\n"); return; }
    Params p{};
    for (int i = 0; i < 27; ++i) p.in[i] = (const float*)d_in[i];
    p.out = (float*)d_out; p.ws = (unsigned char*)d_ws;
#if MK_MULTI
    for (int i = 0; i < N_PHASES; ++i) { p.lo = i; p.hi = i + 1; hipLaunchKernelGGL(mega, dim3(grid), dim3(512), LDS_BYTES, stream, p); }
#else
    p.lo = 0; p.hi = N_PHASES;
    void* args[] = {&p};
    hipError_t e = hipLaunchCooperativeKernel((void*)mega, dim3(grid), dim3(512), args, LDS_BYTES, stream);
    if (e != hipSuccess) fprintf(stderr, "cooperative launch failed: %s (grid %d)\n", hipGetErrorString(e), grid);
#endif
}
```

```cpp
#include <hip/hip_runtime.h>
#include <hip/hip_cooperative_groups.h>
#include <cstdio>
#include <cstdint>
namespace cg = cooperative_groups;
namespace pg8 {
#define PG8_LAS __attribute__((address_space(3)))
typedef unsigned short bf16_t;
typedef short bf16x8 __attribute__((ext_vector_type(8)));
typedef float f32x4 __attribute__((ext_vector_type(4)));
typedef unsigned u32x4 __attribute__((ext_vector_type(4)));
constexpr int BM = 256, BK = 64, HALF = 128, HTB = HALF * BK * 2  , STAGE_BYTES = 8 * HTB, NXCD = 8, WGM = 8;

__host__ __device__ __forceinline__ int lds_byte(int r, int c) { const int st = (r >> 4) * 2 + (c >> 5), rr = r & 15, cc = c & 31, ob = rr * 64 + cc * 2; return st * 1024 + (ob ^ (((ob >> 9) & 1) << 5)); }
__host__ __device__ __forceinline__ void stage_rc(int b, int& R, int& C) { const int st = b / 1024, sb = b % 1024, swz = sb ^ (((sb >> 9) & 1) << 5); R = (st >> 1) * 16 + swz / 64; C = (st & 1) * 32 + (swz % 64) / 2; }
__host__ __device__ __forceinline__ int perm32(int rho) { const int n = rho >> 4, i = rho & 15; return 8 * (i >> 2) + 4 * n + (i & 3); }

struct Unit { int pm, pn; };
struct Gemm { const bf16_t* A; const bf16_t* Bt; int M, N, K; };

struct StaticOrder {
    int nM, nN, nwg, G, c;
    __host__ __device__ void init(int M, int N, int G_, int c_) { nM = M / BM; nN = N / BM; nwg = nM * nN; G = G_; c = c_; }
    __host__ __device__ bool next(int i, Unit& u) const {
        const long L = (long)i * G + c; if (L >= nwg) return false;
        int wgid = (int)L; { const int q = nwg / NXCD, r = nwg % NXCD, xcd = wgid % NXCD, off = wgid / NXCD; wgid = (xcd < r ? xcd * (q + 1) : r * (q + 1) + (xcd - r) * q) + off; }
        const int nig = WGM * nN, gid = wgid / nig, fm = gid * WGM, gsz = (nM - fm) < WGM ? (nM - fm) : WGM;
        u.pm = fm + ((wgid % nig) % gsz); u.pn = (wgid % nig) / gsz; return true;
    }
    __device__ __forceinline__ void a_ready(const Unit&) const {}
    __device__ __forceinline__ void done(const Unit&) const {}
};

__device__ __forceinline__ unsigned cvt_pk_bf16(float lo, float hi) { unsigned r; asm volatile("v_cvt_pk_bf16_f32 %0, %1, %2" : "=v"(r) : "v"(lo), "v"(hi)); return r; }
typedef float f32x2 __attribute__((ext_vector_type(2)));
__device__ __forceinline__ f32x2 gelu_pk(f32x2 v) {
    const f32x2 av = __builtin_elementwise_abs(v), d = av * 0.2316418882f + 1.0f;
    f32x2 t; t.x = __builtin_amdgcn_rcpf(d.x); t.y = __builtin_amdgcn_rcpf(d.y);
    f32x2 q = t * 0.5307027145f + (-0.7265760135f); q = q * t + 0.7107068705f; q = q * t + (-0.142248368f); q = q * t + 0.127414796f; q = q * t;
    const f32x2 s = (v * v) * (-0.72134752044f);
    f32x2 e; e.x = __builtin_amdgcn_exp2f(s.x); e.y = __builtin_amdgcn_exp2f(s.y);
    const f32x2 m = v * (q * e), r = v - m;
    f32x2 o; o.x = v.x < 0.f ? m.x : r.x; o.y = v.y < 0.f ? m.y : r.y; return o;
}
template <class Epi, class Sched, bool ALIGN_EPI = false, bool SP2 = false>
__device__ __forceinline__ void gemm_phase(PG8_LAS unsigned char* lds, const Gemm g, const Sched& S, const Epi& E) {
    int tid = threadIdx.x; asm volatile("" : "+v"(tid));
    const int wid = __builtin_amdgcn_readfirstlane(tid >> 6), lane = tid & 63, wr = wid >> 2, wc = wid & 3, fr = lane & 15, fq = lane >> 4;
    const int K = g.K, nt = K / BK;
    unsigned voffA[2], voffB[2];
#pragma unroll
    for (int i = 0; i < 2; ++i) { int R, C; stage_rc(tid * 16 + i * 8192, R, C); const int Rb = Epi::PERM ? ((R & ~31) + perm32(R & 31)) : R;
        voffA[i] = (unsigned)(R * K + C) * 2u; voffB[i] = (unsigned)(Rb * K + C) * 2u; }
    const size_t kstep = (size_t)(BK * 2);
    const size_t hstep = (size_t)HALF * K * 2;
    const size_t tstep = 2 * hstep;
    const unsigned ldsw = (unsigned)wid * 1024u;
    const int aoff = lds_byte(wr * 64 + fr, fq * 8), boff = lds_byte(wc * 32 + fr, fq * 8);
#define PG8_SA(b, h) (((b) * 2 + (h)) * HTB)
#define PG8_SB(b, h) ((4 + (b) * 2 + (h)) * HTB)
#define PG8_STAGE(bufoff, gbase, voff) do { _Pragma("unroll") for (int _i = 0; _i < 2; ++_i) \
        __builtin_amdgcn_global_load_lds((const unsigned*)((const char*)(gbase) + (voff)[_i]), (PG8_LAS unsigned*)(lds + (bufoff) + ldsw + _i * 8192), 16, 0, 0); } while (0)
#define PG8_LDA(dst, b, h) do { _Pragma("unroll") for (int m = 0; m < 4; ++m) _Pragma("unroll") for (int k = 0; k < 2; ++k) dst[m][k] = *(const PG8_LAS bf16x8*)(lds + PG8_SA(b, h) + aoff + m * 2048 + k * 1024); } while (0)
#define PG8_LDB(dst, b, h) do { _Pragma("unroll") for (int n = 0; n < 2; ++n) _Pragma("unroll") for (int k = 0; k < 2; ++k) dst[n][k] = *(const PG8_LAS bf16x8*)(lds + PG8_SB(b, h) + boff + n * 2048 + k * 1024); } while (0)
#define PG8_MMA(ai, bj, At, Bt) do { __builtin_amdgcn_s_setprio(1); _Pragma("unroll") for (int m = 0; m < 4; ++m) _Pragma("unroll") for (int n = 0; n < 2; ++n) _Pragma("unroll") for (int k = 0; k < 2; ++k) \
        acc[ai][bj][m][n] = __builtin_amdgcn_mfma_f32_16x16x32_bf16(Bt[n][k], At[m][k], acc[ai][bj][m][n], 0, 0, 0); __builtin_amdgcn_s_setprio(0); } while (0)
#define PG8_WAIT_V(n) asm volatile("s_waitcnt vmcnt(" #n ")" ::: "memory")
#define PG8_WAIT_L(n) asm volatile("s_waitcnt lgkmcnt(" #n ")" ::: "memory")
#define PG8_BAR __builtin_amdgcn_s_barrier()
#define PG8_SCHED __builtin_amdgcn_sched_barrier(0)
    Unit cur, nxt; int ui = 0;
    if (!S.next(0, cur)) return;
    f32x4 acc[2][2][4][2];
#pragma unroll
    for (int a = 0; a < 2; ++a)
#pragma unroll
        for (int b = 0; b < 2; ++b)
#pragma unroll
            for (int m = 0; m < 4; ++m)
#pragma unroll
                for (int n = 0; n < 2; ++n) acc[a][b][m][n] = (f32x4){0.f, 0.f, 0.f, 0.f};
    bf16x8 At[4][2], B0[2][2], B1[2][2];
    const char* cA = (const char*)g.A + (size_t)cur.pm * tstep; const char* cB = (const char*)g.Bt + (size_t)cur.pn * tstep;
    S.a_ready(cur);
    if constexpr (SP2) {
        PG8_STAGE(PG8_SB(0, 0), cB, voffB); PG8_STAGE(PG8_SB(0, 1), cB + hstep, voffB); PG8_STAGE(PG8_SA(0, 0), cA, voffA); PG8_STAGE(PG8_SA(0, 1), cA + hstep, voffA);
        if (wr == 1) PG8_BAR;
        PG8_WAIT_V(2); PG8_BAR;
        PG8_STAGE(PG8_SB(1, 0), cB + kstep, voffB); PG8_STAGE(PG8_SA(1, 0), cA + kstep, voffA); PG8_STAGE(PG8_SB(1, 1), cB + hstep + kstep, voffB);
        PG8_WAIT_V(6); PG8_BAR;
    } else {
        PG8_STAGE(PG8_SB(0, 0), cB, voffB); PG8_STAGE(PG8_SA(0, 0), cA, voffA); PG8_STAGE(PG8_SB(0, 1), cB + hstep, voffB); PG8_STAGE(PG8_SA(0, 1), cA + hstep, voffA);
        if (wr == 1) PG8_BAR;
        PG8_WAIT_V(4); PG8_BAR;
        PG8_STAGE(PG8_SB(1, 0), cB + kstep, voffB); PG8_STAGE(PG8_SA(1, 0), cA + kstep, voffA); PG8_STAGE(PG8_SB(1, 1), cB + hstep + kstep, voffB);
        PG8_WAIT_V(6); PG8_BAR;
    }
    for (;;) {
        const bool has_next = S.next(ui + 1, nxt);
        const char* nA = has_next ? (const char*)g.A + (size_t)nxt.pm * tstep : cA; const char* nB = has_next ? (const char*)g.Bt + (size_t)nxt.pn * tstep : cB;
        for (int t = 0; t < nt; t += 2) {
            const bool last = (t == nt - 2);
            const char* a1 = cA + (size_t)(t + 1) * kstep;
            const char* a2 = last ? nA : cA + (size_t)(t + 2) * kstep; const char* b2 = last ? nB : cB + (size_t)(t + 2) * kstep;
            const char* a3 = a2 + kstep; const char* b3 = b2 + kstep;
            if (last && has_next) S.a_ready(nxt);
            if constexpr (SP2) {
            PG8_LDB(B0, 0, 0); PG8_LDB(B1, 0, 1); PG8_SCHED; PG8_LDA(At, 0, 0); PG8_STAGE(PG8_SA(1, 1), a1 + hstep, voffA);
            PG8_WAIT_V(8); PG8_WAIT_L(0); PG8_BAR; PG8_MMA(0, 0, At, B0); PG8_MMA(0, 1, At, B1); PG8_BAR; PG8_SCHED;
            PG8_LDA(At, 0, 1); PG8_STAGE(PG8_SB(0, 0), b2, voffB); PG8_STAGE(PG8_SB(0, 1), b2 + hstep, voffB); PG8_STAGE(PG8_SA(0, 0), a2, voffA);
            PG8_WAIT_V(8); PG8_WAIT_L(0); PG8_BAR; PG8_MMA(1, 0, At, B0); PG8_MMA(1, 1, At, B1); PG8_BAR; PG8_SCHED;
            PG8_LDB(B0, 1, 0); PG8_LDB(B1, 1, 1); PG8_SCHED; PG8_LDA(At, 1, 0); PG8_STAGE(PG8_SA(0, 1), a2 + hstep, voffA);
            PG8_WAIT_V(8); PG8_WAIT_L(0); PG8_BAR; PG8_MMA(0, 0, At, B0); PG8_MMA(0, 1, At, B1); PG8_BAR; PG8_SCHED;
            PG8_LDA(At, 1, 1); PG8_STAGE(PG8_SB(1, 0), b3, voffB); PG8_STAGE(PG8_SB(1, 1), b3 + hstep, voffB); PG8_STAGE(PG8_SA(1, 0), a3, voffA);
            PG8_WAIT_V(8); PG8_WAIT_L(0); PG8_BAR; PG8_MMA(1, 0, At, B0); PG8_MMA(1, 1, At, B1); PG8_BAR; PG8_SCHED;
            } else {
            PG8_LDB(B0, 0, 0); PG8_SCHED; PG8_LDA(At, 0, 0); PG8_STAGE(PG8_SA(1, 1), a1 + hstep, voffA);
            PG8_WAIT_L(8); PG8_BAR; PG8_WAIT_L(0); PG8_MMA(0, 0, At, B0); PG8_BAR; PG8_SCHED;
            PG8_LDB(B1, 0, 1); PG8_STAGE(PG8_SB(0, 0), b2, voffB);
            PG8_BAR; PG8_WAIT_L(0); PG8_MMA(0, 1, At, B1); PG8_BAR;
            PG8_LDA(At, 0, 1); PG8_STAGE(PG8_SA(0, 0), a2, voffA);
            PG8_BAR; PG8_WAIT_L(0); PG8_MMA(1, 0, At, B0); PG8_BAR; PG8_SCHED;
            PG8_STAGE(PG8_SB(0, 1), b2 + hstep, voffB);
            PG8_WAIT_V(6); PG8_BAR; PG8_MMA(1, 1, At, B1); PG8_BAR;
            PG8_LDB(B0, 1, 0); PG8_SCHED; PG8_LDA(At, 1, 0); PG8_STAGE(PG8_SA(0, 1), a2 + hstep, voffA);
            PG8_WAIT_L(8); PG8_BAR; PG8_WAIT_L(0); PG8_MMA(0, 0, At, B0); PG8_BAR; PG8_SCHED;
            PG8_LDB(B1, 1, 1); PG8_STAGE(PG8_SB(1, 0), b3, voffB);
            PG8_BAR; PG8_WAIT_L(0); PG8_MMA(0, 1, At, B1); PG8_BAR;
            PG8_LDA(At, 1, 1); PG8_STAGE(PG8_SA(1, 0), a3, voffA);
            PG8_BAR; PG8_WAIT_L(0); PG8_MMA(1, 0, At, B0); PG8_BAR; PG8_SCHED;
            PG8_STAGE(PG8_SB(1, 1), b3 + hstep, voffB);
            PG8_WAIT_V(6); PG8_BAR; PG8_MMA(1, 1, At, B1); PG8_BAR;
            }
        }
        if constexpr (ALIGN_EPI) { if (wr == 0) PG8_BAR; }
        if constexpr (!Epi::AFTER_DRAIN) { E(acc, cur, wr, wc, fr, fq); S.done(cur); }
        if (!has_next) break;
#pragma unroll
        for (int a = 0; a < 2; ++a)
#pragma unroll
            for (int b = 0; b < 2; ++b)
#pragma unroll
                for (int m = 0; m < 4; ++m)
#pragma unroll
                    for (int n = 0; n < 2; ++n) acc[a][b][m][n] = (f32x4){0.f, 0.f, 0.f, 0.f};
        cur = nxt; cA = nA; cB = nB; ++ui;
        if constexpr (ALIGN_EPI) { if (wr == 1) PG8_BAR; }
    }
    PG8_WAIT_V(0);
    if constexpr (!ALIGN_EPI) { if (wr == 0) PG8_BAR; }
    PG8_BAR;
    if constexpr (Epi::AFTER_DRAIN) { E.fused(acc, cur, wr, wc, fr, fq, lds, wid, lane); S.done(cur); }
#undef PG8_SA
#undef PG8_SB
#undef PG8_STAGE
#undef PG8_LDA
#undef PG8_LDB
#undef PG8_MMA
#undef PG8_WAIT_V
#undef PG8_WAIT_L
#undef PG8_BAR
#undef PG8_SCHED
}
}

#ifndef EN_PRO
#define EN_PRO 1
#endif
#ifndef EN_HY14
#define EN_HY14 1
#endif
#ifndef EN_HY12
#define EN_HY12 1
#endif
#ifndef EN_ATT
#define EN_ATT 1
#endif
#ifndef EN_GEMM
#define EN_GEMM 0xffff
#endif
#ifndef EPI_FENCE
#define EPI_FENCE 1
#endif
#ifndef G_ALIGN
#define G_ALIGN true
#endif
#ifndef G_SP2
#define G_SP2 true
#endif
#ifndef REP_ATT
#define REP_ATT 1
#endif
#ifndef REP_HY
#define REP_HY 1
#endif
#ifndef REP_G
#define REP_G 1
#endif
#ifndef REP_SM
#define REP_SM 1
#endif
#ifndef REP_PRO
#define REP_PRO 1
#endif
#ifndef UNR_K
#define UNR_K 8
#endif
#ifndef UNR_Z
#define UNR_Z 8
#endif
#ifndef UNR_Y
#define UNR_Y 8
#endif
#ifndef UNR_F
#define UNR_F 4
#endif
#ifndef MK_MULTI
#define MK_MULTI 0
#endif
#define LAS __attribute__((address_space(3)))
#define XB_TMO      128
#define XB_XCNT(j)  (256  + 64 * (j))
#define XB_XSUB(j)  (1280 + 64 * (j))
#define XB_XGEN(j)  (2304 + 64 * (j))
#define XB_TOP      3328
#define XB_TOPGEN   3392
#define XCD_BAR_WORDS 3456
#define XB_SPIN_CAP (1u << 18)
__device__ __forceinline__ unsigned xb_ld(unsigned* p)              { return __hip_atomic_load(p, __ATOMIC_RELAXED, __HIP_MEMORY_SCOPE_AGENT); }
__device__ __forceinline__ unsigned xb_add(unsigned* p, unsigned v) { return __hip_atomic_fetch_add(p, v, __ATOMIC_RELAXED, __HIP_MEMORY_SCOPE_AGENT); }
__device__ __forceinline__ unsigned xb_xcc_id() { return (unsigned)__builtin_amdgcn_s_getreg((3 << 11) | 20) & 0xFu; }
#define XB_SPIN(cond, bar) do { unsigned _sp = 0; while (cond) { __builtin_amdgcn_s_sleep(1); \
    if ((++_sp & 255u) == 0u) { if (xb_ld(&(bar)[XB_TMO])) break; if (_sp > XB_SPIN_CAP) { atomicAdd(&(bar)[XB_TMO], 1u); break; } } } } while (0)

struct XcdBarrier {
    unsigned* bar; unsigned x;
    volatile LAS unsigned* st;
};

__device__ __forceinline__ XcdBarrier xcd_barrier_post(unsigned* bar, volatile LAS unsigned* st) {
    XcdBarrier b; b.bar = bar; b.x = xb_xcc_id(); b.st = st;
    if (threadIdx.x == 0) (void)xb_add(&bar[XB_XCNT(b.x)], 1u);
    return b;
}
__device__ __forceinline__ void xcd_barrier_complete(unsigned* bar, unsigned x, unsigned& nloc, unsigned& nx) {
    const unsigned G = gridDim.x * gridDim.y * gridDim.z;
    unsigned sum, cnt, mine, sp = 0u;
    for (;;) {
        sum = 0u; cnt = 0u; mine = 0u;
#pragma unroll
        for (unsigned j = 0; j < 16; ++j) { const unsigned c = xb_ld(&bar[XB_XCNT(j)]); sum += c; cnt += (c > 0u) ? 1u : 0u; mine = (j == x) ? c : mine; }
        if (sum == G) break;
        __builtin_amdgcn_s_sleep(1);
        if ((++sp & 255u) == 0u) { if (xb_ld(&bar[XB_TMO])) break; if (sp > XB_SPIN_CAP) { atomicAdd(&bar[XB_TMO], 1u); break; } }
    }
    nloc = mine > 0u ? mine : 1u; nx = cnt > 0u ? cnt : 1u;
}

__device__ __forceinline__ void xcd_barrier(const XcdBarrier& b) {
    asm volatile("s_waitcnt vmcnt(0)" ::: "memory");
    __syncthreads();
    if (threadIdx.x == 0) {
        unsigned* bar = b.bar;
        __builtin_amdgcn_s_waitcnt(0);
        unsigned nloc = b.st[0], nx = b.st[1];
        if (nloc == 0u) { xcd_barrier_complete(bar, b.x, nloc, nx); b.st[0] = nloc; b.st[1] = nx; }
        const unsigned old = xb_add(&bar[XB_XSUB(b.x)], 1u);
        const unsigned gen = old / nloc;
        if (old + 1u == (gen + 1u) * nloc) {
            __builtin_amdgcn_fence(__ATOMIC_RELEASE, "agent");
            asm volatile("s_waitcnt vmcnt(0)" ::: "memory");
            const unsigned og = xb_add(&bar[XB_TOP], 1u);
            const unsigned tg = og / nx;
            if (og + 1u == (tg + 1u) * nx) xb_add(&bar[XB_TOPGEN], 1u);
            else XB_SPIN(xb_ld(&bar[XB_TOPGEN]) == tg, bar);
            __builtin_amdgcn_fence(__ATOMIC_ACQUIRE, "agent");
            xb_add(&bar[XB_XGEN(b.x)], 1u);
            asm volatile("s_waitcnt vmcnt(0)" ::: "memory");
        } else {
            XB_SPIN(xb_ld(&bar[XB_XGEN(b.x)]) == gen, bar);
            __builtin_amdgcn_fence(__ATOMIC_ACQUIRE, "agent");
            asm volatile("s_waitcnt vmcnt(0)" ::: "memory");
        }
    }
    __syncthreads();
}

using pg8::bf16_t; using pg8::f32x4; using pg8::u32x4; using pg8::Unit;
typedef float c2 __attribute__((ext_vector_type(2)));

constexpr int TC = 16384;
constexpr int LDS_FFT = 139264;
constexpr int LDS_BYTES = LDS_FFT + 16;
constexpr float DN_ALPHA = 1.189207115002721f, LN_EPS = 1e-5f, RMS_EPS = 1e-6f;
constexpr size_t MiB = 1u << 20;
constexpr size_t WS_WIN = 0, WS_WUQ = 12 * MiB, WS_WUKV = 14 * MiB, WS_WOMLA = 15 * MiB, WS_WOHY = 17 * MiB, WS_WOUT = 19 * MiB, WS_WUP = 21 * MiB,
                 WS_WDOWN = 32 * MiB, WS_W3B = 38 * MiB, WS_COS = 40 * MiB, WS_SIN = 42 * MiB, WS_H2B = 44 * MiB, WS_SSQ = 50 * MiB, WS_BAR = 51 * MiB, WS_Z = 52 * MiB,
                 WS_UT = 116 * MiB, WS_FT = 308 * MiB, WS_ZT = 436 * MiB,
                 WS_CQ = 116 * MiB, WS_CKV = 128 * MiB, WS_KR = 136 * MiB, WS_G = 138 * MiB, WS_Q = 202 * MiB, WS_KV = 250 * MiB, WS_O = 314 * MiB,
                 WS_MG = 346 * MiB, WS_X1B = 378 * MiB, WS_HM = 410 * MiB, WS_AB = 116 * MiB, WS_END = 512 * MiB;

__device__ __forceinline__ float bflo(unsigned w) { return __uint_as_float(w << 16); }
__device__ __forceinline__ float bfhi(unsigned w) { return __uint_as_float(w & 0xffff0000u); }
__device__ __forceinline__ float bf2f(bf16_t v) { return __uint_as_float(((unsigned)v) << 16); }
__device__ __forceinline__ unsigned pk(float lo, float hi) { return pg8::cvt_pk_bf16(lo, hi); }
__device__ __forceinline__ bf16_t f2bf(float v) { return (bf16_t)(pk(v, 0.f) & 0xffffu); }
__device__ __forceinline__ void st8(bf16_t* p, f32x4 a, f32x4 b) { u32x4 w; w.x = pk(a[0], a[1]); w.y = pk(a[2], a[3]); w.z = pk(b[0], b[1]); w.w = pk(b[2], b[3]); *(u32x4*)p = w; }
__device__ __forceinline__ void ld8(const bf16_t* p, f32x4& a, f32x4& b) { const u32x4 w = *(const u32x4*)p;
    a[0] = bflo(w.x); a[1] = bfhi(w.x); a[2] = bflo(w.y); a[3] = bfhi(w.y); b[0] = bflo(w.z); b[1] = bfhi(w.z); b[2] = bflo(w.w); b[3] = bfhi(w.w); }

__device__ __forceinline__ void unp8(u32x4 w, f32x4& a, f32x4& b) { a[0] = bflo(w.x); a[1] = bfhi(w.x); a[2] = bflo(w.y); a[3] = bfhi(w.y); b[0] = bflo(w.z); b[1] = bfhi(w.z); b[2] = bflo(w.w); b[3] = bfhi(w.w); }
template <class F> struct Epi8 {
    static constexpr bool PERM = true, AFTER_DRAIN = false;
    F f;
    __device__ __forceinline__ void operator()(const f32x4 (&acc)[2][2][4][2], const Unit& u, int wr, int wc, int fr, int fq) const {
        const int row0 = u.pm * pg8::BM + wr * 64 + fr, col0 = u.pn * pg8::BM + wc * 32 + 8 * fq;
        if constexpr (F::HAS_LD) {
#pragma unroll
            for (int ai = 0; ai < 2; ++ai)
#pragma unroll
                for (int mh = 0; mh < 2; ++mh) {
                    typename F::LD l[2][2];
#pragma unroll
                    for (int mm = 0; mm < 2; ++mm)
#pragma unroll
                        for (int bj = 0; bj < 2; ++bj) l[mm][bj] = f.ld(row0 + ai * pg8::HALF + (2 * mh + mm) * 16, col0 + bj * pg8::HALF);
#pragma unroll
                    for (int mm = 0; mm < 2; ++mm)
#pragma unroll
                        for (int bj = 0; bj < 2; ++bj) f.st(row0 + ai * pg8::HALF + (2 * mh + mm) * 16, col0 + bj * pg8::HALF, acc[ai][bj][2 * mh + mm][0], acc[ai][bj][2 * mh + mm][1], l[mm][bj]);
                    asm volatile("" ::: "memory");
                }
        } else {
#pragma unroll
            for (int ai = 0; ai < 2; ++ai)
#pragma unroll
                for (int m = 0; m < 4; ++m)
#pragma unroll
                    for (int bj = 0; bj < 2; ++bj) { f(row0 + ai * pg8::HALF + m * 16, col0 + bj * pg8::HALF, acc[ai][bj][m][0], acc[ai][bj][m][1], fq);
                      if (EPI_FENCE) asm volatile("" ::: "memory"); }
        }
    }
};
__device__ __forceinline__ void rope8(f32x4& a, f32x4& b, const float* cosT, const float* sinT, int pos, int i0) {
    const f32x4 c = *(const f32x4*)(cosT + pos * 32 + i0), s = *(const f32x4*)(sinT + pos * 32 + i0);
    f32x4 oa, ob;
    oa[0] = a[0] * c[0] - a[1] * s[0]; oa[1] = a[0] * s[0] + a[1] * c[0]; oa[2] = a[2] * c[1] - a[3] * s[1]; oa[3] = a[2] * s[1] + a[3] * c[1];
    ob[0] = b[0] * c[2] - b[1] * s[2]; ob[1] = b[0] * s[2] + b[1] * c[2]; ob[2] = b[2] * c[3] - b[3] * s[3]; ob[3] = b[2] * s[3] + b[3] * c[3];
    a = oa; b = ob;
}
__device__ __forceinline__ float sigm(float x) { return 1.0f / (1.0f + __expf(-x)); }
struct FTm { static constexpr bool HAS_LD = false; bf16_t *CQ, *CKV, *KR, *G; float* ssq; const float *cosT, *sinT; int seqmask;
    __device__ __forceinline__ void operator()(int row, int col, f32x4 a, f32x4 b, int fq) const {
        if (col < 640) {
            float s = (a[0] * a[0] + a[1] * a[1]) + (a[2] * a[2] + a[3] * a[3]) + (b[0] * b[0] + b[1] * b[1]) + (b[2] * b[2] + b[3] * b[3]);
            s += __shfl_xor(s, 16); s += __shfl_xor(s, 32);
            if (col < 384) { st8(CQ + (size_t)row * 384 + col, a, b); if (fq == 0) __hip_atomic_fetch_add(ssq + row * 2, s, __ATOMIC_RELAXED, __HIP_MEMORY_SCOPE_AGENT); }
            else { st8(CKV + (size_t)row * 256 + (col - 384), a, b); if (fq == 0) __hip_atomic_fetch_add(ssq + row * 2 + 1, s, __ATOMIC_RELAXED, __HIP_MEMORY_SCOPE_AGENT); }
        } else if (col < 704) {
            const int j = col - 640; rope8(a, b, cosT, sinT, row & seqmask, j >> 1); st8(KR + (size_t)row * 64 + j, a, b);
        } else if (col < 2752) {
#pragma unroll
            for (int i = 0; i < 4; ++i) { a[i] = sigm(a[i]); b[i] = sigm(b[i]); }
            st8(G + (size_t)row * 2048 + (col - 704), a, b);
        }
    }
};
struct FQ { static constexpr bool HAS_LD = true; typedef float LD; bf16_t* Q; const float* ssq; const float *cosT, *sinT; int seqmask;
    __device__ __forceinline__ LD ld(int row, int) const { return ssq[row * 2]; }
    __device__ __forceinline__ void st(int row, int col, f32x4 a, f32x4 b, LD sq) const {
        const float rs = rsqrtf(sq * (1.0f / 384.0f) + RMS_EPS); a = a * rs; b = b * rs;
        if (col >= 1024) rope8(a, b, cosT, sinT, row & seqmask, ((col - 1024) & 63) >> 1);
        st8(Q + (size_t)row * 1536 + col, a, b);
    }
};
struct FKV { static constexpr bool HAS_LD = true; typedef float LD; bf16_t* KV; const float* ssq;
    __device__ __forceinline__ LD ld(int row, int) const { return ssq[row * 2 + 1]; }
    __device__ __forceinline__ void st(int row, int col, f32x4 a, f32x4 b, LD sq) const {
        const float rs = rsqrtf(sq * (1.0f / 256.0f) + RMS_EPS); st8(KV + (size_t)row * 2048 + col, a * rs, b * rs);
    }
};
struct FBf { static constexpr bool HAS_LD = false; bf16_t* O; size_t ld;
    __device__ __forceinline__ void operator()(int row, int col, f32x4 a, f32x4 b, int) const { st8(O + (size_t)row * ld + col, a, b); }
};
struct FFilt { static constexpr bool HAS_LD = false; bf16_t* FT; int L;
    __device__ __forceinline__ void operator()(int row, int col, f32x4 a, f32x4 b, int) const {
        const int c = row & 1023; const float MIN_DECAY = -3.0701134573253944f, MAX_DECAY = -15.350567286626973f;
        const float kk = -1.4426950408889634f * fabsf(MIN_DECAY + (MAX_DECAY - MIN_DECAY) * ((float)c * (1.0f / 1023.0f))) / (float)(L - 1); const float fc = (float)col;
#pragma unroll
        for (int i = 0; i < 4; ++i) { a[i] *= __builtin_amdgcn_exp2f((fc + (float)i) * kk) + 0.05f; b[i] *= __builtin_amdgcn_exp2f((fc + (float)(4 + i)) * kk) + 0.05f; }
        st8(FT + (size_t)row * L + col, a, b);
    }
};
struct FM1 { static constexpr bool HAS_LD = true; typedef u32x4 LD; bf16_t* MG; const bf16_t* G;
    __device__ __forceinline__ LD ld(int row, int col) const { return *(const u32x4*)(G + (size_t)row * 2048 + col); }
    __device__ __forceinline__ void st(int row, int col, f32x4 a, f32x4 b, LD g) const { f32x4 ga, gb; unp8(g, ga, gb); st8(MG + (size_t)row * 1024 + col, a * ga, b * gb); }
};
struct LD2 { u32x4 g, p; };
struct FM2 { static constexpr bool HAS_LD = true; typedef LD2 LD; bf16_t* MG; const bf16_t* G;
    __device__ __forceinline__ LD ld(int row, int col) const { LD2 l; l.g = *(const u32x4*)(G + (size_t)row * 2048 + 1024 + col); l.p = *(const u32x4*)(MG + (size_t)row * 1024 + col); return l; }
    __device__ __forceinline__ void st(int row, int col, f32x4 a, f32x4 b, LD l) const { f32x4 ga, gb, pa, pb; unp8(l.g, ga, gb); unp8(l.p, pa, pb); st8(MG + (size_t)row * 1024 + col, pa + a * ga, pb + b * gb); }
};
struct LDF { f32x4 a, b; };
struct FOut { static constexpr bool HAS_LD = true; typedef LDF LD; float* Y; const float* X;
    __device__ __forceinline__ LD ld(int row, int col) const { const size_t o = (size_t)row * 1024 + col; LDF l; l.a = *(const f32x4*)(X + o); l.b = *(const f32x4*)(X + o + 4); return l; }
    __device__ __forceinline__ void st(int row, int col, f32x4 a, f32x4 b, LD l) const { const size_t o = (size_t)row * 1024 + col; *(f32x4*)(Y + o) = l.a * DN_ALPHA + a; *(f32x4*)(Y + o + 4) = l.b * DN_ALPHA + b; }
};
struct FDown { static constexpr bool HAS_LD = true; typedef LDF LD; float* Y;
    __device__ __forceinline__ LD ld(int row, int col) const { const size_t o = (size_t)row * 1024 + col; LDF l; l.a = *(const f32x4*)(Y + o); l.b = *(const f32x4*)(Y + o + 4); return l; }
    __device__ __forceinline__ void st(int row, int col, f32x4 a, f32x4 b, LD l) const { const size_t o = (size_t)row * 1024 + col; *(f32x4*)(Y + o) = l.a * DN_ALPHA + a; *(f32x4*)(Y + o + 4) = l.b * DN_ALPHA + b; }
};
template <int ID, class F> __device__ __forceinline__ void run_gemm(PG8_LAS unsigned char* lds, const bf16_t* A, const bf16_t* Bt, int M, int N, int K, const F& f) {
  if constexpr ((EN_GEMM >> ID) & 1) {
    asm volatile("" : "+s"(M), "+s"(N), "+s"(K));
    pg8::Gemm g{A, Bt, M, N, K}; pg8::StaticOrder S; S.init(M, N, (int)gridDim.x, (int)blockIdx.x);
    Epi8<F> E{f};
    pg8::gemm_phase<Epi8<F>, pg8::StaticOrder, G_ALIGN, (ID != 0 && ID != 3)>(lds, g, S, E);
  }
}

namespace att {
typedef short bf16x8 __attribute__((ext_vector_type(8)));
typedef short s16x4 __attribute__((ext_vector_type(4)));
typedef float f32x16 __attribute__((ext_vector_type(16)));
constexpr int NW = 8, QBLK = 32, KVBLK = 64, LDQ = 1536, LDK = 2048, LDKR = 64, LDO = 1024;
constexpr float SCALE = 0.07216878364870323f, THR = 8.f;
constexpr int SHM_V = 16384, SHM_K = 24576;
#define AKSWZ(row, colB) ((row) * 384 + ((colB) ^ (((row) & 7) << 4)))
#define SBAR() __builtin_amdgcn_sched_barrier(0)
__device__ __forceinline__ int crow(int r, int hi) { return (r & 3) + 8 * (r >> 2) + 4 * hi; }
__device__ __forceinline__ void partialSM(f32x16& p0, f32x16& p1, float& m_reg, float& mn, float& alpha) {
  constexpr float C = SCALE * 1.4426950408889634f;
  float pmax = p0[0]; for (int r = 1; r < 16; ++r) pmax = fmaxf(pmax, p0[r]); for (int r = 0; r < 16; ++r) pmax = fmaxf(pmax, p1[r]);
  { auto rr = __builtin_amdgcn_permlane32_swap(__float_as_uint(pmax), __float_as_uint(pmax), false, false);
    pmax = fmaxf(__uint_as_float(rr[0]), __uint_as_float(rr[1])); }
  if (__builtin_expect(__all(pmax - m_reg <= THR / SCALE), 1)) { mn = m_reg; alpha = 1.f; }
  else { mn = fmaxf(m_reg, pmax); alpha = __builtin_amdgcn_exp2f((m_reg - mn) * C); m_reg = mn; }
  float mnC = -mn * C;
  for (int r = 0; r < 16; ++r) p0[r] = fmaf(p0[r], C, mnC); for (int r = 0; r < 16; ++r) p1[r] = fmaf(p1[r], C, mnC);
  for (int r = 0; r < 16; ++r) p0[r] = __builtin_amdgcn_exp2f(p0[r]);
}
__device__ __forceinline__ void finishSM(f32x16& p0, f32x16& p1, float alpha, float& l_reg, bf16x8& pa0, bf16x8& pa1, bf16x8& pa2, bf16x8& pa3) {
  for (int r = 0; r < 16; ++r) p1[r] = __builtin_amdgcn_exp2f(p1[r]);
  float ps = 0; for (int r = 0; r < 16; ++r) ps += p0[r]; for (int r = 0; r < 16; ++r) ps += p1[r];
  { auto rr = __builtin_amdgcn_permlane32_swap(__float_as_uint(ps), __float_as_uint(ps), false, false);
    ps = __uint_as_float(rr[0]) + __uint_as_float(rr[1]); }
  l_reg = l_reg * alpha + ps;
#define PK4(P, BASE, OUT) do { unsigned a0 = pk(P[BASE + 0], P[BASE + 1]), a1 = pk(P[BASE + 2], P[BASE + 3]);   \
    unsigned b0 = pk(P[BASE + 4], P[BASE + 5]), b1 = pk(P[BASE + 6], P[BASE + 7]);                              \
    auto r0 = __builtin_amdgcn_permlane32_swap(a0, b0, false, false); auto r1 = __builtin_amdgcn_permlane32_swap(a1, b1, false, false); \
    u32x4 w = {r0[0], r1[0], r0[1], r1[1]}; OUT = *reinterpret_cast<bf16x8*>(&w); } while (0)
  PK4(p0, 0, pa0); PK4(p0, 8, pa1); PK4(p1, 0, pa2); PK4(p1, 8, pa3);
#undef PK4
}
__device__ __forceinline__ void qkt(f32x16& p0, f32x16& p1, const char* Ks, const bf16x8* qr, const bf16x8* qrl, int r32, int hi) {
  p0 = f32x16{}; p1 = f32x16{};
  int kb[4];
#pragma unroll
  for (int dl = 0; dl < 4; ++dl) kb[dl] = r32 * 384 + ((dl * 32 + hi * 16) ^ ((r32 & 7) << 4));
#pragma unroll
  for (int d0 = 0; d0 < 12; ++d0) {
    bf16x8 b0 = *reinterpret_cast<const bf16x8*>(Ks + kb[d0 & 3] + (d0 >> 2) * 128);
    bf16x8 b1 = *reinterpret_cast<const bf16x8*>(Ks + kb[d0 & 3] + (d0 >> 2) * 128 + 32 * 384);
    const bf16x8 qv = (d0 < 8) ? qr[d0 & 7] : qrl[(d0 - 8) * 64];
    p0 = __builtin_amdgcn_mfma_f32_32x32x16_bf16(b0, qv, p0, 0, 0, 0);
    p1 = __builtin_amdgcn_mfma_f32_32x32x16_bf16(b1, qv, p1, 0, 0, 0); }
}
__device__ __forceinline__ int v_st(int k, int c) { const int kk = (k & ~0xC) | ((k & 4) << 1) | ((k & 8) >> 1); return ((kk >> 3) * 4 + (c >> 5)) * 512 + ((kk & 7) * 32 + (c & 31)) * 2; }
__device__ __forceinline__ int v_rd_base(int lane) { return ((lane & 3) << 3) | (((lane >> 2) & 3) << 6) | (((lane >> 4) & 1) << 5) | (((lane >> 5) & 1) << 8); }
constexpr int v_rd_off(int d0, int ks, int half) { return d0 * 512 + ks * 4096 + half * 2048; }
template <int OFF> __device__ __forceinline__ s16x4 tr_read(int vb) {
  s16x4 r; asm volatile("ds_read_b64_tr_b16 %0, %1 offset:%2" : "=&v"(r) : "v"(vb), "i"(OFF) : "memory"); return r;
}
template <int D0> __device__ __forceinline__ void pv_one(f32x16& od, int vb, bf16x8 pa0, bf16x8 pa1, bf16x8 pa2, bf16x8 pa3) {
  const s16x4 l0 = tr_read<v_rd_off(D0, 0, 0)>(vb), h0 = tr_read<v_rd_off(D0, 0, 1)>(vb), l1 = tr_read<v_rd_off(D0, 1, 0)>(vb), h1 = tr_read<v_rd_off(D0, 1, 1)>(vb);
  const s16x4 l2 = tr_read<v_rd_off(D0, 2, 0)>(vb), h2 = tr_read<v_rd_off(D0, 2, 1)>(vb), l3 = tr_read<v_rd_off(D0, 3, 0)>(vb), h3 = tr_read<v_rd_off(D0, 3, 1)>(vb);
  asm volatile("s_waitcnt lgkmcnt(0)" ::: "memory"); SBAR();
#define PKV(L, H) (bf16x8){L[0], L[1], L[2], L[3], H[0], H[1], H[2], H[3]}
  od = __builtin_amdgcn_mfma_f32_32x32x16_bf16(pa0, PKV(l0, h0), od, 0, 0, 0);
  od = __builtin_amdgcn_mfma_f32_32x32x16_bf16(pa1, PKV(l1, h1), od, 0, 0, 0);
  od = __builtin_amdgcn_mfma_f32_32x32x16_bf16(pa2, PKV(l2, h2), od, 0, 0, 0);
  od = __builtin_amdgcn_mfma_f32_32x32x16_bf16(pa3, PKV(l3, h3), od, 0, 0, 0);
#undef PKV
}
__device__ __forceinline__ void pv_d0(f32x16* o, int vb, bf16x8 pa0, bf16x8 pa1, bf16x8 pa2, bf16x8 pa3) {
  pv_one<0>(o[0], vb, pa0, pa1, pa2, pa3); pv_one<1>(o[1], vb, pa0, pa1, pa2, pa3); pv_one<2>(o[2], vb, pa0, pa1, pa2, pa3); pv_one<3>(o[3], vb, pa0, pa1, pa2, pa3);
}
__device__ __forceinline__ void attn_unit(const bf16_t* __restrict__ Qb, const bf16_t* __restrict__ Kh, const bf16_t* __restrict__ Vh, const bf16_t* __restrict__ KRb,
                                          bf16_t* __restrict__ Ob, int seq, char* lds, int h) {
  int tid = threadIdx.x; asm volatile("" : "+v"(tid));
  const int wid = tid >> 6, lane = tid & 63, r32 = lane & 31, hi = lane >> 5;
  char* V_lds = lds; char* K_lds = lds + 2 * SHM_V;
  float* ws = (float*)(lds + 2 * SHM_V + 2 * SHM_K) + wid * 64; float* li_l = ws; float* al_l = ws + 32;
  float m_reg = -1e30f, l_reg = 0; f32x16 o[4] = {}; bf16x8 qr[8];
  bf16x8* qrl = (bf16x8*)(lds + 2 * SHM_V + 2 * SHM_K + 2048) + wid * 256 + lane;
  const bf16_t* Qw = Qb + (long)(wid * QBLK + r32) * LDQ + hi * 8 + h * 128;
  const bf16_t* Qwr = Qb + (long)(wid * QBLK + r32) * LDQ + hi * 8 + 1024 + h * 64;
#pragma unroll
  for (int d0 = 0; d0 < 8; ++d0) qr[d0] = *reinterpret_cast<const bf16x8*>(Qw + d0 * 16);
#pragma unroll
  for (int d0 = 8; d0 < 12; ++d0) qrl[(d0 - 8) * 64] = *reinterpret_cast<const bf16x8*>(Qwr + (d0 - 8) * 16);
  const int sr = tid >> 4, sc = (tid & 15) * 8, vst0 = v_st(sr, sc), vst1 = v_st(32 + sr, sc);
  const int rr = tid >> 3, rc = (tid & 7) * 8;
  const int vb0 = (int)(uintptr_t)V_lds + v_rd_base(lane);
  bf16x8 vs0, vs1, ks0, ks1, kr0;
#define SLOAD(k0) do { vs0 = *reinterpret_cast<const bf16x8*>(&Vh[(long)((k0) + sr) * LDK + sc]); vs1 = *reinterpret_cast<const bf16x8*>(&Vh[(long)((k0) + 32 + sr) * LDK + sc]); \
    ks0 = *reinterpret_cast<const bf16x8*>(&Kh[(long)((k0) + sr) * LDK + sc]); ks1 = *reinterpret_cast<const bf16x8*>(&Kh[(long)((k0) + 32 + sr) * LDK + sc]); \
    kr0 = *reinterpret_cast<const bf16x8*>(&KRb[(long)((k0) + rr) * LDKR + rc]); } while (0)
#define SWRITE(b) do { *(bf16x8*)(V_lds + (b) * SHM_V + vst0) = vs0; *(bf16x8*)(V_lds + (b) * SHM_V + vst1) = vs1; int kc = sc * 2; \
    *(bf16x8*)(K_lds + (b) * SHM_K + AKSWZ(sr, kc)) = ks0; *(bf16x8*)(K_lds + (b) * SHM_K + AKSWZ(32 + sr, kc)) = ks1; \
    *(bf16x8*)(K_lds + (b) * SHM_K + AKSWZ(rr, 256 + rc * 2)) = kr0; } while (0)
#define SWAIT() asm volatile("s_waitcnt vmcnt(0)" ::: "memory")
#define RESC(a) do { if (__any((a) < 1.f)) { if (hi == 0) al_l[r32] = (a); asm volatile("s_waitcnt lgkmcnt(0)" ::: "memory"); \
    for (int d = 0; d < 4; ++d) for (int r = 0; r < 16; ++r) o[d][r] *= al_l[crow(r, hi)]; } } while (0)
  f32x16 pA0, pA1, pB0, pB1; float mnA, mnB, alA, alB; bf16x8 pa0, pa1, pa2, pa3; const int NT = seq / KVBLK;
  SLOAD(0); SWAIT(); SWRITE(0); __syncthreads();
  qkt(pA0, pA1, K_lds, qr, qrl, r32, hi); partialSM(pA0, pA1, m_reg, mnA, alA);
  SLOAD(KVBLK);
  SWAIT(); SWRITE(1); __syncthreads();
  for (int j = 1; j + 1 < NT; j += 2) {
    SBAR(); qkt(pB0, pB1, K_lds + SHM_K, qr, qrl, r32, hi);
    finishSM(pA0, pA1, alA, l_reg, pa0, pa1, pa2, pa3); SBAR();
    SLOAD((j + 1) * KVBLK); SBAR();
    pv_d0(o, vb0, pa0, pa1, pa2, pa3); partialSM(pB0, pB1, m_reg, mnB, alB);
    __syncthreads(); SWAIT(); SWRITE(0);
    RESC(alB); __syncthreads();
    SBAR(); qkt(pA0, pA1, K_lds, qr, qrl, r32, hi);
    finishSM(pB0, pB1, alB, l_reg, pa0, pa1, pa2, pa3); SBAR();
    SLOAD((j + 2) * KVBLK); SBAR();
    pv_d0(o, vb0 + SHM_V, pa0, pa1, pa2, pa3); partialSM(pA0, pA1, m_reg, mnA, alA);
    __syncthreads(); SWAIT(); SWRITE(1);
    RESC(alA); __syncthreads();
  }
  SBAR(); qkt(pB0, pB1, K_lds + SHM_K, qr, qrl, r32, hi);
  finishSM(pA0, pA1, alA, l_reg, pa0, pa1, pa2, pa3); SBAR();
  pv_d0(o, vb0, pa0, pa1, pa2, pa3); partialSM(pB0, pB1, m_reg, mnB, alB);
  __syncthreads(); RESC(alB);
  finishSM(pB0, pB1, alB, l_reg, pa0, pa1, pa2, pa3); SBAR();
  pv_d0(o, vb0 + SHM_V, pa0, pa1, pa2, pa3);
  if (hi == 0) li_l[r32] = l_reg; asm volatile("s_waitcnt lgkmcnt(0)" ::: "memory");
  float rli[16];
#pragma unroll
  for (int r = 0; r < 16; ++r) rli[r] = __builtin_amdgcn_rcpf(li_l[crow(r, hi)]);
  bf16_t* Ow = Ob + (long)(wid * QBLK) * LDO;
#pragma unroll
  for (int r = 0; r < 16; ++r) { int orow = crow(r, hi);
#pragma unroll
    for (int d0 = 0; d0 < 4; ++d0) Ow[(long)orow * LDO + d0 * 32 + r32] = f2bf(o[d0][r] * rli[r]); }
  __syncthreads();
#undef SLOAD
#undef SWRITE
#undef SWAIT
#undef RESC
}
}

namespace hy {
__device__ __forceinline__ c2 cmul(c2 a, c2 b) { return (c2){a.x * b.x - a.y * b.y, a.x * b.y + a.y * b.x}; }
__device__ __forceinline__ c2 cmulc(c2 a, c2 b) { return (c2){a.x * b.x + a.y * b.y, a.y * b.x - a.x * b.y}; }
__device__ __forceinline__ c2 twid(float fr) { return (c2){__builtin_amdgcn_cosf(fr), -__builtin_amdgcn_sinf(fr)}; }
struct T2 { c2 w, wr; };
__device__ __forceinline__ T2 mk(c2 w) { T2 t; t.w = w; t.wr = (c2){-w.y, w.x}; return t; }
__device__ __forceinline__ c2 mulT(c2 x, const T2& t) { return x.xx * t.w + x.yy * t.wr; }
template <bool INV> __device__ __forceinline__ void r4(c2& x0, c2& x1, c2& x2, c2& x3) {
    const c2 t0 = x0 + x2, t1 = x0 - x2, t2 = x1 + x3, t3 = x1 - x3;
    const c2 r = INV ? (c2){-t3.y, t3.x} : (c2){t3.y, -t3.x};
    x0 = t0 + t2; x1 = t1 + r; x2 = t0 - t2; x3 = t1 - r;
}
template <bool INV> __device__ __forceinline__ c2 mulw(c2 x, int k) {
    const float C1 = 0.9238795325112867f, S1 = 0.3826834323650898f, R = 0.7071067811865476f;
    const float sg = INV ? -1.f : 1.f; c2 w;
    switch (k) { case 0: return x; case 1: w = (c2){C1, -S1 * sg}; break; case 2: w = (c2){R, -R * sg}; break; case 3: w = (c2){S1, -C1 * sg}; break;
                 case 4: return INV ? (c2){-x.y, x.x} : (c2){x.y, -x.x}; case 6: w = (c2){-R, -R * sg}; break; default: w = (c2){-C1, S1 * sg}; break;   }
    return x.xx * w + x.yy * (c2){-w.y, w.x};
}
template <bool INV> __device__ __forceinline__ void dft16(c2 (&e)[16]) {
#pragma unroll
    for (int a0 = 0; a0 < 4; ++a0) { r4<INV>(e[a0], e[a0 + 4], e[a0 + 8], e[a0 + 12]);
#pragma unroll
        for (int b0 = 1; b0 < 4; ++b0) e[a0 + 4 * b0] = mulw<INV>(e[a0 + 4 * b0], a0 * b0); }
#pragma unroll
    for (int b0 = 0; b0 < 4; ++b0) r4<INV>(e[4 * b0], e[4 * b0 + 1], e[4 * b0 + 2], e[4 * b0 + 3]);
#pragma unroll
    for (int b0 = 0; b0 < 4; ++b0)
#pragma unroll
        for (int b1 = b0 + 1; b1 < 4; ++b1) { const c2 t = e[b1 + 4 * b0]; e[b1 + 4 * b0] = e[b0 + 4 * b1]; e[b0 + 4 * b1] = t; }
}
template <int R, bool INV, bool TW> __device__ __forceinline__ void bfly(c2 (&e)[R], c2 th) {
    T2 t1, t2, t3, T1, T2_, T3;
    if (TW) { t1 = mk(th); t2 = mk(mulT(th, t1)); t3 = mk(mulT(t2.w, t1));
        if (R == 16) { T1 = mk(mulT(t2.w, t2)); T2_ = mk(mulT(T1.w, T1)); T3 = mk(mulT(T2_.w, T1)); } }
#define HY_APPLY_TW() do { if (R == 16) { _Pragma("unroll") for (int b1 = 0; b1 < 4; ++b1) { e[4 * b1 + 1] = mulT(e[4 * b1 + 1], t1); e[4 * b1 + 2] = mulT(e[4 * b1 + 2], t2); e[4 * b1 + 3] = mulT(e[4 * b1 + 3], t3); } \
        _Pragma("unroll") for (int b0 = 0; b0 < 4; ++b0) { e[4 + b0] = mulT(e[4 + b0], T1); e[8 + b0] = mulT(e[8 + b0], T2_); e[12 + b0] = mulT(e[12 + b0], T3); } } \
      else { e[1] = mulT(e[1], t1); e[2] = mulT(e[2], t2); e[3] = mulT(e[3], t3); } } while (0)
    if (INV && TW) HY_APPLY_TW();
    if constexpr (R == 16) dft16<INV>(e); else r4<INV>(e[0], e[1], e[2], e[3]);
    if (!INV && TW) HY_APPLY_TW();
#undef HY_APPLY_TW
}
struct NoF { static constexpr bool ON = false; };
template <int R, bool INV, int S, int LS, int NSL, class LD, class ST> __device__ __forceinline__ void fft_pass(LAS c2* X, int seqstride, int nseq, int tid, const LD& ld, const ST& st) {
    const int total = nseq << NSL;
    for (int g = tid; g < total; g += 512) {
        const int q = g >> NSL, sg = g & ((1 << NSL) - 1);
        const int j0 = sg & (S - 1), blk = sg >> LS, base = blk * R * S + j0;
        LAS c2* p = X + q * seqstride + base + (base >> 4);
        constexpr int sp = (S >= 16) ? S + (S >> 4) : S;
        c2 e[R];
#pragma unroll
        for (int a = 0; a < R; ++a) { if constexpr (LD::ON) { e[a] = ld(q, base + a * S); if ((a & 3) == 3) asm volatile("" ::: "memory"); } else e[a] = p[a * sp]; }
        c2 th0 = twid((float)j0 * (1.0f / (float)(R * S))); if (INV) th0.y = -th0.y;
        bfly<R, INV, (S > 1)>(e, th0);
#pragma unroll
        for (int a = 0; a < R; ++a) { if constexpr (ST::ON) { st(q, base + a * S, e[a]); if ((a & 1) == 1) asm volatile("" ::: "memory"); } else p[a * sp] = e[a]; }
    }
    __syncthreads();
}
template <int LOGN> __device__ __forceinline__ void fft_mid(LAS c2* X, int nseq, const c2* KS, int tid) {
    constexpr int N = 1 << LOGN, SS = N + N / 16, NSL = LOGN - 4;
    const int total = nseq << NSL;
    for (int g = tid; g < total; g += 512) {
        const int q = g >> NSL, sg = g & ((1 << NSL) - 1);
        LAS c2* p = X + q * SS + sg * 17;
        c2 e[16]; const c2* kp = KS + sg;
        if constexpr (LOGN == 14) {
            c2 k[16];
#pragma unroll
            for (int a = 0; a < 16; ++a) k[a] = kp[a * (N / 16)];
#pragma unroll
            for (int a = 0; a < 16; ++a) e[a] = p[a];
            dft16<false>(e);
#pragma unroll
            for (int a = 0; a < 16; ++a) e[a] = mulT(e[a], mk(k[a]));
        } else {
#pragma unroll
            for (int a = 0; a < 16; ++a) e[a] = p[a];
            dft16<false>(e);
#pragma unroll
            for (int a0 = 0; a0 < 16; a0 += 4) { c2 k[4];
#pragma unroll
                for (int a = 0; a < 4; ++a) k[a] = kp[(a0 + a) * (N / 16)];
#pragma unroll
                for (int a = 0; a < 4; ++a) e[a0 + a] = mulT(e[a0 + a], mk(k[a]));
                asm volatile("" ::: "memory"); }
        }
        dft16<true>(e);
#pragma unroll
        for (int a = 0; a < 16; ++a) p[a] = e[a];
    }
    __syncthreads();
}
template <int LOGN, class LD> __device__ __forceinline__ void fft_fwd_head(LAS c2* X, int nseq, int tid, const LD& ld) {
    constexpr int N = 1 << LOGN, SS = N + N / 16; const NoF nf;
    if constexpr (LOGN == 14) { fft_pass<4, false, 4096, 12, LOGN - 2>(X, SS, nseq, tid, ld, nf); fft_pass<16, false, 256, 8, LOGN - 4>(X, SS, nseq, tid, nf, nf); }
    else fft_pass<16, false, 256, 8, LOGN - 4>(X, SS, nseq, tid, ld, nf);
    fft_pass<16, false, 16, 4, LOGN - 4>(X, SS, nseq, tid, nf, nf);
}
template <int LOGN, class ST> __device__ __forceinline__ void fft_inv_tail(LAS c2* X, int nseq, int tid, const ST& st) {
    constexpr int N = 1 << LOGN, SS = N + N / 16; const NoF nf;
    fft_pass<16, true, 16, 4, LOGN - 4>(X, SS, nseq, tid, nf, nf);
    if constexpr (LOGN == 14) { fft_pass<16, true, 256, 8, LOGN - 4>(X, SS, nseq, tid, nf, nf); fft_pass<4, true, 4096, 12, LOGN - 2>(X, SS, nseq, tid, nf, st); }
    else fft_pass<16, true, 256, 8, LOGN - 4>(X, SS, nseq, tid, nf, st);
}
template <int L> __device__ __forceinline__ float dw3(const bf16_t* u, int m, float w0, float w1, float w2, float b) {
    float x = bf2f(u[m]) * w1 + b; if (m > 0) x += bf2f(u[m - 1]) * w0; if (m < L - 1) x += bf2f(u[m + 1]) * w2; return x;
}
template <int L> struct HyCtx {
    const bf16_t *hf, *hb, *uv, *ug; bf16_t* zt; c2 *KS, *YC; float v0, v1, v2, vb, g0, g1, g2, gb, skip; int n;
    __device__ __forceinline__ c2 loadz(int q, int m) const { const int oA = 2 * q * L, oB = oA + L; c2 z;
        if (n == 0) { z.x = dw3<L>(uv + oA, m, v0, v1, v2, vb); z.y = dw3<L>(uv + oB, m, v0, v1, v2, vb); } else { z.x = bf2f(zt[oA + m]); z.y = bf2f(zt[oB + m]); }
        return z; }
};
template <int L, bool NEG> struct LdK { static constexpr bool ON = true; const HyCtx<L>* c;
    __device__ __forceinline__ c2 operator()(int, int m) const { const float f = bf2f(c->hf[m]); const float b = m ? bf2f(c->hb[L - m]) : 0.f;
        if (!NEG) return (c2){f + b, 0.f}; return twid((float)m * (0.5f / (float)L)) * (f - b); } };
template <int L, bool NEG> struct LdZ { static constexpr bool ON = true; const HyCtx<L>* c;
    __device__ __forceinline__ c2 operator()(int q, int m) const { c2 z = c->loadz(q, m); if (NEG) z = mulT(z, mk(twid((float)m * (0.5f / (float)L)))); return z; } };
template <int L> struct StKS { static constexpr bool ON = true; const HyCtx<L>* c;
    __device__ __forceinline__ void operator()(int, int pos, c2 v) const { c->KS[(pos & 15) * (L / 16) + (pos >> 4)] = v; } };
template <int L> struct StYC { static constexpr bool ON = true; const HyCtx<L>* c;
    __device__ __forceinline__ void operator()(int q, int m, c2 v) const { c->YC[q * L + m] = v; } };
template <int L> struct StFin { static constexpr bool ON = true; const HyCtx<L>* c;
    __device__ __forceinline__ void operator()(int q, int m, c2 v) const { const int oA = 2 * q * L, oB = oA + L;
        const c2 z = c->loadz(q, m); c2 tw = twid((float)m * (0.5f / (float)L)); tw.y = -tw.y;
        const c2 y = (c->YC[q * L + m] + mulT(v, mk(tw))) * (0.5f / (float)L) + z * c->skip;
        const float gA = dw3<L>(c->ug + oA, m, c->g0, c->g1, c->g2, c->gb), gB = dw3<L>(c->ug + oB, m, c->g0, c->g1, c->g2, c->gb);
        c->zt[oA + m] = f2bf(y.x * gA); c->zt[oB + m] = f2bf(y.y * gB); } };
__device__ __forceinline__ unsigned ldw(const void* base, unsigned boff) { return *(const unsigned*)((const char*)base + boff); }
struct W3 { unsigned p, c, n; };
template <int L> __device__ __forceinline__ W3 dw3ld(const bf16_t* u, unsigned j) {
    const unsigned o = j * 4u; W3 w; w.c = ldw(u, o); w.p = ldw(u, j > 0u ? o - 4u : o); w.n = ldw(u, j < (unsigned)(L / 2 - 1) ? o + 4u : o); return w; }
template <int L> __device__ __forceinline__ c2 dw3c(W3 w, unsigned j, float w0, float w1, float w2, float b) {
    const unsigned prv = j > 0u ? w.p : 0u, nxt = j < (unsigned)(L / 2 - 1) ? w.n : 0u;
    const float xm = bfhi(prv), x0 = bflo(w.c), x1 = bfhi(w.c), x2 = bflo(nxt);
    return (c2){xm * w0 + x0 * w1 + x1 * w2 + b, x0 * w0 + x1 * w1 + x2 * w2 + b};
}
template <int L, bool NEG> __device__ __forceinline__ void ew_loadk(LAS c2* X, const HyCtx<L>& c, int tid) {
    constexpr int NI = L / 1024, U = (L == 4096) ? 2 : 8;
#pragma unroll 1
    for (int i0 = 0; i0 < NI; i0 += U) {
        unsigned wf[U], wA[U], wB[U];
#pragma unroll
        for (int u = 0; u < U; ++u) { const unsigned j = (unsigned)tid + 512u * (i0 + u);
            wf[u] = ldw(c.hf, j * 4u); wA[u] = ldw(c.hb, (unsigned)(2 * L - 4) - j * 4u); wB[u] = ldw(c.hb, j ? (unsigned)(2 * L) - j * 4u : 0u); }
#pragma unroll
        for (int u = 0; u < U; ++u) { const unsigned j = (unsigned)tid + 512u * (i0 + u);
            const float f0 = bflo(wf[u]), f1 = bfhi(wf[u]), b0 = j ? bflo(wB[u]) : 0.f, b1 = bfhi(wA[u]); LAS c2* p = X + 2 * j + (j >> 3);
            if (!NEG) { p[0] = (c2){f0 + b0, 0.f}; p[1] = (c2){f1 + b1, 0.f}; }
            else { p[0] = twid((float)(2 * j) * (0.5f / (float)L)) * (f0 - b0); p[1] = twid((float)(2 * j + 1) * (0.5f / (float)L)) * (f1 - b1); } }
    }
    __syncthreads();
}
template <int L, bool NEG, bool N0> __device__ __forceinline__ void ew_loadz(LAS c2* X, const HyCtx<L>& c, int nseq, int tid) {
    constexpr int SS = L + L / 16, NI = L / 1024, U = (L == 4096) ? 2 : 8;
#pragma unroll 1
    for (int q = 0; q < nseq; ++q) { const int oA = 2 * q * L, oB = oA + L;
#pragma unroll 1
        for (int i0 = 0; i0 < NI; i0 += U) {
            W3 a[U], b[U];
#pragma unroll
            for (int u = 0; u < U; ++u) { const unsigned j = (unsigned)tid + 512u * (i0 + u);
                if (N0) { a[u] = dw3ld<L>(c.uv + oA, j); b[u] = dw3ld<L>(c.uv + oB, j); } else { a[u].c = ldw(c.zt + oA, j * 4u); b[u].c = ldw(c.zt + oB, j * 4u); } }
#pragma unroll
            for (int u = 0; u < U; ++u) { const unsigned j = (unsigned)tid + 512u * (i0 + u); c2 zA, zB;
                if (N0) { zA = dw3c<L>(a[u], j, c.v0, c.v1, c.v2, c.vb); zB = dw3c<L>(b[u], j, c.v0, c.v1, c.v2, c.vb); } else { zA = (c2){bflo(a[u].c), bfhi(a[u].c)}; zB = (c2){bflo(b[u].c), bfhi(b[u].c)}; }
                LAS c2* p = X + q * SS + 2 * j + (j >> 3); c2 e0 = (c2){zA.x, zB.x}, e1 = (c2){zA.y, zB.y};
                if (NEG) { e0 = mulT(e0, mk(twid((float)(2 * j) * (0.5f / (float)L)))); e1 = mulT(e1, mk(twid((float)(2 * j + 1) * (0.5f / (float)L)))); }
                p[0] = e0; p[1] = e1; }
        } }
    __syncthreads();
}
template <int L> __device__ __forceinline__ void ew_storeyc(LAS c2* X, const HyCtx<L>& c, int nseq, int tid) {
    constexpr int SS = L + L / 16; typedef float f4 __attribute__((ext_vector_type(4)));
#pragma unroll 1
    for (int q = 0; q < nseq; ++q)
#pragma unroll (L == 4096 ? 2 : 8)
        for (int i = 0; i < L / 1024; ++i) { const unsigned j = (unsigned)tid + 512u * i; LAS c2* p = X + q * SS + 2 * j + (j >> 3); const c2 a = p[0], b = p[1];
            *(f4*)((char*)(c.YC + q * L) + j * 16u) = (f4){a.x, a.y, b.x, b.y}; }
    __syncthreads();
}
template <int L, bool N0> __device__ __forceinline__ void ew_final(LAS c2* X, const HyCtx<L>& c, int nseq, int tid) {
    constexpr int SS = L + L / 16, NI = L / 1024, U = (L == 4096) ? 2 : 4; typedef float f4 __attribute__((ext_vector_type(4)));
#pragma unroll 1
    for (int q = 0; q < nseq; ++q) { const int oA = 2 * q * L, oB = oA + L;
#pragma unroll 1
        for (int i0 = 0; i0 < NI; i0 += U) {
            W3 a[U], b[U], ga[U], gb[U]; f4 yc[U];
#pragma unroll
            for (int u = 0; u < U; ++u) { const unsigned j = (unsigned)tid + 512u * (i0 + u);
                if (N0) { a[u] = dw3ld<L>(c.uv + oA, j); b[u] = dw3ld<L>(c.uv + oB, j); } else { a[u].c = ldw(c.zt + oA, j * 4u); b[u].c = ldw(c.zt + oB, j * 4u); }
                ga[u] = dw3ld<L>(c.ug + oA, j); gb[u] = dw3ld<L>(c.ug + oB, j); yc[u] = *(const f4*)((const char*)(c.YC + q * L) + j * 16u); }
#pragma unroll
            for (int u = 0; u < U; ++u) { const unsigned j = (unsigned)tid + 512u * (i0 + u); c2 zA, zB;
                if (N0) { zA = dw3c<L>(a[u], j, c.v0, c.v1, c.v2, c.vb); zB = dw3c<L>(b[u], j, c.v0, c.v1, c.v2, c.vb); } else { zA = (c2){bflo(a[u].c), bfhi(a[u].c)}; zB = (c2){bflo(b[u].c), bfhi(b[u].c)}; }
                LAS c2* p = X + q * SS + 2 * j + (j >> 3); const c2 yn0 = p[0], yn1 = p[1];
                c2 t0 = twid((float)(2 * j) * (0.5f / (float)L)), t1 = twid((float)(2 * j + 1) * (0.5f / (float)L)); t0.y = -t0.y; t1.y = -t1.y;
                const c2 y0 = ((c2){yc[u][0], yc[u][1]} + mulT(yn0, mk(t0))) * (0.5f / (float)L) + (c2){zA.x, zB.x} * c.skip;
                const c2 y1 = ((c2){yc[u][2], yc[u][3]} + mulT(yn1, mk(t1))) * (0.5f / (float)L) + (c2){zA.y, zB.y} * c.skip;
                const c2 gA = dw3c<L>(ga[u], j, c.g0, c.g1, c.g2, c.gb), gB = dw3c<L>(gb[u], j, c.g0, c.g1, c.g2, c.gb);
                *(unsigned*)((char*)(c.zt + oA) + j * 4u) = pk(y0.x * gA.x, y1.x * gA.y); *(unsigned*)((char*)(c.zt + oB) + j * 4u) = pk(y0.y * gB.x, y1.y * gB.y); }
        } }
    __syncthreads();
}
template <int LOGN> __device__ __forceinline__ void hyena_item(LAS c2* X, const bf16_t* UT, int Tg, const bf16_t* FT, bf16_t* ZT, int c,
                                                               const float* short_w, const float* short_b, const float* hy_skip, c2* KS, c2* YC, int tid) {
    constexpr int L = 1 << LOGN, NSEQ = (LOGN == 12) ? 2 : 1, SS = L + L / 16; constexpr bool FUSE = false;
    HyCtx<L> cx; cx.uv = UT + (size_t)(2048 + c) * Tg; cx.zt = ZT + (size_t)c * Tg; cx.KS = KS; cx.YC = YC;
    cx.v0 = short_w[2048 + c]; cx.v1 = short_w[3072 + 2048 + c]; cx.v2 = short_w[6144 + 2048 + c]; cx.vb = short_b[2048 + c];
    const NoF nf;
    for (int n = 0; n < 2; ++n) {
        cx.n = n; cx.hf = FT + (size_t)(n * 1024 + c) * L; cx.hb = FT + (size_t)((2 + n) * 1024 + c) * L; cx.skip = hy_skip[n * 1024 + c];
        const int gr = n ? 1024 + c : c; cx.ug = UT + (size_t)gr * Tg;
        cx.g0 = short_w[gr]; cx.g1 = short_w[3072 + gr]; cx.g2 = short_w[6144 + gr]; cx.gb = short_b[gr];
        if constexpr (FUSE) fft_fwd_head<LOGN>(X, 1, tid, LdK<L, false>{&cx}); else { ew_loadk<L, false>(X, cx, tid); fft_fwd_head<LOGN>(X, 1, tid, nf); }
        fft_pass<16, false, 1, 0, LOGN - 4>(X, SS, 1, tid, nf, StKS<L>{&cx});
        if constexpr (FUSE) fft_fwd_head<LOGN>(X, NSEQ, tid, LdZ<L, false>{&cx}); else { if (n == 0) ew_loadz<L, false, true>(X, cx, NSEQ, tid); else ew_loadz<L, false, false>(X, cx, NSEQ, tid); fft_fwd_head<LOGN>(X, NSEQ, tid, nf); }
        fft_mid<LOGN>(X, NSEQ, KS, tid);
        if constexpr (FUSE) fft_inv_tail<LOGN>(X, NSEQ, tid, StYC<L>{&cx}); else { fft_inv_tail<LOGN>(X, NSEQ, tid, nf); ew_storeyc<L>(X, cx, NSEQ, tid); }
        if constexpr (FUSE) fft_fwd_head<LOGN>(X, 1, tid, LdK<L, true>{&cx}); else { ew_loadk<L, true>(X, cx, tid); fft_fwd_head<LOGN>(X, 1, tid, nf); }
        fft_pass<16, false, 1, 0, LOGN - 4>(X, SS, 1, tid, nf, StKS<L>{&cx});
        if constexpr (FUSE) fft_fwd_head<LOGN>(X, NSEQ, tid, LdZ<L, true>{&cx}); else { if (n == 0) ew_loadz<L, true, true>(X, cx, NSEQ, tid); else ew_loadz<L, true, false>(X, cx, NSEQ, tid); fft_fwd_head<LOGN>(X, NSEQ, tid, nf); }
        fft_mid<LOGN>(X, NSEQ, KS, tid);
        if constexpr (FUSE) fft_inv_tail<LOGN>(X, NSEQ, tid, StFin<L>{&cx}); else { fft_inv_tail<LOGN>(X, NSEQ, tid, nf); if (n == 0) ew_final<L, true>(X, cx, NSEQ, tid); else ew_final<L, false>(X, cx, NSEQ, tid); }
    }
}
}

__device__ __forceinline__ int colmap(int mode, int n) {
    if (mode == 0) return n;
    if (mode == 1) {
        if (n >= 2816) return 704 + (n - 2816);
        if (n < 640) return n;
        if (n < 704) { const int j = n - 640; return 640 + (j >> 1) + 32 * (j & 1); }
        if (n < 2752) return 3776 + (n - 704);
        return -1;
    }
    if (n < 1024) return (n >> 7) * 192 + (n & 127);
    { const int h = (n - 1024) >> 6, j = (n - 1024) & 63; return h * 192 + 128 + (j >> 1) + 32 * (j & 1); }
}
__device__ __forceinline__ void wtrans(float* tile  , const float* src, int ld, int K, int dstN, bf16_t* dst, int mode, const float* scale, int tid) {
    const int tk = K / 64, ntiles = (dstN / 64) * tk;
    for (int t = blockIdx.x; t < ntiles; t += gridDim.x) {
        const int n0 = (t / tk) * 64, k0 = (t % tk) * 64;
        { const int nn = tid & 63, col = colmap(mode, n0 + nn);
          float vv[8];
#pragma unroll
          for (int i = 0; i < 8; ++i) { const int kk = (tid >> 6) + 8 * i; vv[i] = src[(size_t)(k0 + kk) * ld + (col >= 0 ? col : 0)]; if (scale) vv[i] *= scale[k0 + kk]; }
#pragma unroll
          for (int i = 0; i < 8; ++i) { const int kk = (tid >> 6) + 8 * i; tile[kk * 65 + nn] = col >= 0 ? vv[i] : 0.f; } }
        __syncthreads();
        { const int kk = tid & 63;
#pragma unroll
          for (int i = 0; i < 8; ++i) { const int nn = (tid >> 6) + 8 * i; dst[(size_t)(n0 + nn) * K + k0 + kk] = f2bf(tile[kk * 65 + nn]); } }
        __syncthreads();
    }
}
__device__ __forceinline__ void cvt_rows(const float* src, bf16_t* dst, size_t n8, int gtid, int gthreads) {
    for (size_t i = gtid; i < n8; i += (size_t)gthreads * 4) {
        f32x4 a[4], b[4];
#pragma unroll
        for (int u = 0; u < 4; ++u) { const size_t k = i + (size_t)u * gthreads; a[u] = *(const f32x4*)(src + k * 8); b[u] = *(const f32x4*)(src + k * 8 + 4); }
#pragma unroll
        for (int u = 0; u < 4; ++u) { const size_t k = i + (size_t)u * gthreads; st8(dst + k * 8, a[u], b[u]); } }
}
__device__ __forceinline__ float wsum(float v) { v += __shfl_xor(v, 1); v += __shfl_xor(v, 2); v += __shfl_xor(v, 4); v += __shfl_xor(v, 8); v += __shfl_xor(v, 16); v += __shfl_xor(v, 32); return v; }
__device__ __forceinline__ void ln_rows(float* Y, const float* g, const float* b, bf16_t* Xb, int nrows, int tid) {
    const int wid = tid >> 6, lane = tid & 63;
    f32x4 gv[4], bv[4];
#pragma unroll
    for (int k = 0; k < 4; ++k) { gv[k] = *(const f32x4*)(g + k * 256 + lane * 4); bv[k] = *(const f32x4*)(b + k * 256 + lane * 4); }
    for (int row = (blockIdx.x * 8 + wid) * 2; row < nrows; row += gridDim.x * 16) {
        f32x4 v[2][4];
#pragma unroll
        for (int u = 0; u < 2; ++u)
#pragma unroll
            for (int k = 0; k < 4; ++k) v[u][k] = *(const f32x4*)(Y + (size_t)(row + u) * 1024 + k * 256 + lane * 4);
#pragma unroll
        for (int u = 0; u < 2; ++u) {
            float* y = Y + (size_t)(row + u) * 1024; float s = 0.f;
#pragma unroll
            for (int k = 0; k < 4; ++k) s += (v[u][k][0] + v[u][k][1]) + (v[u][k][2] + v[u][k][3]);
            const float mean = wsum(s) * (1.0f / 1024.0f); float q = 0.f;
#pragma unroll
            for (int k = 0; k < 4; ++k) { v[u][k] = v[u][k] - mean; q += (v[u][k][0] * v[u][k][0] + v[u][k][1] * v[u][k][1]) + (v[u][k][2] * v[u][k][2] + v[u][k][3] * v[u][k][3]); }
            const float rstd = rsqrtf(wsum(q) * (1.0f / 1024.0f) + LN_EPS);
#pragma unroll
            for (int k = 0; k < 4; ++k) { const f32x4 o = v[u][k] * rstd * gv[k] + bv[k]; *(f32x4*)(y + k * 256 + lane * 4) = o;
                if (Xb) { unsigned w0 = pk(o[0], o[1]), w1 = pk(o[2], o[3]); *(uint2*)(Xb + (size_t)(row + u) * 1024 + k * 256 + lane * 4) = make_uint2(w0, w1); } }
        }
    }
}
__device__ __forceinline__ void ffn_mid(const bf16_t* AB, bf16_t* HM, const float* dw_w, const float* dw_b, int seqmask, int tid) {
    typedef float f32x2 __attribute__((ext_vector_type(2)));
    if (tid >= 352) return;
    const int col = tid * 8;
    const f32x4 w0a = *(const f32x4*)(dw_w + col), w0b = *(const f32x4*)(dw_w + col + 4), w1a = *(const f32x4*)(dw_w + 2816 + col), w1b = *(const f32x4*)(dw_w + 2816 + col + 4),
                w2a = *(const f32x4*)(dw_w + 5632 + col), w2b = *(const f32x4*)(dw_w + 5632 + col + 4), ba = *(const f32x4*)(dw_b + col), bb = *(const f32x4*)(dw_b + col + 4);
    const f32x4 zero = {0.f, 0.f, 0.f, 0.f};
    for (int rb = blockIdx.x; rb < TC / 64; rb += gridDim.x) {
        const int r0 = rb * 64; const bf16_t* p = AB + (size_t)r0 * 5632 + col; bf16_t* o = HM + (size_t)r0 * 2816 + col;
        u32x4 wp = {0u, 0u, 0u, 0u}, wc;
        if ((r0 & seqmask) > 0) wp = *(const u32x4*)(p - 5632);
        wc = *(const u32x4*)p;
#pragma unroll 1
        for (int r = 0; r < 64; r += 4) {
            u32x4 wn[4], wg[4];
#pragma unroll
            for (int u = 0; u < 4; ++u) { const int pos = (r0 + r + u) & seqmask;
                wn[u] = *(const u32x4*)(p + (size_t)(r + u + (pos < seqmask ? 1 : 0)) * 5632); wg[u] = *(const u32x4*)(p + (size_t)(r + u) * 5632 + 2816); }
#pragma unroll
            for (int u = 0; u < 4; ++u) { const int pos = (r0 + r + u) & seqmask;
                f32x4 pa, pb, ca, cb, na, nb, ga, gb;
                if (pos == 0) wp = (u32x4){0u, 0u, 0u, 0u};
                if (pos == seqmask) wn[u] = (u32x4){0u, 0u, 0u, 0u};
                unp8(wp, pa, pb); unp8(wc, ca, cb); unp8(wn[u], na, nb); unp8(wg[u], ga, gb);
                f32x4 ta = pa * w0a + ca * w1a + na * w2a + ba, tb = pb * w0b + cb * w1b + nb * w2b + bb;
                const f32x2 q0 = pg8::gelu_pk((f32x2){ta[0], ta[1]}), q1 = pg8::gelu_pk((f32x2){ta[2], ta[3]}), q2 = pg8::gelu_pk((f32x2){tb[0], tb[1]}), q3 = pg8::gelu_pk((f32x2){tb[2], tb[3]});
                ta = (f32x4){q0.x, q0.y, q1.x, q1.y} * ga; tb = (f32x4){q2.x, q2.y, q3.x, q3.y} * gb;
                st8(o + (size_t)(r + u) * 2816, ta, tb);
                wp = wc; wc = wn[u]; }
        }
    }
}
__device__ __forceinline__ void transpose_z(LAS bf16_t* tile  , const bf16_t* ZT, bf16_t* Z, int Tg, int tid) {
    const int tt = Tg / 64, ngroups = 16 * tt / 4;
    for (int gI = blockIdx.x; gI < ngroups; gI += gridDim.x) {
        const int c0 = (gI / (tt / 4)) * 64, tb = (gI % (tt / 4)) * 256;
        const int cc = tid >> 3, t8 = (tid & 7) * 8;
        u32x4 w[4];
#pragma unroll
        for (int k = 0; k < 4; ++k) w[k] = *(const u32x4*)(ZT + (size_t)(c0 + cc) * Tg + tb + k * 64 + t8);
#pragma unroll
        for (int k = 0; k < 4; ++k) { LAS bf16_t* T = tile + k * 64 * 72;
          T[(t8 + 0) * 72 + cc] = (bf16_t)(w[k].x & 0xffff); T[(t8 + 1) * 72 + cc] = (bf16_t)(w[k].x >> 16); T[(t8 + 2) * 72 + cc] = (bf16_t)(w[k].y & 0xffff); T[(t8 + 3) * 72 + cc] = (bf16_t)(w[k].y >> 16);
          T[(t8 + 4) * 72 + cc] = (bf16_t)(w[k].z & 0xffff); T[(t8 + 5) * 72 + cc] = (bf16_t)(w[k].z >> 16); T[(t8 + 6) * 72 + cc] = (bf16_t)(w[k].w & 0xffff); T[(t8 + 7) * 72 + cc] = (bf16_t)(w[k].w >> 16); }
        __syncthreads();
        { const int r = tid >> 3, c8 = (tid & 7) * 8;
#pragma unroll
          for (int k = 0; k < 4; ++k) { const u32x4 o = *(const LAS u32x4*)(tile + k * 64 * 72 + r * 72 + c8); *(u32x4*)(Z + (size_t)(tb + k * 64 + r) * 1024 + c0 + c8) = o; } }
        __syncthreads();
    }
}

struct Params { const float* in[27]; float* out; unsigned char* ws; int lo, hi; };

__device__ __forceinline__ void prologue(const Params& P, unsigned char* smem, int tid) {
    unsigned char* ws = P.ws; float* tile = (float*)smem;
    const int gtid = blockIdx.x * 512 + tid, gthreads = gridDim.x * 512;
    wtrans(tile, P.in[2], 5824, 1024, 5888, (bf16_t*)(ws + WS_WIN), 1, nullptr, tid);
    wtrans(tile, P.in[6], 1536, 384, 1536, (bf16_t*)(ws + WS_WUQ), 2, P.in[5], tid);
    wtrans(tile, P.in[8], 2048, 256, 2048, (bf16_t*)(ws + WS_WUKV), 0, P.in[7], tid);
    wtrans(tile, P.in[9], 1024, 1024, 1024, (bf16_t*)(ws + WS_WOMLA), 0, nullptr, tid);
    wtrans(tile, P.in[17], 1024, 1024, 1024, (bf16_t*)(ws + WS_WOHY), 0, nullptr, tid);
    wtrans(tile, P.in[18], 1024, 1024, 1024, (bf16_t*)(ws + WS_WOUT), 0, nullptr, tid);
    wtrans(tile, P.in[21], 5632, 1024, 5632, (bf16_t*)(ws + WS_WUP), 0, nullptr, tid);
    wtrans(tile, P.in[24], 1024, 2816, 1024, (bf16_t*)(ws + WS_WDOWN), 0, nullptr, tid);
    { bf16_t* W3B = (bf16_t*)(ws + WS_W3B); const float* w3 = P.in[15];
      for (int i = gtid; i < 4096 * 128; i += gthreads) { const int k = i >> 12, o = i & 4095; W3B[o * 128 + k] = f2bf(w3[(k & 63) * 4096 + o]); } }
    cvt_rows(P.in[0], (bf16_t*)(P.out + (size_t)1 * TC * 1024), (size_t)TC * 1024 / 8, gtid, gthreads);
    cvt_rows(P.in[1], (bf16_t*)(P.out + (size_t)2 * TC * 1024), (size_t)2 * TC * 1024 / 8, gtid, gthreads);
    { float* cosT = (float*)(ws + WS_COS); float* sinT = (float*)(ws + WS_SIN);
      for (int i = gtid; i < 16384 * 32; i += gthreads) { const int pos = i >> 5, k = i & 31; const float inv = powf(10000.0f, -(float)(2 * k) / 64.0f); const float ang = (float)pos * inv;
          cosT[i] = cosf(ang); sinT[i] = sinf(ang); } }
    { float* ssq = (float*)(ws + WS_SSQ); for (int i = gtid; i < 3 * TC * 2; i += gthreads) ssq[i] = 0.f; }
    { bf16_t* H2B = (bf16_t*)(ws + WS_H2B); const float *w1 = P.in[10], *b1 = P.in[11], *fq = P.in[12], *w2 = P.in[13], *b2 = P.in[14];
      const int wid = tid >> 6, lane = tid & 63; const float fr = fq[lane];
      for (int row = blockIdx.x * 8 + wid; row < 20480; row += gridDim.x * 8) {
          const int L = row < 4096 ? 4096 : 16384, m = row < 4096 ? row : row - 4096;
          const float t = (float)m / (float)(L - 1); const int kb = lane & 15;
          const float band = 1e-4f + (float)kb * ((15.0f - 1e-4f) / 15.0f); const float a0 = (6.283185307179586f * (float)m) / (float)L; const float ang = a0 * band;
          const float cv = cosf(ang), sv = -sinf(ang);
          float acc = b1[lane] + t * w1[lane];
#pragma unroll
          for (int k = 0; k < 16; ++k) { acc += __shfl(cv, k) * w1[(1 + k) * 64 + lane]; acc += __shfl(sv, k) * w1[(17 + k) * 64 + lane]; }
          const float h1 = sinf(fr * acc);
          float acc2 = b2[lane];
#pragma unroll 8
          for (int k = 0; k < 64; ++k) acc2 += __shfl(h1, k) * w2[k * 64 + lane];
          const float h2 = sinf(fr * acc2);
          const bf16_t hi = f2bf(h2); H2B[(size_t)row * 128 + lane] = hi; H2B[(size_t)row * 128 + 64 + lane] = f2bf(h2 - bf2f(hi));
      } }
}

#define KCONST __attribute__((address_space(4)))
__device__ __forceinline__ const KCONST Params* kargs() { const KCONST void* kp = (const KCONST void*)__builtin_amdgcn_kernarg_segment_ptr(); asm volatile("" : "+s"(kp)); return (const KCONST Params*)kp; }
__global__ void __launch_bounds__(512, 2) mega(Params P) {
    extern __shared__ __attribute__((aligned(16))) unsigned char smem[];
    cg::grid_group grid = cg::this_grid();
    PG8_LAS unsigned char* lds = (PG8_LAS unsigned char*)smem;
    volatile LAS unsigned* xst = (volatile LAS unsigned*)(lds + LDS_FFT);
    if (threadIdx.x == 0) { xst[0] = 0u; xst[1] = 0u; }
    __syncthreads();
    (void)xcd_barrier_post((unsigned*)(P.ws + WS_BAR), xst);
#define GBAR() do { XcdBarrier b_; b_.bar = (unsigned*)(kargs()->ws + WS_BAR); b_.x = xb_xcc_id(); b_.st = (volatile LAS unsigned*)((PG8_LAS unsigned char*)smem + LDS_FFT); xcd_barrier(b_); } while (0)
#if MK_MULTI
    const int lo = P.lo, hi = P.hi; int ph = 0;
#define PH_BEGIN if (ph >= lo && ph < hi) { PH_SETUP
#define PH_END } ++ph; if (ph > lo && ph < hi) GBAR();
#define PH_END_NOSYNC } ++ph;
#else
#define PH_BEGIN { PH_SETUP
#define PH_END } GBAR();
#define PH_END_NOSYNC }
#endif
#define PH_SETUP int tid = threadIdx.x; asm volatile("" : "+v"(tid)); const int gtid = blockIdx.x * 512 + tid; const int gthreads = gridDim.x * 512; (void)gtid; (void)gthreads; \
    const KCONST Params* PQ = kargs(); unsigned char* ws = PQ->ws; (void)ws;
#define WB(off) ((bf16_t*)(ws + (off)))
#define XB_G ((const bf16_t*)(PQ->out + (size_t)(g ? 2 : 1) * TC * 1024))
#define COS_T ((const float*)(ws + WS_COS))
#define SIN_T ((const float*)(ws + WS_SIN))
#define SSQ_C ((float*)(ws + WS_SSQ) + (size_t)chunk * TC * 2)
#define Y_C (PQ->out + (size_t)chunk * TC * 1024)
    if (P.lo < 0) grid.sync();
    PH_BEGIN
#if EN_PRO
        { Params Pl; for (int i = 0; i < 27; ++i) Pl.in[i] = PQ->in[i]; Pl.out = PQ->out; Pl.ws = PQ->ws; Pl.lo = 0; Pl.hi = 0;
          for (int rep = 0; rep < REP_PRO; ++rep) prologue(Pl, smem, tid); }
#endif
    PH_END
    for (int g = 0; g < 2; ++g) {
        PH_BEGIN
            const int L = g ? 16384 : 4096, Tg = g ? 2 * TC : TC;
            for (int rep = 0; rep < REP_G; ++rep) run_gemm<0>(lds, WB(WS_W3B), WB(WS_H2B) + (g ? (size_t)4096 * 128 : 0), 4096, L, 128, FFilt{WB(WS_FT), L});
            for (int rep = 0; rep < REP_G; ++rep) run_gemm<1>(lds, WB(WS_WIN) + (size_t)2816 * 1024, XB_G, 3072, Tg, 1024, FBf{WB(WS_UT), (size_t)Tg});
        PH_END
        PH_BEGIN
            const int Tg = g ? 2 * TC : TC;
            for (int rep = 0; rep < REP_HY; ++rep)
            for (int c = blockIdx.x; c < 1024; c += gridDim.x) {
                c2* KS = (c2*)(PQ->out + (size_t)(g ? 1 : 0) * TC * 1024) + (size_t)blockIdx.x * 32768; c2* YC = KS + 16384;
#if EN_HY14
                if (g) hy::hyena_item<14>((LAS c2*)smem, WB(WS_UT), Tg, WB(WS_FT), WB(WS_ZT), c, PQ->in[3], PQ->in[4], PQ->in[16], KS, YC, tid);
#endif
#if EN_HY12
                if (!g) hy::hyena_item<12>((LAS c2*)smem, WB(WS_UT), Tg, WB(WS_FT), WB(WS_ZT), c, PQ->in[3], PQ->in[4], PQ->in[16], KS, YC, tid);
#endif
            }
        PH_END
        for (int ck = 0; ck < (g ? 2 : 1); ++ck) {
            const int chunk = g ? 1 + ck : 0;
            PH_BEGIN
                const int Tg = g ? 2 * TC : TC, seqmask = (g ? 16384 : 4096) - 1;
                if (ck == 0) transpose_z((LAS bf16_t*)smem, WB(WS_ZT), WB(WS_Z), Tg, tid);
                run_gemm<2>(lds, XB_G + (size_t)ck * TC * 1024, WB(WS_WIN), TC, 2816, 1024, FTm{WB(WS_CQ), WB(WS_CKV), WB(WS_KR), WB(WS_G), SSQ_C, COS_T, SIN_T, seqmask});
            PH_END
            PH_BEGIN
                const int seqmask = (g ? 16384 : 4096) - 1;
                for (int rep = 0; rep < REP_G; ++rep) run_gemm<3>(lds, WB(WS_CQ), WB(WS_WUQ), TC, 1536, 384, FQ{WB(WS_Q), SSQ_C, COS_T, SIN_T, seqmask});
                for (int rep = 0; rep < REP_G; ++rep) run_gemm<4>(lds, WB(WS_CKV), WB(WS_WUKV), TC, 2048, 256, FKV{WB(WS_KV), SSQ_C});
            PH_END
            PH_BEGIN
                const int L = g ? 16384 : 4096, nqb = L / 256;
                const bf16_t *Q = WB(WS_Q), *KV = WB(WS_KV), *KR = WB(WS_KR); bf16_t* O = WB(WS_O);
                for (int rep = 0; rep < REP_ATT; ++rep)
                for (int i = blockIdx.x; i < 512; i += gridDim.x) {
                    const int h = i & 7, combo = i >> 3, b = combo / nqb, qb = combo % nqb;
                    const size_t r0 = (size_t)b * L;
#if EN_ATT
                    att::attn_unit(Q + (r0 + (size_t)qb * 256) * 1536, KV + r0 * 2048 + h * 256, KV + r0 * 2048 + h * 256 + 128, KR + r0 * 64,
                                   O + (r0 + (size_t)qb * 256) * 1024 + h * 128, L, (char*)smem, h);
#endif
                }
            PH_END
            PH_BEGIN
                run_gemm<5>(lds, WB(WS_Z) + (size_t)ck * TC * 1024, WB(WS_WOHY), TC, 1024, 1024, FM1{WB(WS_MG), WB(WS_G)});
                run_gemm<6>(lds, WB(WS_O), WB(WS_WOMLA), TC, 1024, 1024, FM2{WB(WS_MG), WB(WS_G)});
            PH_END
            PH_BEGIN
                const float* xin = g ? PQ->in[1] + (size_t)ck * TC * 1024 : PQ->in[0];
                for (int rep = 0; rep < REP_G; ++rep) run_gemm<7>(lds, WB(WS_MG), WB(WS_WOUT), TC, 1024, 1024, FOut{Y_C, xin});
            PH_END
            PH_BEGIN ln_rows(Y_C, PQ->in[19], PQ->in[20], WB(WS_X1B), TC, tid); PH_END
            PH_BEGIN
                for (int rep = 0; rep < REP_G; ++rep) run_gemm<8>(lds, WB(WS_X1B), WB(WS_WUP), TC, 5632, 1024, FBf{WB(WS_AB), (size_t)5632});
            PH_END
            PH_BEGIN const int seqmask = (g ? 16384 : 4096) - 1; for (int rep = 0; rep < REP_SM; ++rep) ffn_mid(WB(WS_AB), WB(WS_HM), PQ->in[22], PQ->in[23], seqmask, tid); PH_END
            PH_BEGIN
                run_gemm<9>(lds, WB(WS_HM), WB(WS_WDOWN), TC, 1024, 2816, FDown{Y_C});
            PH_END
            PH_BEGIN ln_rows(Y_C, PQ->in[25], PQ->in[26], nullptr, TC, tid); PH_END_NOSYNC
        }
    }
}
constexpr int N_PHASES = 1 + 2 * 2 + 3 * 10;

extern "C" void kernel_launch(void* const* d_in, const int* in_sizes, int n_in, void* d_out, int out_size, void* d_ws, size_t ws_size, hipStream_t stream) {
    static int grid = 0;
    if (grid == 0) {
        if (n_in != 27 || out_size != 3 * TC * 1024 || ws_size < WS_END) { fprintf(stderr, "kernel_launch: unexpected shapes: n_in %d out %d ws %zu\n", n_in, out_size, ws_size); grid = -1; return; }
        int dev = 0, cus = 0, per_cu = 0;
        hipGetDevice(&dev); hipDeviceGetAttribute(&cus, hipDeviceAttributeMultiprocessorCount, dev);
        if (hipFuncSetAttribute((const void*)mega, hipFuncAttributeMaxDynamicSharedMemorySize, LDS_BYTES) != hipSuccess) { fprintf(stderr, "kernel_launch: hipFuncSetAttribute failed\n"); grid = -1; return; }
        if (hipOccupancyMaxActiveBlocksPerMultiprocessor(&per_cu, (const void*)mega, 512, LDS_BYTES) != hipSuccess || per_cu < 1) { fprintf(stderr, "kernel_launch: occupancy query says %d\n", per_cu); per_cu = 1; }
        (void)hipGetLastError();
        grid = cus * per_cu;
    }
    if (grid < 0) return;
    if (hipMemsetAsync((char*)d_ws + WS_BAR, 0, XCD_BAR_WORDS * 4, stream) != hipSuccess) { fprintf(stderr, "kernel_launch: memset of barrier words failed\n"); return; }
    Params p{};
    for (int i = 0; i < 27; ++i) p.in[i] = (const float*)d_in[i];
    p.out = (float*)d_out; p.ws = (unsigned char*)d_ws;
#if MK_MULTI
    for (int i = 0; i < N_PHASES; ++i) { p.lo = i; p.hi = i + 1; hipLaunchKernelGGL(mega, dim3(grid), dim3(512), LDS_BYTES, stream, p); }
#else
    p.lo = 0; p.hi = N_PHASES;
    void* args[] = {&p};
    hipError_t e = hipLaunchCooperativeKernel((void*)mega, dim3(grid), dim3(512), args, LDS_BYTES, stream);
    if (e != hipSuccess) fprintf(stderr, "cooperative launch failed: %s (grid %d)\n", hipGetErrorString(e), grid);
#endif
}
```
